# Optimizing an MI355X kernel written in HIP

```python
import jax, jax.numpy as jnp
from jax import lax
import numpy as np

D_MODEL = 1024
BATCH = 8
SEQ = 8192
DEPTH = 1

N_MEM = 256
EPS = 1e-6
NEG = -1e30
ROPE_THETA = 10000.0
MOBA_HEADS = 8
MOBA_HD = 64
MOBA_WIDTH = MOBA_HEADS * MOBA_HD
MOBA_BLOCK = 256
MOBA_TOPK = 3
Q_CHUNK = 128
GMLP_GROUPS = 8
GMLP_GD = 64
GMLP_WIDTH = GMLP_GROUPS * GMLP_GD
GMLP_CHUNK = 128
N_BRANCH = 2
IN_COLS = 3 * MOBA_WIDTH + 2 * GMLP_WIDTH + N_BRANCH * D_MODEL
XA_HEADS = 4
XA_HD = 128
XA_WIDTH = XA_HEADS * XA_HD
PEER_HEADS = 8
PEER_NKEYS = 128
PEER_N = PEER_NKEYS * PEER_NKEYS
PEER_DQ = 256
PEER_TOPK = 16
PEER_TOK_CHUNK = 128

kernel_name = "moba_gmlp_gated_peer_hybrid"


def rmsnorm(x, g):
    xf = x.astype(jnp.float32)
    y = xf * lax.rsqrt(jnp.mean(xf * xf, axis=-1, keepdims=True) + EPS)
    return (y * g.astype(jnp.float32)).astype(x.dtype)


def rope(x):
    S, Dh = x.shape[1], x.shape[3]
    half = Dh // 2
    freqs = ROPE_THETA ** (-jnp.arange(half, dtype=jnp.float32) / half)
    ang = jnp.arange(S, dtype=jnp.float32)[:, None] * freqs[None, :]
    c = jnp.cos(ang)[None, :, None, :]
    s = jnp.sin(ang)[None, :, None, :]
    xf = x.astype(jnp.float32)
    x1, x2 = xf[..., :half], xf[..., half:]
    return jnp.concatenate([x1 * c - x2 * s, x2 * c + x1 * s], axis=-1).astype(x.dtype)


def moba_attention(q, k, v):
    B, S, H, Dh = q.shape
    nb = -(-S // MOBA_BLOCK)
    pad = nb * MOBA_BLOCK - S
    nq = S // Q_CHUNK
    top = min(MOBA_TOPK, nb)
    kp = jnp.pad(k, ((0, 0), (0, pad), (0, 0), (0, 0)))
    vp = jnp.pad(v, ((0, 0), (0, pad), (0, 0), (0, 0)))
    kb = kp.reshape(B, nb, MOBA_BLOCK, H, Dh).transpose(0, 3, 1, 2, 4)
    vb = vp.reshape(B, nb, MOBA_BLOCK, H, Dh).transpose(0, 3, 1, 2, 4)
    k_mean = jnp.mean(kb.astype(jnp.float32), axis=3)
    q_blk = jnp.arange(S) // MOBA_BLOCK
    past = jnp.arange(nb)[None, :] < q_blk[:, None]
    gate = jnp.einsum("bshd,bhnd->bhsn", q.astype(jnp.float32), k_mean)
    gate = jnp.where(past[None, None], gate, NEG)
    _, sel = lax.top_k(gate, top)
    q_c = q.reshape(B, nq, Q_CHUNK, H, Dh).transpose(0, 1, 3, 2, 4).reshape(B * nq, H, Q_CHUNK, Dh)
    sel_c = sel.reshape(B, H, nq, Q_CHUNK, top).transpose(0, 2, 1, 3, 4).reshape(B * nq, H, Q_CHUNK, top)
    scale = Dh ** -0.5
    h_idx = jnp.arange(H)[:, None, None]

    def query_block(args):
        i, qc, si = args
        b = i // nq
        c = i % nq
        kb_b = kb[b]
        vb_b = vb[b]
        pos = c * Q_CHUNK + jnp.arange(Q_CHUNK)
        valid = si < (pos // MOBA_BLOCK)[None, :, None]
        k_sel = kb_b[h_idx, si]
        v_sel = vb_b[h_idx, si]
        s_sel = jnp.einsum("hqd,hqnld->hqnl", qc, k_sel).astype(jnp.float32) * scale
        s_sel = jnp.where(valid[..., None], s_sel, NEG).reshape(H, Q_CHUNK, top * MOBA_BLOCK)
        own = (c * Q_CHUNK) // MOBA_BLOCK
        k_own = lax.dynamic_index_in_dim(kb_b, own, axis=1, keepdims=False)
        v_own = lax.dynamic_index_in_dim(vb_b, own, axis=1, keepdims=False)
        s_own = jnp.einsum("hqd,hld->hql", qc, k_own).astype(jnp.float32) * scale
        k_pos = own * MOBA_BLOCK + jnp.arange(MOBA_BLOCK)
        s_own = jnp.where((k_pos[None, :] <= pos[:, None])[None], s_own, NEG)
        p = jax.nn.softmax(jnp.concatenate([s_sel, s_own], axis=-1), axis=-1).astype(qc.dtype)
        p_sel = p[..., :top * MOBA_BLOCK].reshape(H, Q_CHUNK, top, MOBA_BLOCK)
        p_own = p[..., top * MOBA_BLOCK:]
        return (jnp.einsum("hqnl,hqnld->hqd", p_sel, v_sel)
                + jnp.einsum("hql,hld->hqd", p_own, v_own))

    out = lax.map(query_block, (jnp.arange(B * nq), q_c, sel_c))
    return out.reshape(B, nq, H, Q_CHUNK, Dh).transpose(0, 1, 3, 2, 4).reshape(B, S, H * Dh)


def gmlp_spatial_gating(u, v, norm_g, w_s, b_s):
    B, S, _ = u.shape
    nc = S // GMLP_CHUNK
    u = jax.nn.gelu(u)
    v = rmsnorm(jax.nn.gelu(v), norm_g)
    vc = v.reshape(B, nc, GMLP_CHUNK, GMLP_GROUPS, GMLP_GD)
    causal = jnp.tril(jnp.ones((GMLP_CHUNK, GMLP_CHUNK), dtype=bool))
    wm = jnp.where(causal[None], w_s, 0.0).astype(v.dtype)
    z = jnp.einsum("gts,bcsgd->bctgd", wm, vc) + b_s.T.astype(v.dtype)[None, None, :, :, None]
    return u * z.reshape(B, S, GMLP_WIDTH)


def memory_cross_attention(h, m, w_q, w_kv, w_o):
    B, S, _ = h.shape
    M = m.shape[1]
    q = (h @ w_q).reshape(B, S, XA_HEADS, XA_HD)
    k, v = jnp.split(m @ w_kv, 2, axis=-1)
    k = k.reshape(B, M, XA_HEADS, XA_HD)
    v = v.reshape(B, M, XA_HEADS, XA_HD)
    s = jnp.einsum("bshd,bmhd->bhsm", q, k).astype(jnp.float32) * (XA_HD ** -0.5)
    p = jax.nn.softmax(s, axis=-1).astype(h.dtype)
    o = jnp.einsum("bhsm,bmhd->bshd", p, v).reshape(B, S, XA_WIDTH)
    return o @ w_o


def peer_ffn(h, w_q, subkeys, w_down, w_up):
    B, S, D = h.shape
    n_chunks = (B * S) // PEER_TOK_CHUNK
    half = PEER_DQ // 2
    kk = PEER_TOPK * PEER_TOPK

    def token_chunk(xc):
        q = (xc @ w_q).reshape(PEER_TOK_CHUNK, PEER_HEADS, 2, half).astype(jnp.float32)
        s = jnp.einsum("thpd,hpnd->thpn", q, subkeys.astype(jnp.float32))
        s1, i1 = lax.top_k(s[:, :, 0], PEER_TOPK)
        s2, i2 = lax.top_k(s[:, :, 1], PEER_TOPK)
        cand_s = (s1[..., :, None] + s2[..., None, :]).reshape(PEER_TOK_CHUNK, PEER_HEADS, kk)
        cand_i = (i1[..., :, None] * PEER_NKEYS + i2[..., None, :]).reshape(PEER_TOK_CHUNK, PEER_HEADS, kk)
        top_s, top_pos = lax.top_k(cand_s, PEER_TOPK)
        e = jnp.take_along_axis(cand_i, top_pos, axis=-1)
        g = jax.nn.softmax(top_s, axis=-1).astype(xc.dtype)
        a = jax.nn.gelu(jnp.einsum("td,thkd->thk", xc, w_down[e]))
        return jnp.einsum("thk,thkd->td", g * a, w_up[e])

    y = lax.map(token_chunk, h.reshape(n_chunks, PEER_TOK_CHUNK, D))
    return y.reshape(B, S, D)


def setup_inputs(seed: int = 0) -> dict:
    key = jax.random.key(seed)
    ks = jax.random.split(key, 24)

    def nrm(k, shape, scale):
        return jax.random.normal(k, shape, jnp.float32) * scale

    def gain(k, shape):
        return 1.0 + 0.01 * jax.random.normal(k, shape, jnp.float32)

    return {
        "x": nrm(ks[0], (BATCH, SEQ, D_MODEL), 1.0),
        "mem": nrm(ks[1], (BATCH, N_MEM, D_MODEL), 1.0),
        "norm_mix_g": gain(ks[2], (DEPTH, D_MODEL)),
        "w_in": nrm(ks[3], (DEPTH, D_MODEL, IN_COLS), D_MODEL ** -0.5),
        "moba_w_proj": nrm(ks[4], (DEPTH, MOBA_WIDTH, D_MODEL), MOBA_WIDTH ** -0.5),
        "gmlp_norm_g": gain(ks[5], (DEPTH, GMLP_WIDTH)),
        "gmlp_w_s": nrm(ks[6], (DEPTH, GMLP_GROUPS, GMLP_CHUNK, GMLP_CHUNK), GMLP_CHUNK ** -0.5),
        "gmlp_b_s": 1.0 + 0.1 * jax.random.normal(ks[7], (DEPTH, GMLP_GROUPS, GMLP_CHUNK), jnp.float32),
        "gmlp_w_proj": nrm(ks[8], (DEPTH, GMLP_WIDTH, D_MODEL), GMLP_WIDTH ** -0.5),
        "w_out": nrm(ks[9], (DEPTH, D_MODEL, D_MODEL), D_MODEL ** -0.5),
        "norm_xa_g": gain(ks[10], (DEPTH, D_MODEL)),
        "norm_mem_g": gain(ks[11], (DEPTH, D_MODEL)),
        "xa_w_q": nrm(ks[12], (DEPTH, D_MODEL, XA_WIDTH), D_MODEL ** -0.5),
        "xa_w_kv": nrm(ks[13], (DEPTH, D_MODEL, 2 * XA_WIDTH), D_MODEL ** -0.5),
        "xa_w_o": nrm(ks[14], (DEPTH, XA_WIDTH, D_MODEL), XA_WIDTH ** -0.5),
        "norm_ffn_g": gain(ks[15], (DEPTH, D_MODEL)),
        "peer_w_q": nrm(ks[16], (DEPTH, D_MODEL, PEER_HEADS * PEER_DQ), D_MODEL ** -0.5),
        "peer_subkeys": nrm(ks[17], (DEPTH, PEER_HEADS, 2, PEER_NKEYS, PEER_DQ // 2), (PEER_DQ // 2) ** -0.5),
        "peer_w_down": nrm(ks[18], (DEPTH, PEER_N, D_MODEL), D_MODEL ** -0.5),
        "peer_w_up": nrm(ks[19], (DEPTH, PEER_N, D_MODEL), 0.3),
        "final_g": gain(ks[20], (D_MODEL,)),
    }


def reference(x, mem, norm_mix_g, w_in, moba_w_proj, gmlp_norm_g, gmlp_w_s, gmlp_b_s,
              gmlp_w_proj, w_out, norm_xa_g, norm_mem_g, xa_w_q, xa_w_kv, xa_w_o,
              norm_ffn_g, peer_w_q, peer_subkeys, peer_w_down, peer_w_up, final_g):
    B, S, _ = x.shape
    splits = list(np.cumsum([MOBA_WIDTH, MOBA_WIDTH, MOBA_WIDTH, GMLP_WIDTH, GMLP_WIDTH, D_MODEL]))
    for l in range(DEPTH):
        h = rmsnorm(x, norm_mix_g[l])
        proj = h @ w_in[l]
        q, k, v, gu, gv, gate_a, gate_b = jnp.split(proj, splits, axis=-1)
        q = rope(q.reshape(B, S, MOBA_HEADS, MOBA_HD))
        k = rope(k.reshape(B, S, MOBA_HEADS, MOBA_HD))
        v = v.reshape(B, S, MOBA_HEADS, MOBA_HD)
        y_a = moba_attention(q, k, v) @ moba_w_proj[l]
        y_b = gmlp_spatial_gating(gu, gv, gmlp_norm_g[l], gmlp_w_s[l], gmlp_b_s[l]) @ gmlp_w_proj[l]
        merged = jax.nn.sigmoid(gate_a) * y_a + jax.nn.sigmoid(gate_b) * y_b
        x = x + merged @ w_out[l]
        h = rmsnorm(x, norm_xa_g[l])
        m = rmsnorm(mem, norm_mem_g[l])
        x = x + memory_cross_attention(h, m, xa_w_q[l], xa_w_kv[l], xa_w_o[l])
        h = rmsnorm(x, norm_ffn_g[l])
        x = x + peer_ffn(h, peer_w_q[l], peer_subkeys[l], peer_w_down[l], peer_w_up[l])
    return rmsnorm(x, final_g)
```

```cpp
#include <hip/hip_runtime.h>
#include <hip/hip_cooperative_groups.h>
#include <cstdio>
#include <cstdint>
namespace cg = cooperative_groups;

constexpr int T_TOK = 65536, DM = 1024, NB = 8, SEQ = 8192, NMEM = 256;
constexpr int IN_COLS = 4608;
constexpr float EPS = 1e-6f;
constexpr float LOG2E = 1.4426950408889634f;
constexpr float C2M = 0.125f * LOG2E;
constexpr float C2X = 0.08838834764831845f * LOG2E;

typedef unsigned short bf16_t;
#define LAS __attribute__((address_space(3)))

constexpr size_t MiB = 1u << 20;
constexpr size_t WS_CTL = 0, CTL_BYTES = 1 * MiB;
constexpr size_t WS_ROPE = 1 * MiB;
constexpr size_t WS_WIN_T = 3 * MiB;
constexpr size_t WS_WAB_T = 12 * MiB;
constexpr size_t WS_WOUT_T = 14 * MiB;
constexpr size_t WS_XAQ_T = 16 * MiB;
constexpr size_t WS_XAKV_T = 17 * MiB;
constexpr size_t WS_XAO_T = 19 * MiB;
constexpr size_t WS_PQ_T = 20 * MiB;
constexpr size_t WS_SK = 24 * MiB;
constexpr size_t WS_WM = 24 * MiB + 512 * 1024;
constexpr size_t WS_MN = 25 * MiB;
constexpr size_t WS_XKV = 29 * MiB;
constexpr size_t WS_KMP = 33 * MiB;
constexpr size_t WS_SS1 = 34 * MiB;
constexpr size_t WS_SS2 = 38 * MiB;
constexpr size_t WS_SEL = 42 * MiB;
constexpr size_t WS_WD = 44 * MiB;
constexpr size_t WS_SD = 60 * MiB;
constexpr size_t WS_SU = 61 * MiB;
constexpr size_t WS_WU = 76 * MiB;
constexpr size_t WS_SS3 = 92 * MiB;
constexpr size_t WS_RA = 108 * MiB;
constexpr size_t WS_XN = WS_RA, WS_PART = WS_RA, WS_ML = WS_RA + 192 * MiB, WS_MERGED = WS_RA;
constexpr size_t WS_RB = 316 * MiB;
constexpr size_t WS_Q = WS_RB, WS_K = WS_RB + 64 * MiB, WS_V = WS_RB + 128 * MiB, WS_XB = WS_RB, WS_XQ = WS_V;
constexpr size_t WS_RC = 508 * MiB;
constexpr size_t WS_U = WS_RC, WS_GV = WS_RC + 64 * MiB, WS_XO = WS_U, WS_PID = WS_GV, WS_PW = WS_GV + 32 * MiB;
constexpr size_t WS_RD = 636 * MiB;
constexpr size_t WS_GA = WS_RD, WS_GB = WS_RD + 128 * MiB, WS_QP = WS_RD;
constexpr size_t WS_RE = 892 * MiB;
constexpr size_t WS_ATTGM = WS_RE, WS_COEF = WS_RE;
constexpr size_t WS_PARTD = WS_RD;
constexpr size_t WS_END = 1020 * MiB;
constexpr size_t WS_RS = WS_SS2;

__device__ __forceinline__ float bf2f(bf16_t v) { return __uint_as_float((unsigned)v << 16); }
__device__ __forceinline__ bf16_t f2bf(float f) { unsigned u = __float_as_uint(f); return (bf16_t)((u + 0x7fffu + ((u >> 16) & 1u)) >> 16); }
__device__ __forceinline__ unsigned pk2(float lo, float hi) { return (unsigned)f2bf(lo) | ((unsigned)f2bf(hi) << 16); }
__device__ __forceinline__ float gelu_tanh(float x) { const float u = 0.7978845608028654f * (x + 0.044715f * x * x * x); return x / (1.f + __expf(-2.f * u)); }
__device__ __forceinline__ float sigmoidf(float x) { return 1.f / (1.f + __expf(-x)); }
template <int CTRL> __device__ __forceinline__ float dppf_(float v) { return __builtin_bit_cast(float, __builtin_amdgcn_update_dpp(0, __builtin_bit_cast(int, v), CTRL, 0xf, 0xf, true)); }
__device__ __forceinline__ float wave_sum(float v) {
    v += dppf_<0xB1>(v); v += dppf_<0x4E>(v); v += dppf_<0x141>(v); v += dppf_<0x140>(v);
    { auto rr = __builtin_amdgcn_permlane16_swap(__float_as_uint(v), __float_as_uint(v), false, false); v = __uint_as_float(rr[0]) + __uint_as_float(rr[1]); }
    { auto rr = __builtin_amdgcn_permlane32_swap(__float_as_uint(v), __float_as_uint(v), false, false); v = __uint_as_float(rr[0]) + __uint_as_float(rr[1]); }
    return v;
}
__device__ __forceinline__ float wave_max(float v) {
#pragma unroll
    for (int o = 1; o < 64; o <<= 1) v = fmaxf(v, __shfl_xor(v, o));
    return v;
}
__device__ __forceinline__ int qk_store_col(int d) { return 2 * (d & 31) + (d >> 5); }

struct Args { const float* in[21]; float* out; unsigned char* ws; int ph_lo, ph_hi, li, pad; };

template <bool QKPERM>
__device__ __forceinline__ void p0_transpose_item(const float* W, int ldw, int K, int Ncols, bf16_t* WT, int ldt, int col_off, const float* kscale, LAS float* scr, int item, int lane) {
    const int nblk = Ncols / 32, kb = item / nblk, nb = item % nblk, k0 = 64 * kb, n0 = 32 * nb;
#pragma unroll 8
    for (int i = 0; i < 32; ++i) { const int kk = 2 * i + (lane >> 5); float v = W[(size_t)(k0 + kk) * ldw + n0 + (lane & 31)]; if (kscale) v *= kscale[k0 + kk]; scr[kk * 33 + (lane & 31)] = v; }
    asm volatile("s_waitcnt lgkmcnt(0)" ::: "memory");
    const int c = lane & 7;
#pragma unroll
    for (int j = 0; j < 4; ++j) { const int n = (lane >> 3) + 8 * j; const LAS float* s = scr + (8 * c) * 33 + n;
        uint4 o; o.x = pk2(s[0 * 33], s[1 * 33]); o.y = pk2(s[2 * 33], s[3 * 33]); o.z = pk2(s[4 * 33], s[5 * 33]); o.w = pk2(s[6 * 33], s[7 * 33]);
        int nn = n0 + n;
        if (QKPERM) { if (nn < 1024) nn = (nn & ~63) + qk_store_col(nn & 63); }
        *(uint4*)(WT + (size_t)nn * ldt + col_off + k0 + 8 * c) = o; }
    asm volatile("s_waitcnt lgkmcnt(0)" ::: "memory");
}
template <int B>
__device__ __forceinline__ void rms_rows_to_bf16(const float* __restrict__ X, const float* __restrict__ g, bf16_t* __restrict__ O, size_t m0, size_t mstride, int lane) {
    float4 v[B][4];
#pragma unroll
    for (int u = 0; u < B; ++u) { const float4* xr = (const float4*)(X + (m0 + u * mstride) * DM) + lane;
#pragma unroll
        for (int j = 0; j < 4; ++j) v[u][j] = xr[64 * j]; }
    const float4* gr = (const float4*)g + lane; float4 gg[4];
#pragma unroll
    for (int j = 0; j < 4; ++j) gg[j] = gr[64 * j];
#pragma unroll
    for (int u = 0; u < B; ++u) { float s = 0.f;
#pragma unroll
        for (int j = 0; j < 4; ++j) s += (v[u][j].x * v[u][j].x + v[u][j].y * v[u][j].y) + (v[u][j].z * v[u][j].z + v[u][j].w * v[u][j].w);
        const float rstd = rsqrtf(wave_sum(s) * (1.f / DM) + EPS);
        uint2* o8 = (uint2*)(O + (m0 + u * mstride) * DM) + lane;
#pragma unroll
        for (int j = 0; j < 4; ++j) { uint2 o; o.x = pk2(v[u][j].x * rstd * gg[j].x, v[u][j].y * rstd * gg[j].y); o.y = pk2(v[u][j].z * rstd * gg[j].z, v[u][j].w * rstd * gg[j].w); o8[64 * j] = o; } }
}
__device__ __forceinline__ void p0_prologue(const Args& a, LAS unsigned char* lds) {
    const int tid = threadIdx.x, lane = tid & 63, wave = tid >> 6;
    const int gw = blockIdx.x * 8 + wave, NGW = gridDim.x * 8;
    unsigned char* ws = a.ws;
    LAS float* scr = (LAS float*)(lds + wave * 16384);
    constexpr int I_IN = (1024 / 64) * (IN_COLS / 32), I_A = (512 / 64) * (1024 / 32), I_O = (1024 / 64) * (1024 / 32), I_XQ = (1024 / 64) * (512 / 32), I_KV = I_O, I_XO = (512 / 64) * (1024 / 32), I_PQ = (1024 / 64) * (2048 / 32);
    constexpr int NITEMS = I_IN + 2 * I_A + I_O + I_XQ + I_KV + I_XO + I_PQ;
    for (int it = gw; it < NITEMS; it += NGW) {
        int r = it;
        if (r < I_IN) { p0_transpose_item<true>(a.in[3], IN_COLS, 1024, IN_COLS, (bf16_t*)(ws + WS_WIN_T), 1024, 0, nullptr, scr, r, lane); continue; } r -= I_IN;
        if (r < I_A) { p0_transpose_item<false>(a.in[4], 1024, 512, 1024, (bf16_t*)(ws + WS_WAB_T), 1024, 0, nullptr, scr, r, lane); continue; } r -= I_A;
        if (r < I_A) { p0_transpose_item<false>(a.in[8], 1024, 512, 1024, (bf16_t*)(ws + WS_WAB_T), 1024, 512, nullptr, scr, r, lane); continue; } r -= I_A;
        if (r < I_O) { p0_transpose_item<false>(a.in[9], 1024, 1024, 1024, (bf16_t*)(ws + WS_WOUT_T), 1024, 0, nullptr, scr, r, lane); continue; } r -= I_O;
        if (r < I_XQ) { p0_transpose_item<false>(a.in[12], 512, 1024, 512, (bf16_t*)(ws + WS_XAQ_T), 1024, 0, a.in[10], scr, r, lane); continue; } r -= I_XQ;
        if (r < I_KV) { p0_transpose_item<false>(a.in[13], 1024, 1024, 1024, (bf16_t*)(ws + WS_XAKV_T), 1024, 0, nullptr, scr, r, lane); continue; } r -= I_KV;
        if (r < I_XO) { p0_transpose_item<false>(a.in[14], 1024, 512, 1024, (bf16_t*)(ws + WS_XAO_T), 512, 0, nullptr, scr, r, lane); continue; } r -= I_XO;
        p0_transpose_item<false>(a.in[16], 2048, 1024, 2048, (bf16_t*)(ws + WS_PQ_T), 1024, 0, a.in[15], scr, r, lane);
    }
    const size_t gt = (size_t)blockIdx.x * blockDim.x + tid, GT = (size_t)gridDim.x * blockDim.x;
    {
        const float* s = a.in[17]; bf16_t* d = (bf16_t*)(ws + WS_SK);
        for (size_t i = gt; i < 8 * 2 * 128 * 128 / 4; i += GT) { const float4 v = ((const float4*)s)[i]; uint2 o; o.x = pk2(v.x, v.y); o.y = pk2(v.z, v.w); ((uint2*)d)[i] = o; }
    }
    {
        const float* s = a.in[6]; bf16_t* d = (bf16_t*)(ws + WS_WM);
        for (size_t i = gt; i < 8 * 128 * 128; i += GT) { const int ss = i & 127, tt = (i >> 7) & 127; d[i] = f2bf(ss <= tt ? s[i] : 0.f); }
    }
    {
        float2* d = (float2*)(ws + WS_ROPE);
        for (size_t i = gt; i < 8192 * 32; i += GT) { const int p = (int)(i >> 5), k = (int)(i & 31);
            const float freq = powf(10000.0f, -(float)k / 32.0f); const float ang = (float)p * freq; float sn, cs; sincosf(ang, &sn, &cs); d[i] = make_float2(cs, sn); }
    }
    for (int r0 = gw; r0 < 2 * 16384; r0 += 4 * NGW) {
        float v[4][16];
#pragma unroll
        for (int u = 0; u < 4; ++u) { const int r = r0 + u * NGW; if (r < 2 * 16384) { const int which = r >> 14, e = r & 16383; const float* src = (which ? a.in[19] : a.in[18]) + (size_t)e * 1024 + lane * 16;
#pragma unroll
            for (int q = 0; q < 4; ++q) { const float4 t4 = *(const float4*)(src + 4 * q); v[u][4 * q] = t4.x; v[u][4 * q + 1] = t4.y; v[u][4 * q + 2] = t4.z; v[u][4 * q + 3] = t4.w; } } }
#pragma unroll
        for (int u = 0; u < 4; ++u) { const int r = r0 + u * NGW; if (r < 2 * 16384) { const int which = r >> 14, e = r & 16383;
            if (!which) {
#pragma unroll
                for (int q = 0; q < 4; ++q) { const float4 g4 = *(const float4*)(a.in[15] + lane * 16 + 4 * q); v[u][4 * q] *= g4.x; v[u][4 * q + 1] *= g4.y; v[u][4 * q + 2] *= g4.z; v[u][4 * q + 3] *= g4.w; } }
            float am = 0.f;
#pragma unroll
            for (int q = 0; q < 16; ++q) am = fmaxf(am, fabsf(v[u][q]));
            am = wave_max(am);
            const float qmax = which ? 440.f : 127.f;
            const float inv = am > 0.f ? qmax / am : 0.f;
            if (lane == 0) ((float*)(ws + (which ? WS_SU : WS_SD)))[e] = am > 0.f ? am / qmax : 1.f;
            unsigned w[4];
            if (which) {
#pragma unroll
                for (int q = 0; q < 4; ++q) { int pk = __builtin_amdgcn_cvt_pk_fp8_f32(v[u][4 * q] * inv, v[u][4 * q + 1] * inv, 0, false); pk = __builtin_amdgcn_cvt_pk_fp8_f32(v[u][4 * q + 2] * inv, v[u][4 * q + 3] * inv, pk, true); w[q] = (unsigned)pk; }
            } else {
#pragma unroll
                for (int q = 0; q < 4; ++q) w[q] = ((unsigned)__float2int_rn(v[u][4 * q] * inv) & 0xffu) | (((unsigned)__float2int_rn(v[u][4 * q + 1] * inv) & 0xffu) << 8) | (((unsigned)__float2int_rn(v[u][4 * q + 2] * inv) & 0xffu) << 16) | ((unsigned)__float2int_rn(v[u][4 * q + 3] * inv) << 24);
            }
            *(uint4*)(ws + (which ? WS_WU : WS_WD) + (size_t)(lane >> 3) * (16384 * 128) + (size_t)e * 128 + (lane & 7) * 16) = make_uint4(w[0], w[1], w[2], w[3]); } }
    }
    { size_t m = gw;
      for (; m + 3 * (size_t)NGW < T_TOK; m += 4 * (size_t)NGW) rms_rows_to_bf16<4>(a.in[0], a.in[2], (bf16_t*)(ws + WS_XN), m, NGW, lane);
      for (; m < T_TOK; m += NGW) rms_rows_to_bf16<1>(a.in[0], a.in[2], (bf16_t*)(ws + WS_XN), m, NGW, lane); }
    for (size_t m = gw; m < NB * NMEM; m += NGW) rms_rows_to_bf16<1>(a.in[1], a.in[11], (bf16_t*)(ws + WS_MN), m, NGW, lane);
}


namespace pg8 {
typedef short bf16x8 __attribute__((ext_vector_type(8)));
typedef float f32x4 __attribute__((ext_vector_type(4)));
typedef unsigned u32x4 __attribute__((ext_vector_type(4)));
constexpr int BM = 256, BK = 64, HALF = 128, HTB = HALF * BK * 2, STAGE_BYTES = 8 * HTB, NXCD = 8, WGM = 8;
__host__ __device__ __forceinline__ int lds_byte(int r, int c) { const int st = (r >> 4) * 2 + (c >> 5), rr = r & 15, cc = c & 31, ob = rr * 64 + cc * 2; return st * 1024 + (ob ^ (((ob >> 9) & 1) << 5)); }
__host__ __device__ __forceinline__ void stage_rc(int b, int& R, int& C) { const int st = b / 1024, sb = b % 1024, swz = sb ^ (((sb >> 9) & 1) << 5); R = (st >> 1) * 16 + swz / 64; C = (st & 1) * 32 + (swz % 64) / 2; }
__host__ __device__ __forceinline__ int perm32(int rho) { const int n = rho >> 4, i = rho & 15; return 8 * (i >> 2) + 4 * n + (i & 3); }
struct Unit { int pm, pn, kofs, var; };
struct Gemm { const bf16_t* A; const bf16_t* Bt; int lda, ldb, K; };
struct StaticOrder {
    int nM, nN, nwg, G, c, NV, kvar;
    __device__ void init(int M, int N, int G_, int c_, int NV_ = 1, int kvar_ = 0) { nM = M / BM; nN = N / BM; nwg = nM * nN; G = G_; c = c_; NV = NV_; kvar = kvar_; }
    __device__ bool next(int i, Unit& u) const {
        const int it = i / NV, v = i - it * NV;
        const long L = (long)it * G + c; if (L >= nwg) return false;
        int wgid = (int)L; { const int q = nwg / NXCD, r = nwg % NXCD, xcd = wgid % NXCD, off = wgid / NXCD; wgid = (xcd < r ? xcd * (q + 1) : r * (q + 1) + (xcd - r) * q) + off; }
        const int nig = WGM * nN, gid = wgid / nig, fm = gid * WGM, gsz = (nM - fm) < WGM ? (nM - fm) : WGM;
        u.pm = fm + ((wgid % nig) % gsz); u.pn = (wgid % nig) / gsz; u.kofs = v * kvar; u.var = v; return true;
    }
};
__device__ __forceinline__ unsigned cvt_pk_bf16(float lo, float hi) { unsigned r; asm volatile("v_cvt_pk_bf16_f32 %0, %1, %2" : "=v"(r) : "v"(lo), "v"(hi)); return r; }
__device__ __forceinline__ u32x4 pack8(const f32x4 a, const f32x4 b) { u32x4 w; w.x = cvt_pk_bf16(a[0], a[1]); w.y = cvt_pk_bf16(a[2], a[3]); w.z = cvt_pk_bf16(b[0], b[1]); w.w = cvt_pk_bf16(b[2], b[3]); return w; }
__device__ __forceinline__ void unpack8(const u32x4 w, f32x4& a, f32x4& b) {
    a[0] = __uint_as_float(w.x << 16); a[1] = __uint_as_float(w.x & 0xffff0000u); a[2] = __uint_as_float(w.y << 16); a[3] = __uint_as_float(w.y & 0xffff0000u);
    b[0] = __uint_as_float(w.z << 16); b[1] = __uint_as_float(w.z & 0xffff0000u); b[2] = __uint_as_float(w.w << 16); b[3] = __uint_as_float(w.w & 0xffff0000u); }

template <class Epi, class Sched, bool MIDHOOK = false>
__device__ __forceinline__ void gemm_phase(LAS unsigned char* lds, const Gemm g, const Sched& S, const Epi& E) {
    const int tid = threadIdx.x, wid = __builtin_amdgcn_readfirstlane(tid >> 6), lane = tid & 63, wr = wid >> 2, wc = wid & 3, fr = lane & 15, fq = lane >> 4;
    const int nt = g.K / BK;
    unsigned voffA[2], voffB[2];
#pragma unroll
    for (int i = 0; i < 2; ++i) { int R, C; stage_rc(tid * 16 + i * 8192, R, C); const int Rb = (R & ~31) + perm32(R & 31);
        voffA[i] = (unsigned)(R * g.lda + C) * 2u; voffB[i] = (unsigned)(Rb * g.ldb + C) * 2u; }
    const size_t kstep = (size_t)(BK * 2);
    const size_t hstepA = (size_t)HALF * g.lda * 2, hstepB = (size_t)HALF * g.ldb * 2;
    const size_t tstepA = 2 * hstepA, tstepB = 2 * hstepB;
    const unsigned ldsw = (unsigned)wid * 1024u;
    const int aoff = lds_byte(wr * 64 + fr, fq * 8), boff = lds_byte(wc * 32 + fr, fq * 8);
#define PG8_SA(b, h) (((b) * 2 + (h)) * HTB)
#define PG8_SB(b, h) ((4 + (b) * 2 + (h)) * HTB)
#define PG8_STAGE(bufoff, gbase, voff) do { _Pragma("unroll") for (int _i = 0; _i < 2; ++_i) \
        __builtin_amdgcn_global_load_lds((const unsigned*)((const char*)(gbase) + (voff)[_i]), (LAS unsigned*)(lds + (bufoff) + ldsw + _i * 8192), 16, 0, 0); } while (0)
#define PG8_LDA(dst, b, h) do { _Pragma("unroll") for (int m = 0; m < 4; ++m) _Pragma("unroll") for (int k = 0; k < 2; ++k) dst[m][k] = *(const LAS bf16x8*)(lds + PG8_SA(b, h) + aoff + m * 2048 + k * 1024); } while (0)
#define PG8_LDB(dst, b, h) do { _Pragma("unroll") for (int n = 0; n < 2; ++n) _Pragma("unroll") for (int k = 0; k < 2; ++k) dst[n][k] = *(const LAS bf16x8*)(lds + PG8_SB(b, h) + boff + n * 2048 + k * 1024); } while (0)
#define PG8_MMA(ai, bj, At, Bt) do { __builtin_amdgcn_s_setprio(1); _Pragma("unroll") for (int m = 0; m < 4; ++m) _Pragma("unroll") for (int n = 0; n < 2; ++n) _Pragma("unroll") for (int k = 0; k < 2; ++k) \
        acc[ai][bj][m][n] = __builtin_amdgcn_mfma_f32_16x16x32_bf16(Bt[n][k], At[m][k], acc[ai][bj][m][n], 0, 0, 0); __builtin_amdgcn_s_setprio(0); } while (0)
#define PG8_WAIT_V(n) asm volatile("s_waitcnt vmcnt(" #n ")" ::: "memory")
#define PG8_WAIT_L(n) asm volatile("s_waitcnt lgkmcnt(" #n ")" ::: "memory")
#define PG8_BAR __builtin_amdgcn_s_barrier()
#define PG8_SCHED __builtin_amdgcn_sched_barrier(0)
    Unit cur, nxt; int ui = 0;
    if (!S.next(0, cur)) return;
    f32x4 acc[2][2][4][2];
#pragma unroll
    for (int a = 0; a < 2; ++a)
#pragma unroll
        for (int b = 0; b < 2; ++b)
#pragma unroll
            for (int m = 0; m < 4; ++m)
#pragma unroll
                for (int n = 0; n < 2; ++n) acc[a][b][m][n] = (f32x4){0.f, 0.f, 0.f, 0.f};
    bf16x8 At[4][2], B0[2][2], B1[2][2];
    const char* cA = (const char*)g.A + (size_t)cur.pm * tstepA + (size_t)cur.kofs * 2; const char* cB = (const char*)g.Bt + (size_t)cur.pn * tstepB + (size_t)cur.kofs * 2;
    PG8_STAGE(PG8_SB(0, 0), cB, voffB); PG8_STAGE(PG8_SB(0, 1), cB + hstepB, voffB); PG8_STAGE(PG8_SA(0, 0), cA, voffA); PG8_STAGE(PG8_SA(0, 1), cA + hstepA, voffA);
    if (wr == 1) PG8_BAR;
    PG8_WAIT_V(2); PG8_BAR;
    PG8_STAGE(PG8_SB(1, 0), cB + kstep, voffB); PG8_STAGE(PG8_SA(1, 0), cA + kstep, voffA); PG8_STAGE(PG8_SB(1, 1), cB + hstepB + kstep, voffB);
    PG8_WAIT_V(6); PG8_BAR;
    for (;;) {
        const bool has_next = S.next(ui + 1, nxt);
        const char* nA = has_next ? (const char*)g.A + (size_t)nxt.pm * tstepA + (size_t)nxt.kofs * 2 : cA; const char* nB = has_next ? (const char*)g.Bt + (size_t)nxt.pn * tstepB + (size_t)nxt.kofs * 2 : cB;
#define PG8_KPAIR(t) do { \
            const bool last = (t == nt - 2); \
            const char* a1 = cA + (size_t)(t + 1) * kstep; \
            const char* a2 = last ? nA : cA + (size_t)(t + 2) * kstep; const char* b2 = last ? nB : cB + (size_t)(t + 2) * kstep; \
            const char* a3 = a2 + kstep; const char* b3 = b2 + kstep; \
            PG8_LDB(B0, 0, 0); PG8_LDB(B1, 0, 1); PG8_SCHED; PG8_LDA(At, 0, 0); PG8_STAGE(PG8_SA(1, 1), a1 + hstepA, voffA); \
            PG8_WAIT_V(8); PG8_WAIT_L(0); PG8_BAR; PG8_MMA(0, 0, At, B0); PG8_MMA(0, 1, At, B1); PG8_BAR; PG8_SCHED; \
            PG8_LDA(At, 0, 1); PG8_STAGE(PG8_SB(0, 0), b2, voffB); PG8_STAGE(PG8_SB(0, 1), b2 + hstepB, voffB); PG8_STAGE(PG8_SA(0, 0), a2, voffA); \
            PG8_WAIT_V(8); PG8_WAIT_L(0); PG8_BAR; PG8_MMA(1, 0, At, B0); PG8_MMA(1, 1, At, B1); PG8_BAR; PG8_SCHED; \
            PG8_LDB(B0, 1, 0); PG8_LDB(B1, 1, 1); PG8_SCHED; PG8_LDA(At, 1, 0); PG8_STAGE(PG8_SA(0, 1), a2 + hstepA, voffA); \
            PG8_WAIT_V(8); PG8_WAIT_L(0); PG8_BAR; PG8_MMA(0, 0, At, B0); PG8_MMA(0, 1, At, B1); PG8_BAR; PG8_SCHED; \
            PG8_LDA(At, 1, 1); PG8_STAGE(PG8_SB(1, 0), b3, voffB); PG8_STAGE(PG8_SB(1, 1), b3 + hstepB, voffB); PG8_STAGE(PG8_SA(1, 0), a3, voffA); \
            PG8_WAIT_V(8); PG8_WAIT_L(0); PG8_BAR; PG8_MMA(1, 0, At, B0); PG8_MMA(1, 1, At, B1); PG8_BAR; PG8_SCHED; \
        } while (0)
        if constexpr (MIDHOOK) {
            for (int t = 0; t < nt / 2; t += 2) PG8_KPAIR(t);
            E.mid(acc, cur, wr, wc, fr, fq);
            for (int t = nt / 2; t < nt; t += 2) PG8_KPAIR(t);
        } else {
            for (int t = 0; t < nt; t += 2) PG8_KPAIR(t);
        }
#undef PG8_KPAIR
        if (wr == 0) PG8_BAR;
        E(acc, cur, wr, wc, fr, fq);
        if (!has_next) break;
#pragma unroll
        for (int a = 0; a < 2; ++a)
#pragma unroll
            for (int b = 0; b < 2; ++b)
#pragma unroll
                for (int m = 0; m < 4; ++m)
#pragma unroll
                    for (int n = 0; n < 2; ++n) acc[a][b][m][n] = (f32x4){0.f, 0.f, 0.f, 0.f};
        cur = nxt; cA = nA; cB = nB; ++ui;
        if (wr == 1) PG8_BAR;
    }
    PG8_WAIT_V(0);
    PG8_BAR;
#undef PG8_SA
#undef PG8_SB
#undef PG8_STAGE
#undef PG8_LDA
#undef PG8_LDB
#undef PG8_MMA
#undef PG8_WAIT_V
#undef PG8_WAIT_L
#undef PG8_BAR
#undef PG8_SCHED
}

#define EPI_ROWS() const int row0 = u.pm * BM + wr * 64 + fr; const int cw = wc * 32 + 8 * fq
template <int ACT>
__device__ __forceinline__ void store_act(const f32x4 (&acc)[2][2][4][2], bf16_t* O, int ldc, int colt, int row0, int cw) {
#pragma unroll
    for (int ai = 0; ai < 2; ++ai)
#pragma unroll
        for (int m = 0; m < 4; ++m) { bf16_t* rowp = O + (size_t)(row0 + ai * HALF + m * 16) * ldc + colt + cw;
#pragma unroll
            for (int bj = 0; bj < 2; ++bj) { f32x4 v0 = acc[ai][bj][m][0], v1 = acc[ai][bj][m][1];
                if (ACT == 1) {
#pragma unroll
                    for (int e = 0; e < 4; ++e) { v0[e] = gelu_tanh(v0[e]); v1[e] = gelu_tanh(v1[e]); } }
                if (ACT == 2) {
#pragma unroll
                    for (int e = 0; e < 4; ++e) { v0[e] = sigmoidf(v0[e]); v1[e] = sigmoidf(v1[e]); } }
                *(u32x4*)(rowp + bj * HALF) = pack8(v0, v1); } }
}
struct EpiPlain { bf16_t* O; int ldc;
    __device__ __forceinline__ void operator()(const f32x4 (&acc)[2][2][4][2], const Unit& u, int wr, int wc, int fr, int fq) const { EPI_ROWS(); store_act<0>(acc, O, ldc, u.pn * BM, row0, cw); } };
struct EpiInProj { bf16_t *Q, *K, *V, *U, *GV, *GA, *GB; float* KMP; const float2* rope;
    __device__ __forceinline__ void operator()(const f32x4 (&acc)[2][2][4][2], const Unit& u, int wr, int wc, int fr, int fq) const {
        EPI_ROWS(); const int pn = u.pn;
        if (pn < 4) {
            const bool isk = pn >= 2; bf16_t* O = isk ? K : Q; const float sc = isk ? 1.f : C2M; const int ct = (pn & 1) * 256;
            const int i0 = ((wc & 1) * 32 + 8 * fq) >> 1;
            f32x4 ks[2][2];
#pragma unroll
            for (int bj = 0; bj < 2; ++bj) { ks[bj][0] = (f32x4){0.f, 0.f, 0.f, 0.f}; ks[bj][1] = (f32x4){0.f, 0.f, 0.f, 0.f}; }
            f32x4 tt[2][4][2];
#pragma unroll
            for (int ai = 0; ai < 2; ++ai)
#pragma unroll
                for (int m = 0; m < 4; ++m) { const int pos = (row0 + ai * HALF + m * 16) & (SEQ - 1); tt[ai][m][0] = *(const f32x4*)(rope + pos * 32 + i0); tt[ai][m][1] = *(const f32x4*)(rope + pos * 32 + i0 + 2); }
#pragma unroll
            for (int ai = 0; ai < 2; ++ai)
#pragma unroll
                for (int m = 0; m < 4; ++m) { const int r = row0 + ai * HALF + m * 16;
                    const f32x4 t0 = tt[ai][m][0], t1 = tt[ai][m][1];
#pragma unroll
                    for (int bj = 0; bj < 2; ++bj) { const f32x4 v0 = acc[ai][bj][m][0], v1 = acc[ai][bj][m][1]; f32x4 o0, o1;
                        o0[0] = v0[0] * t0[0] - v0[1] * t0[1]; o0[1] = v0[1] * t0[0] + v0[0] * t0[1];
                        o0[2] = v0[2] * t0[2] - v0[3] * t0[3]; o0[3] = v0[3] * t0[2] + v0[2] * t0[3];
                        o1[0] = v1[0] * t1[0] - v1[1] * t1[1]; o1[1] = v1[1] * t1[0] + v1[0] * t1[1];
                        o1[2] = v1[2] * t1[2] - v1[3] * t1[3]; o1[3] = v1[3] * t1[2] + v1[2] * t1[3];
                        if (isk) { ks[bj][0] += o0; ks[bj][1] += o1; }
                        *(u32x4*)(O + (size_t)r * 512 + ct + bj * HALF + cw) = pack8(o0 * sc, o1 * sc); } }
            if (isk) {
#pragma unroll
                for (int bj = 0; bj < 2; ++bj)
#pragma unroll
                    for (int n = 0; n < 2; ++n)
#pragma unroll
                        for (int e = 0; e < 4; ++e) { float v = ks[bj][n][e]; v += __shfl_xor(v, 1); v += __shfl_xor(v, 2); v += __shfl_xor(v, 4); v += __shfl_xor(v, 8); ks[bj][n][e] = v; }
                if (fr == 0) {
#pragma unroll
                    for (int bj = 0; bj < 2; ++bj)
#pragma unroll
                        for (int n = 0; n < 2; ++n) *(f32x4*)(KMP + ((size_t)u.pm * 2 + wr) * 512 + ct + bj * HALF + cw + 4 * n) = ks[bj][n]; }
            }
        } else if (pn < 6) store_act<0>(acc, V, 512, (pn - 4) * BM, row0, cw);
        else if (pn < 8) store_act<1>(acc, U, 512, (pn - 6) * BM, row0, cw);
        else if (pn < 10) store_act<1>(acc, GV, 512, (pn - 8) * BM, row0, cw);
        else if (pn < 14) store_act<2>(acc, GA, 1024, (pn - 10) * BM, row0, cw);
        else store_act<2>(acc, GB, 1024, (pn - 14) * BM, row0, cw);
    } };
struct EpiMerged { const bf16_t *GA, *GB; bf16_t* MG;
    __device__ __forceinline__ void operator()(const f32x4 (&acc)[2][2][4][2], const Unit& u, int wr, int wc, int fr, int fq) const {
        EPI_ROWS(); const bf16_t* G = u.var ? GB : GA;
#pragma unroll
        for (int ai = 0; ai < 2; ++ai) {
            u32x4 gq[4][2], pq[4][2];
#pragma unroll
            for (int m = 0; m < 4; ++m)
#pragma unroll
                for (int bj = 0; bj < 2; ++bj) { const size_t off = (size_t)(row0 + ai * HALF + m * 16) * 1024 + u.pn * BM + cw + bj * HALF; gq[m][bj] = *(const u32x4*)(G + off); if (u.var) pq[m][bj] = *(const u32x4*)(MG + off); }
#pragma unroll
            for (int m = 0; m < 4; ++m)
#pragma unroll
                for (int bj = 0; bj < 2; ++bj) { const size_t off = (size_t)(row0 + ai * HALF + m * 16) * 1024 + u.pn * BM + cw + bj * HALF; f32x4 g0, g1; unpack8(gq[m][bj], g0, g1);
                    f32x4 v0 = acc[ai][bj][m][0] * g0, v1 = acc[ai][bj][m][1] * g1;
                    if (u.var) { f32x4 p0, p1; unpack8(pq[m][bj], p0, p1); v0 += p0; v1 += p1; }
                    *(u32x4*)(MG + off) = pack8(v0, v1); }
        }
    } };
struct EpiMergedFused { const bf16_t *GA, *GB; bf16_t* MG;
    __device__ __forceinline__ void mid(f32x4 (&acc)[2][2][4][2], const Unit& u, int wr, int wc, int fr, int fq) const {
        EPI_ROWS();
#pragma unroll
        for (int ai = 0; ai < 2; ++ai)
#pragma unroll
            for (int mh = 0; mh < 2; ++mh) {
                u32x4 ga[2][2], gb[2][2];
#pragma unroll
                for (int mm = 0; mm < 2; ++mm)
#pragma unroll
                    for (int bj = 0; bj < 2; ++bj) { const size_t off = (size_t)(row0 + ai * HALF + (mh * 2 + mm) * 16) * 1024 + u.pn * BM + cw + bj * HALF; ga[mm][bj] = *(const u32x4*)(GA + off); gb[mm][bj] = *(const u32x4*)(GB + off); }
#pragma unroll
                for (int mm = 0; mm < 2; ++mm)
#pragma unroll
                    for (int bj = 0; bj < 2; ++bj) { const int m = mh * 2 + mm; f32x4 a0, a1, b0, b1; unpack8(ga[mm][bj], a0, a1); unpack8(gb[mm][bj], b0, b1);
#pragma unroll
                        for (int e = 0; e < 4; ++e) { acc[ai][bj][m][0][e] *= a0[e] * __builtin_amdgcn_rcpf(fmaxf(b0[e], 1e-30f)); acc[ai][bj][m][1][e] *= a1[e] * __builtin_amdgcn_rcpf(fmaxf(b1[e], 1e-30f)); } }
                asm volatile("" ::: "memory");
            }
    }
    __device__ __forceinline__ void operator()(const f32x4 (&acc)[2][2][4][2], const Unit& u, int wr, int wc, int fr, int fq) const {
        EPI_ROWS();
#pragma unroll
        for (int ai = 0; ai < 2; ++ai) {
            u32x4 gb[4][2];
#pragma unroll
            for (int m = 0; m < 4; ++m)
#pragma unroll
                for (int bj = 0; bj < 2; ++bj) gb[m][bj] = *(const u32x4*)(GB + (size_t)(row0 + ai * HALF + m * 16) * 1024 + u.pn * BM + cw + bj * HALF);
#pragma unroll
            for (int m = 0; m < 4; ++m)
#pragma unroll
                for (int bj = 0; bj < 2; ++bj) { f32x4 b0, b1; unpack8(gb[m][bj], b0, b1);
                    *(u32x4*)(MG + (size_t)(row0 + ai * HALF + m * 16) * 1024 + u.pn * BM + cw + bj * HALF) = pack8(acc[ai][bj][m][0] * b0, acc[ai][bj][m][1] * b1); }
        }
    } };
template <bool RESBF> struct EpiResid { const float* res; bf16_t* XB; float* SS;
    __device__ __forceinline__ void operator()(const f32x4 (&acc)[2][2][4][2], const Unit& u, int wr, int wc, int fr, int fq) const {
        EPI_ROWS();
#pragma unroll
        for (int ai = 0; ai < 2; ++ai) {
            f32x4 xr[4][2][2];
#pragma unroll
            for (int m = 0; m < 4; ++m)
#pragma unroll
                for (int bj = 0; bj < 2; ++bj) { const size_t off = (size_t)(row0 + ai * HALF + m * 16) * 1024 + u.pn * BM + cw + bj * HALF;
                    if (RESBF) { const u32x4 w = *(const u32x4*)(XB + off); xr[m][bj][0] = __builtin_bit_cast(f32x4, w); }
                    else { xr[m][bj][0] = *(const f32x4*)(res + off); xr[m][bj][1] = *(const f32x4*)(res + off + 4); } }
#pragma unroll
            for (int m = 0; m < 4; ++m) { const int r = row0 + ai * HALF + m * 16; float ss = 0.f;
#pragma unroll
                for (int bj = 0; bj < 2; ++bj) { const size_t off = (size_t)r * 1024 + u.pn * BM + cw + bj * HALF; f32x4 x0, x1;
                    if (RESBF) unpack8(__builtin_bit_cast(u32x4, xr[m][bj][0]), x0, x1); else { x0 = xr[m][bj][0]; x1 = xr[m][bj][1]; }
                    const f32x4 v0 = acc[ai][bj][m][0] + x0, v1 = acc[ai][bj][m][1] + x1;
                    *(u32x4*)(XB + off) = pack8(v0, v1);
                    ss += (v0[0] * v0[0] + v0[1] * v0[1]) + (v0[2] * v0[2] + v0[3] * v0[3]) + (v1[0] * v1[0] + v1[1] * v1[1]) + (v1[2] * v1[2] + v1[3] * v1[3]); }
                ss += __shfl_xor(ss, 16); ss += __shfl_xor(ss, 32);
                if (fq == 0) SS[(size_t)r * 16 + u.pn * 4 + wc] = ss; }
        }
    } };
struct EpiRowScale { bf16_t* O; int ldc; const float* SS; float cscale;
    __device__ __forceinline__ void operator()(const f32x4 (&acc)[2][2][4][2], const Unit& u, int wr, int wc, int fr, int fq) const {
        EPI_ROWS();
        f32x4 sq[2][4];
#pragma unroll
        for (int ai = 0; ai < 2; ++ai)
#pragma unroll
            for (int m = 0; m < 4; ++m) sq[ai][m] = *(const f32x4*)(SS + (size_t)(row0 + ai * HALF + m * 16) * 16 + 4 * fq);
#pragma unroll
        for (int ai = 0; ai < 2; ++ai)
#pragma unroll
            for (int m = 0; m < 4; ++m) { const int r = row0 + ai * HALF + m * 16; const f32x4 s4 = sq[ai][m];
                float st = (s4[0] + s4[1]) + (s4[2] + s4[3]); st += __shfl_xor(st, 16); st += __shfl_xor(st, 32);
                const float rs = rsqrtf(st * (1.f / DM) + EPS) * cscale;
                bf16_t* rowp = O + (size_t)r * ldc + u.pn * BM + cw;
#pragma unroll
                for (int bj = 0; bj < 2; ++bj) *(u32x4*)(rowp + bj * HALF) = pack8(acc[ai][bj][m][0] * rs, acc[ai][bj][m][1] * rs); }
    } };
#undef EPI_ROWS
}


namespace att {
typedef unsigned u32x4 __attribute__((ext_vector_type(4)));
typedef float f32x4 __attribute__((ext_vector_type(4)));
typedef short bf16x8 __attribute__((ext_vector_type(8)));
typedef short s16x4 __attribute__((ext_vector_type(4)));
typedef float f32x16 __attribute__((ext_vector_type(16)));
typedef float f32x8 __attribute__((ext_vector_type(8)));
typedef float f32x2 __attribute__((ext_vector_type(2)));
#define KSWZ(row, colB) ((row) * 256 + ((colB) ^ (((row) & 7) << 4)))
#define SBAR() __builtin_amdgcn_sched_barrier(0)
constexpr float THR2 = 8.f;
__device__ __forceinline__ int crow(int r, int hi) { return (r & 3) + 8 * (r >> 2) + 4 * hi; }
__device__ __forceinline__ unsigned cvtpk(float lo, float hi) { unsigned r; asm volatile("v_cvt_pk_bf16_f32 %0, %1, %2" : "=v"(r) : "v"(lo), "v"(hi)); return r; }
template <bool SWAPK>
__device__ __forceinline__ void softmax_tile(f32x16& p0, f32x16& p1, float& m_reg, float& l_reg, float& alpha, f32x16& negm, bool first, bf16x8& pa0, bf16x8& pa1, bf16x8& pa2, bf16x8& pa3) {
    float pmax = p0[0];
#pragma unroll
    for (int r = 1; r < 16; ++r) pmax = fmaxf(pmax, p0[r]);
#pragma unroll
    for (int r = 0; r < 16; ++r) pmax = fmaxf(pmax, p1[r]);
    { auto rr = __builtin_amdgcn_permlane32_swap(__float_as_uint(pmax), __float_as_uint(pmax), false, false); pmax = fmaxf(__uint_as_float(rr[0]), __uint_as_float(rr[1])); }
    alpha = 1.f;
    if (first || !__all(pmax <= THR2)) {
        const float d = first ? pmax : fmaxf(pmax, 0.f);
        m_reg += d; alpha = first ? 1.f : __builtin_amdgcn_exp2f(-d);
#pragma unroll
        for (int r = 0; r < 16; ++r) { p0[r] -= d; p1[r] -= d; negm[r] = -m_reg; }
    }
#pragma unroll
    for (int r = 0; r < 16; ++r) { p0[r] = __builtin_amdgcn_exp2f(p0[r]); p1[r] = __builtin_amdgcn_exp2f(p1[r]); }
    float ps;
    { const f32x16 s16 = p0 + p1;
      const f32x8 s8 = s16.lo + s16.hi; const f32x4 s4 = s8.lo + s8.hi; const f32x2 s2 = s4.lo + s4.hi; ps = s2[0] + s2[1]; }
    { auto rr = __builtin_amdgcn_permlane32_swap(__float_as_uint(ps), __float_as_uint(ps), false, false); ps = __uint_as_float(rr[0]) + __uint_as_float(rr[1]); }
    l_reg = l_reg * alpha + ps;
#define PK4(P, BASE, OUT) do { unsigned a0 = cvtpk(P[BASE + 0], P[BASE + 1]), a1 = cvtpk(P[BASE + 2], P[BASE + 3]); \
    unsigned b0 = cvtpk(P[BASE + 4], P[BASE + 5]), b1 = cvtpk(P[BASE + 6], P[BASE + 7]); \
    auto r0 = __builtin_amdgcn_permlane32_swap(a0, b0, false, false); auto r1 = __builtin_amdgcn_permlane32_swap(a1, b1, false, false); \
    u32x4 w = {r0[0], r1[0], r0[1], r1[1]}; OUT = __builtin_bit_cast(bf16x8, w); } while (0)
#define PKD(P, BASE, OUT) do { u32x4 w = {cvtpk(P[BASE + 0], P[BASE + 1]), cvtpk(P[BASE + 2], P[BASE + 3]), cvtpk(P[BASE + 4], P[BASE + 5]), cvtpk(P[BASE + 6], P[BASE + 7])}; OUT = __builtin_bit_cast(bf16x8, w); } while (0)
    if (SWAPK) { PK4(p0, 0, pa0); PK4(p0, 8, pa1); PK4(p1, 0, pa2); PK4(p1, 8, pa3); }
    else { PKD(p0, 0, pa0); PKD(p0, 8, pa1); PKD(p1, 0, pa2); PKD(p1, 8, pa3); }
#undef PKD
#undef PK4
}
__device__ __forceinline__ void qkt128(f32x16& p0, f32x16& p1, const LAS unsigned char* Ks, const bf16x8* qr, const f32x16& negm, int r32, int hi) {
    p0 = negm; p1 = negm;
#pragma unroll
    for (int d0 = 0; d0 < 8; ++d0) { const int cb = (d0 * 16 + hi * 8) * 2;
        const bf16x8 b0 = *(const LAS bf16x8*)(Ks + KSWZ(r32, cb)); const bf16x8 b1 = *(const LAS bf16x8*)(Ks + KSWZ(32 + r32, cb));
        p0 = __builtin_amdgcn_mfma_f32_32x32x16_bf16(b0, qr[d0], p0, 0, 0, 0); p1 = __builtin_amdgcn_mfma_f32_32x32x16_bf16(b1, qr[d0], p1, 0, 0, 0); }
}
__device__ __forceinline__ int v_st(int k, int c) { const int kk = (k & ~0xC) | ((k & 4) << 1) | ((k & 8) >> 1); return ((kk >> 3) * 4 + (c >> 5)) * 512 + ((kk & 7) * 32 + (c & 31)) * 2; }
__device__ __forceinline__ int v_rd_base(int lane) { return ((lane & 3) << 3) | (((lane >> 2) & 3) << 6) | (((lane >> 4) & 1) << 5) | (((lane >> 5) & 1) << 8); }
constexpr int v_rd_off(int d0, int ks, int half) { return d0 * 512 + ks * 4096 + half * 2048; }
template <int OFF> __device__ __forceinline__ s16x4 tr_read(int vb) { s16x4 r; asm volatile("ds_read_b64_tr_b16 %0, %1 offset:%2" : "=&v"(r) : "v"(vb), "i"(OFF) : "memory"); return r; }
template <int D0> __device__ __forceinline__ void pv_one(f32x16& od, int vb, bf16x8 pa0, bf16x8 pa1, bf16x8 pa2, bf16x8 pa3) {
    const s16x4 l0 = tr_read<v_rd_off(D0, 0, 0)>(vb), h0 = tr_read<v_rd_off(D0, 0, 1)>(vb), l1 = tr_read<v_rd_off(D0, 1, 0)>(vb), h1 = tr_read<v_rd_off(D0, 1, 1)>(vb);
    const s16x4 l2 = tr_read<v_rd_off(D0, 2, 0)>(vb), h2 = tr_read<v_rd_off(D0, 2, 1)>(vb), l3 = tr_read<v_rd_off(D0, 3, 0)>(vb), h3 = tr_read<v_rd_off(D0, 3, 1)>(vb);
    asm volatile("s_waitcnt lgkmcnt(0)" ::: "memory"); SBAR();
#define PK(L, H) (bf16x8){L[0], L[1], L[2], L[3], H[0], H[1], H[2], H[3]}
    od = __builtin_amdgcn_mfma_f32_32x32x16_bf16(pa0, PK(l0, h0), od, 0, 0, 0);
    od = __builtin_amdgcn_mfma_f32_32x32x16_bf16(pa1, PK(l1, h1), od, 0, 0, 0);
    od = __builtin_amdgcn_mfma_f32_32x32x16_bf16(pa2, PK(l2, h2), od, 0, 0, 0);
    od = __builtin_amdgcn_mfma_f32_32x32x16_bf16(pa3, PK(l3, h3), od, 0, 0, 0);
#undef PK
}

__device__ __forceinline__ void qkt64(f32x16& p0, f32x16& p1, const LAS unsigned char* Kt, const bf16x8* qr, const f32x16& negm, int r32, int hi) {
    const LAS unsigned char* kb = Kt + hi * 1024 + r32 * 16;
    p0 = negm; p1 = negm;
#pragma unroll
    for (int d0 = 0; d0 < 4; ++d0) { const bf16x8 b0 = *(const LAS bf16x8*)(kb + d0 * 2048), b1 = *(const LAS bf16x8*)(kb + d0 * 2048 + 512);
        p0 = __builtin_amdgcn_mfma_f32_32x32x16_bf16(b0, qr[d0], p0, 0, 0, 0); p1 = __builtin_amdgcn_mfma_f32_32x32x16_bf16(b1, qr[d0], p1, 0, 0, 0); }
}
template <int D0> __device__ __forceinline__ void pv64_one(f32x16& od, int vb, bf16x8 pa0, bf16x8 pa1, bf16x8 pa2, bf16x8 pa3) {
    const s16x4 l0 = tr_read<D0 * 4096 + 0>(vb), h0 = tr_read<D0 * 4096 + 512>(vb), l1 = tr_read<D0 * 4096 + 1024>(vb), h1 = tr_read<D0 * 4096 + 1536>(vb);
    const s16x4 l2 = tr_read<D0 * 4096 + 2048>(vb), h2 = tr_read<D0 * 4096 + 2560>(vb), l3 = tr_read<D0 * 4096 + 3072>(vb), h3 = tr_read<D0 * 4096 + 3584>(vb);
    asm volatile("s_waitcnt lgkmcnt(0)" ::: "memory"); SBAR();
#define PK(L, H) (bf16x8){L[0], L[1], L[2], L[3], H[0], H[1], H[2], H[3]}
    od = __builtin_amdgcn_mfma_f32_32x32x16_bf16(pa0, PK(l0, h0), od, 0, 0, 0);
    od = __builtin_amdgcn_mfma_f32_32x32x16_bf16(pa1, PK(l1, h1), od, 0, 0, 0);
    od = __builtin_amdgcn_mfma_f32_32x32x16_bf16(pa2, PK(l2, h2), od, 0, 0, 0);
    od = __builtin_amdgcn_mfma_f32_32x32x16_bf16(pa3, PK(l3, h3), od, 0, 0, 0);
#undef PK
}
constexpr int MB_K = 0, MB_V = 32768, MB_LIST = 65536, MB_WS = 81920, MB_MISC = 90112, MB_STG = 91136;
struct KVRegs { uint4 k[4], v[4]; };
__device__ __forceinline__ void moba_kv_load(KVRegs& R, const bf16_t* K, const bf16_t* V, size_t row0, int h, int tid) {
#pragma unroll
    for (int i = 0; i < 4; ++i) { const int key = tid & 255, ch = (tid >> 8) + 2 * i; R.k[i] = *(const uint4*)(K + (row0 + key) * 512 + h * 64 + ch * 8); }
#pragma unroll
    for (int i = 0; i < 4; ++i) { const int pc = tid + 512 * i, key = pc >> 3, c8 = pc & 7; R.v[i] = *(const uint4*)(V + (row0 + key) * 512 + h * 64 + c8 * 8); }
}
__device__ __forceinline__ void moba_kv_store(LAS unsigned char* lds, const KVRegs& R, int tid) {
#pragma unroll
    for (int i = 0; i < 4; ++i) { const int key = tid & 255, ch = (tid >> 8) + 2 * i;
        *(LAS u32x4*)(lds + MB_K + (key >> 6) * 8192 + ch * 1024 + (key & 63) * 16) = (u32x4){R.k[i].x, R.k[i].y, R.k[i].z, R.k[i].w}; }
#pragma unroll
    for (int i = 0; i < 4; ++i) { const int pc = tid + 512 * i, key = pc >> 3, c8 = pc & 7;
        *(LAS u32x4*)(lds + MB_V + (key >> 6) * 8192 + (c8 >> 2) * 4096 + ((key >> 4) & 3) * 1024 + (key & 15) * 64 + (c8 & 3) * 16) = (u32x4){R.v[i].x, R.v[i].y, R.v[i].z, R.v[i].w}; }
}
__device__ __forceinline__ void rescale_o2(f32x16 (&o)[2], float alpha, LAS float* wsf, int r32, int hi) {
    if (__any(alpha < 1.f)) { if (hi == 0) wsf[r32] = alpha; asm volatile("s_waitcnt lgkmcnt(0)" ::: "memory");
#pragma unroll
        for (int r = 0; r < 16; ++r) { const float al = wsf[crow(r, hi)]; o[0][r] *= al; o[1][r] *= al; }
        asm volatile("s_waitcnt lgkmcnt(0)" ::: "memory"); }
}
__device__ __forceinline__ void top3_insert(float v, int i, float& v0, int& i0, float& v1, int& i1, float& v2, int& i2) {
    const bool g0 = v > v0, g1 = v > v1, g2 = v > v2;
    v2 = g1 ? v1 : (g2 ? v : v2); i2 = g1 ? i1 : (g2 ? i : i2);
    v1 = g0 ? v0 : (g1 ? v : v1); i1 = g0 ? i0 : (g1 ? i : i1);
    v0 = g0 ? v : v0; i0 = g0 ? i : i0;
}
__device__ __forceinline__ void sel_phase(const bf16_t* __restrict__ Q, const float* __restrict__ KMP, signed char* __restrict__ SEL) {
    const int tid = threadIdx.x, lane = tid & 63, wid = tid >> 6, r32 = lane & 31, hi = lane >> 5;
    const int gw = blockIdx.x * 8 + wid, NGW = gridDim.x * 8;
    for (int wu = gw; wu < 64 * 32; wu += NGW) {
        const int bh = wu & 63, qb = wu >> 6, b = bh >> 3, h = bh & 7;
        if (qb == 0) {
#pragma unroll
            for (int g = 0; g < 4; ++g) ((unsigned*)SEL)[(size_t)(b * 8 + h) * SEQ + g * 64 + lane] = 0xffffffffu;
            continue;
        }
        bf16x8 ka[4];
        { const float* kp = KMP + (size_t)(b * 32 + r32) * 1024 + h * 64 + hi * 8;
#pragma unroll
          for (int ks = 0; ks < 4; ++ks) { const f32x4 a0 = *(const f32x4*)(kp + ks * 16), a1 = *(const f32x4*)(kp + ks * 16 + 4), c0 = *(const f32x4*)(kp + 512 + ks * 16), c1 = *(const f32x4*)(kp + 512 + ks * 16 + 4);
              const f32x4 s0 = (a0 + c0) * (1.f / 256.f), s1 = (a1 + c1) * (1.f / 256.f);
              const u32x4 w = {cvtpk(s0[0], s0[1]), cvtpk(s0[2], s0[3]), cvtpk(s1[0], s1[1]), cvtpk(s1[2], s1[3])}; ka[ks] = __builtin_bit_cast(bf16x8, w); } }
#pragma unroll 1
        for (int gp = 0; gp < 2; ++gp) {
            bf16x8 qf[4][4];
#pragma unroll
            for (int g = 0; g < 4; ++g)
#pragma unroll
                for (int ks = 0; ks < 4; ++ks) qf[g][ks] = *(const bf16x8*)(Q + ((size_t)b * SEQ + qb * 256 + (gp * 4 + g) * 32 + r32) * 512 + h * 64 + ks * 16 + hi * 8);
#pragma unroll
            for (int g = 0; g < 4; ++g) {
                f32x16 acc = {};
#pragma unroll
                for (int ks = 0; ks < 4; ++ks) acc = __builtin_amdgcn_mfma_f32_32x32x16_bf16(ka[ks], qf[g][ks], acc, 0, 0, 0);
                float v0 = -3e38f, v1 = -3e38f, v2 = -3e38f; int i0 = -1, i1 = -1, i2 = -1;
#pragma unroll
                for (int r = 0; r < 16; ++r) { const int n = crow(r, hi); if (n < qb) top3_insert(acc[r], n, v0, i0, v1, i1, v2, i2); }
                float pv[3] = {v0, v1, v2}; int pi[3] = {i0, i1, i2};
#pragma unroll
                for (int k = 0; k < 3; ++k) { auto rv = __builtin_amdgcn_permlane32_swap(__float_as_uint(pv[k]), __float_as_uint(pv[k]), false, false); auto ri = __builtin_amdgcn_permlane32_swap((unsigned)pi[k], (unsigned)pi[k], false, false);
                    const float ov = __uint_as_float(hi ? rv[0] : rv[1]); const int oi = (int)(hi ? ri[0] : ri[1]);
                    if (oi >= 0) top3_insert(ov, oi, v0, i0, v1, i1, v2, i2); }
                if (hi == 0) ((unsigned*)SEL)[(size_t)(b * 8 + h) * SEQ + qb * 256 + (gp * 4 + g) * 32 + r32] = (unsigned)(i0 & 0xff) | ((unsigned)(i1 & 0xff) << 8) | ((unsigned)(i2 & 0xff) << 16) | 0xff000000u;
            }
        }
    }
}
__device__ __forceinline__ void moba_sel_phase(LAS unsigned char* lds, const bf16_t* Q, const bf16_t* K, const bf16_t* V, const signed char* SEL, bf16_t* PART, float* ML, unsigned* qctr) {
    const int tid = threadIdx.x, wid = tid >> 6, lane = tid & 63, r32 = lane & 31, hi = lane >> 5;
    LAS float* wsf = (LAS float*)(lds + MB_WS + wid * 1024); LAS int* wsd = (LAS int*)(wsf + 64);
    LAS unsigned* misc = (LAS unsigned*)(lds + MB_MISC); LAS unsigned short* list = (LAS unsigned short*)(lds + MB_LIST);
    const int vb0 = (int)(uintptr_t)(lds + MB_V) + ((lane >> 4) & 1) * 32 + (lane & 3) * 8 + (4 * hi + ((lane & 15) >> 2)) * 64;
    constexpr int NU = 31 * 64;
    if (tid == 0) misc[2] = __hip_atomic_fetch_add(qctr, 1u, __ATOMIC_RELAXED, __HIP_MEMORY_SCOPE_AGENT);
    __syncthreads();
    int u = (int)misc[2];
    KVRegs R;
    if (u < NU) moba_kv_load(R, K, V, (size_t)((u & 63) >> 3) * SEQ + (size_t)(u >> 6) * 256, u & 7, tid);
    if (tid == 0) misc[4] = 0u;
    int it = 0;
    while (u < NU) {
        const int n = u >> 6, bh = u & 63, b = bh >> 3, h = bh & 7;
        LAS unsigned* cntw = misc + 4 + (it & 1);
        __syncthreads();
        if (tid == 0) misc[2] = __hip_atomic_fetch_add(qctr, 1u, __ATOMIC_RELAXED, __HIP_MEMORY_SCOPE_AGENT);
        unsigned sv[16];
#pragma unroll
        for (int i = 0; i < 16; ++i) { const int pos = 256 * (n + 1) + i * 512 + tid; sv[i] = ((const unsigned*)SEL)[(size_t)(b * 8 + h) * SEQ + (pos < SEQ ? pos : SEQ - 1)]; }
        int wtot = 0;
#pragma unroll
        for (int i = 0; i < 16; ++i) { const int pos = 256 * (n + 1) + i * 512 + tid;
            const bool hit = pos < SEQ && ((sv[i] & 0xff) == (unsigned)n || ((sv[i] >> 8) & 0xff) == (unsigned)n || ((sv[i] >> 16) & 0xff) == (unsigned)n);
            wtot += __popcll(__ballot(hit)); }
        unsigned off = 0; if (lane == 0 && wtot) off = __hip_atomic_fetch_add(cntw, (unsigned)wtot, __ATOMIC_RELAXED, __HIP_MEMORY_SCOPE_WORKGROUP);
        off = __builtin_amdgcn_readfirstlane(off);
#pragma unroll
        for (int i = 0; i < 16; ++i) { const int pos = 256 * (n + 1) + i * 512 + tid;
            const int slot = pos >= SEQ ? -1 : ((sv[i] & 0xff) == (unsigned)n) ? 0 : (((sv[i] >> 8) & 0xff) == (unsigned)n) ? 1 : (((sv[i] >> 16) & 0xff) == (unsigned)n) ? 2 : -1;
            const unsigned long long bal = __ballot(slot >= 0);
            if (slot >= 0) list[off + __popcll(bal & ((1ull << lane) - 1ull))] = (unsigned short)((pos << 2) | slot);
            off += (unsigned)__popcll(bal); }
        __syncthreads();
        const int unext = (int)misc[2];
        const int cnt = (int)*cntw, nbatch = (cnt + 31) >> 5;
        if (tid == 0) misc[4 + ((it + 1) & 1)] = 0u;
        unsigned en = 0; bf16x8 qn[4];
        if (wid < nbatch) { const int li0 = wid * 32 + r32; en = list[li0 < cnt ? li0 : cnt - 1];
#pragma unroll
            for (int d0 = 0; d0 < 4; ++d0) qn[d0] = *(const bf16x8*)(Q + ((size_t)b * SEQ + (en >> 2)) * 512 + h * 64 + d0 * 16 + hi * 8); }
        moba_kv_store(lds, R, tid);
        __syncthreads();
        if (unext < NU) moba_kv_load(R, K, V, (size_t)((unext & 63) >> 3) * SEQ + (size_t)(unext >> 6) * 256, unext & 7, tid);
        ++it;
        for (int bt = wid; bt < nbatch; bt += 8) {
            const int li = bt * 32 + r32; const bool valid = li < cnt; const unsigned e = en;
            const int pos = e >> 2, slot = e & 3; const size_t t = (size_t)b * SEQ + pos;
            bf16x8 qr[4];
#pragma unroll
            for (int d0 = 0; d0 < 4; ++d0) qr[d0] = qn[d0];
            { const int btn = (bt + 8 < nbatch) ? bt + 8 : bt; const int lin = btn * 32 + r32; en = list[lin < cnt ? lin : cnt - 1];
#pragma unroll
              for (int d0 = 0; d0 < 4; ++d0) qn[d0] = *(const bf16x8*)(Q + ((size_t)b * SEQ + (en >> 2)) * 512 + h * 64 + d0 * 16 + hi * 8); }
            float m_reg = 0.f, l_reg = 0.f; f32x16 o[2] = {}; f32x16 negm = {};
#pragma unroll
            for (int kt = 0; kt < 4; ++kt) {
                f32x16 p0, p1; float alpha; bf16x8 pa0, pa1, pa2, pa3;
                qkt64(p0, p1, lds + MB_K + kt * 8192, qr, negm, r32, hi);
                softmax_tile<false>(p0, p1, m_reg, l_reg, alpha, negm, kt == 0, pa0, pa1, pa2, pa3);
                rescale_o2(o, alpha, wsf, r32, hi);
                pv64_one<0>(o[0], vb0 + kt * 8192, pa0, pa1, pa2, pa3); pv64_one<1>(o[1], vb0 + kt * 8192, pa0, pa1, pa2, pa3);
            }
            const int dst = valid ? (int)((t * 8 + h) * 3 + slot) : -1;
            if (hi == 0) { wsf[32 + r32] = l_reg; wsd[r32] = dst; if (valid) *(float2*)(ML + (size_t)dst * 2) = make_float2(m_reg, l_reg); }
            asm volatile("s_waitcnt lgkmcnt(0)" ::: "memory");
            LAS bf16_t* stg = (LAS bf16_t*)(lds + MB_STG + wid * 4096);
#pragma unroll
            for (int r = 0; r < 16; ++r) { const int orow = crow(r, hi); const float rl = __builtin_amdgcn_rcpf(wsf[32 + orow]);
                stg[orow * 64 + r32] = f2bf(o[0][r] * rl); stg[orow * 64 + 32 + r32] = f2bf(o[1][r] * rl); }
            asm volatile("s_waitcnt lgkmcnt(0)" ::: "memory");
#pragma unroll
            for (int i = 0; i < 4; ++i) { const int row = i * 8 + (lane >> 3), pcs = lane & 7; const u32x4 v = *(const LAS u32x4*)(stg + row * 64 + pcs * 8); const int dd = wsd[row];
                if (dd >= 0) *(u32x4*)(PART + (size_t)dd * 64 + pcs * 8) = v; }
            asm volatile("s_waitcnt lgkmcnt(0)" ::: "memory");
        }
        u = unext;
    }
}
__device__ __forceinline__ void moba_own_phase(LAS unsigned char* lds, const bf16_t* Q, const bf16_t* K, const bf16_t* V, const signed char* SEL, const bf16_t* PART, const float* ML, bf16_t* ATT) {
    const int tid = threadIdx.x, wid = tid >> 6, lane = tid & 63, r32 = lane & 31, hi = lane >> 5;
    LAS float* wsf = (LAS float*)(lds + MB_WS + wid * 1024);
    const int vb0 = (int)(uintptr_t)(lds + MB_V) + ((lane >> 4) & 1) * 32 + (lane & 3) * 8 + (4 * hi + ((lane & 15) >> 2)) * 64;
    KVRegs R;
    if ((int)blockIdx.x < 64 * 32) moba_kv_load(R, K, V, (size_t)((blockIdx.x & 63) >> 3) * SEQ + (size_t)(blockIdx.x >> 6) * 256, blockIdx.x & 7, tid);
    for (int u = blockIdx.x; u < 64 * 32; u += gridDim.x) {
        const int bh = u & 63, n = u >> 6, b = bh >> 3, h = bh & 7;
        __syncthreads();
        moba_kv_store(lds, R, tid);
        __syncthreads();
        { const int un = u + gridDim.x; if (un < 64 * 32) moba_kv_load(R, K, V, (size_t)((un & 63) >> 3) * SEQ + (size_t)(un >> 6) * 256, un & 7, tid); }
        const size_t t0 = (size_t)b * SEQ + (size_t)n * 256 + wid * 32, t = t0 + r32;
        bf16x8 qr[4];
#pragma unroll
        for (int d0 = 0; d0 < 4; ++d0) qr[d0] = *(const bf16x8*)(Q + t * 512 + h * 64 + d0 * 16 + hi * 8);
        float m_reg = 0.f, l_reg = 0.f; f32x16 o[2] = {}; f32x16 negm = {};
        const int ntile = (wid >> 1) + 1, rowa = wid * 32 + r32;
#pragma unroll
        for (int kt = 0; kt < 4; ++kt) { if (kt >= ntile) break;
            f32x16 p0, p1; float alpha; bf16x8 pa0, pa1, pa2, pa3;
            qkt64(p0, p1, lds + MB_K + kt * 8192, qr, negm, r32, hi);
            if (kt == ntile - 1) {
#pragma unroll
                for (int r = 0; r < 16; ++r) { const int ka = 64 * kt + crow(r, hi); if (ka > rowa) p0[r] = -1e30f; if (ka + 32 > rowa) p1[r] = -1e30f; } }
            softmax_tile<false>(p0, p1, m_reg, l_reg, alpha, negm, kt == 0, pa0, pa1, pa2, pa3);
            rescale_o2(o, alpha, wsf, r32, hi);
            pv64_one<0>(o[0], vb0 + kt * 8192, pa0, pa1, pa2, pa3); pv64_one<1>(o[1], vb0 + kt * 8192, pa0, pa1, pa2, pa3);
        }
        u32x4 pr[4][3];
#pragma unroll
        for (int i = 0; i < 4; ++i) { const int row = i * 8 + (lane >> 3), pcs = lane & 7;
#pragma unroll
            for (int q = 0; q < 3; ++q) pr[i][q] = *(const u32x4*)(PART + (((t0 + row) * 8 + h) * 3 + q) * 64 + pcs * 8); }
        const unsigned sv = ((const unsigned*)SEL)[(size_t)(b * 8 + h) * SEQ + n * 256 + wid * 32 + r32];
        float2 mlv[3];
#pragma unroll
        for (int i = 0; i < 3; ++i) mlv[i] = *(const float2*)(ML + ((t * 8 + h) * 3 + i) * 2);
        float mi[3], li[3]; float M = m_reg;
#pragma unroll
        for (int i = 0; i < 3; ++i) { const bool v = ((sv >> (8 * i)) & 0x80u) == 0u; mi[i] = v ? mlv[i].x : -1e30f; li[i] = v ? mlv[i].y : 0.f; M = fmaxf(M, mi[i]); }
        const float wo = __builtin_amdgcn_exp2f(m_reg - M); float L = l_reg * wo; float wi[3];
#pragma unroll
        for (int i = 0; i < 3; ++i) { wi[i] = li[i] * __builtin_amdgcn_exp2f(mi[i] - M); L += wi[i]; }
        const float rL = 1.f / L;
        if (hi == 0) { wsf[32 + r32] = wo * rL; wsf[64 + r32] = wi[0] * rL; wsf[96 + r32] = wi[1] * rL; wsf[128 + r32] = wi[2] * rL; }
        asm volatile("s_waitcnt lgkmcnt(0)" ::: "memory");
        LAS bf16_t* stg = (LAS bf16_t*)(lds + MB_STG + wid * 4096);
#pragma unroll
        for (int r = 0; r < 16; ++r) { const int orow = crow(r, hi); const float a0 = wsf[32 + orow];
            stg[orow * 64 + r32] = f2bf(o[0][r] * a0); stg[orow * 64 + 32 + r32] = f2bf(o[1][r] * a0); }
        asm volatile("s_waitcnt lgkmcnt(0)" ::: "memory");
#pragma unroll
        for (int i = 0; i < 4; ++i) { const int row = i * 8 + (lane >> 3), pcs = lane & 7;
            const u32x4 own = *(const LAS u32x4*)(stg + row * 64 + pcs * 8); const float a1 = wsf[64 + row], a2 = wsf[96 + row], a3 = wsf[128 + row];
            float v[8];
#pragma unroll
            for (int q = 0; q < 4; ++q) { v[2 * q] = __uint_as_float(own[q] << 16); v[2 * q + 1] = __uint_as_float(own[q] & 0xffff0000u); }
#pragma unroll
            for (int q = 0; q < 4; ++q) {
                v[2 * q]     += (a1 != 0.f ? a1 * __uint_as_float(pr[i][0][q] << 16) : 0.f) + (a2 != 0.f ? a2 * __uint_as_float(pr[i][1][q] << 16) : 0.f) + (a3 != 0.f ? a3 * __uint_as_float(pr[i][2][q] << 16) : 0.f);
                v[2 * q + 1] += (a1 != 0.f ? a1 * __uint_as_float(pr[i][0][q] & 0xffff0000u) : 0.f) + (a2 != 0.f ? a2 * __uint_as_float(pr[i][1][q] & 0xffff0000u) : 0.f) + (a3 != 0.f ? a3 * __uint_as_float(pr[i][2][q] & 0xffff0000u) : 0.f); }
            *(u32x4*)(ATT + (t0 + row) * 1024 + h * 64 + pcs * 8) = (u32x4){pk2(v[0], v[1]), pk2(v[2], v[3]), pk2(v[4], v[5]), pk2(v[6], v[7])}; }
        asm volatile("s_waitcnt lgkmcnt(0)" ::: "memory");
    }
    __syncthreads();
}
__device__ __forceinline__ void gmlp_phase(LAS unsigned char* lds, const bf16_t* U, const bf16_t* GV, const bf16_t* WM, const float* ng, const float* bs, bf16_t* ATTGM) {
    const int tid = threadIdx.x, wid = tid >> 6, lane = tid & 63, r32 = lane & 31, hi = lane >> 5;
    const int tb = wid & 3, hf = wid >> 2;
    for (int c = blockIdx.x; c < T_TOK / 128; c += gridDim.x) {
        const size_t t0 = (size_t)c * 128;
        __syncthreads();
        {
            uint4 v[16];
#pragma unroll
            for (int i = 0; i < 16; ++i) v[i] = *(const uint4*)(GV + (t0 + wid * 16 + i) * 512 + lane * 8);
#pragma unroll
            for (int i = 0; i < 16; ++i) { const int sidx = wid * 16 + i;
                float f[8]; f[0] = __uint_as_float(v[i].x << 16); f[1] = __uint_as_float(v[i].x & 0xffff0000u); f[2] = __uint_as_float(v[i].y << 16); f[3] = __uint_as_float(v[i].y & 0xffff0000u);
                f[4] = __uint_as_float(v[i].z << 16); f[5] = __uint_as_float(v[i].z & 0xffff0000u); f[6] = __uint_as_float(v[i].w << 16); f[7] = __uint_as_float(v[i].w & 0xffff0000u);
                float ss = 0.f;
#pragma unroll
                for (int e = 0; e < 8; ++e) ss += f[e] * f[e];
                const float rs = rsqrtf(wave_sum(ss) * (1.f / 512.f) + EPS);
                const u32x4 w = {cvtpk(f[0] * rs, f[1] * rs), cvtpk(f[2] * rs, f[3] * rs), cvtpk(f[4] * rs, f[5] * rs), cvtpk(f[6] * rs, f[7] * rs)};
                *(LAS u32x4*)(lds + (lane >> 4) * 32768 + (sidx >> 6) * 16384 + v_st(sidx & 63, (lane & 15) * 8)) = w; }
        }
        __syncthreads();
#pragma unroll 1
        for (int slab = 0; slab < 4; ++slab) {
            const int g = slab * 2 + hf;
            bf16x8 pa[8];
#pragma unroll
            for (int ks = 0; ks < 8; ++ks) pa[ks] = *(const bf16x8*)(WM + ((size_t)(g * 128 + tb * 32 + r32)) * 128 + ks * 16 + hi * 8);
            f32x16 o[2] = {};
            const int vb = (int)(uintptr_t)lds + slab * 32768 + hf * 1024 + v_rd_base(lane);
            const int c0 = slab * 128 + hf * 64 + r32;
            const float ng0 = ng[c0], ng1 = ng[c0 + 32];
            float bbv[16]; bf16_t u0[16], u1[16];
#pragma unroll
            for (int r = 0; r < 16; ++r) { const int tt = tb * 32 + crow(r, hi); bbv[r] = bs[g * 128 + tt]; const bf16_t* up = U + (t0 + tt) * 512 + c0; u0[r] = up[0]; u1[r] = up[32]; }
#define GSTEP(KS) if ((KS) <= 2 * tb + 1) { \
                const s16x4 l0 = tr_read<((KS) >> 2) * 16384 + v_rd_off(0, (KS) & 3, 0)>(vb), h0 = tr_read<((KS) >> 2) * 16384 + v_rd_off(0, (KS) & 3, 1)>(vb); \
                const s16x4 l1 = tr_read<((KS) >> 2) * 16384 + v_rd_off(1, (KS) & 3, 0)>(vb), h1 = tr_read<((KS) >> 2) * 16384 + v_rd_off(1, (KS) & 3, 1)>(vb); \
                asm volatile("s_waitcnt lgkmcnt(0)" ::: "memory"); SBAR(); \
                o[0] = __builtin_amdgcn_mfma_f32_32x32x16_bf16(pa[KS], ((bf16x8){l0[0], l0[1], l0[2], l0[3], h0[0], h0[1], h0[2], h0[3]}), o[0], 0, 0, 0); \
                o[1] = __builtin_amdgcn_mfma_f32_32x32x16_bf16(pa[KS], ((bf16x8){l1[0], l1[1], l1[2], l1[3], h1[0], h1[1], h1[2], h1[3]}), o[1], 0, 0, 0); }
            GSTEP(0) GSTEP(1) GSTEP(2) GSTEP(3) GSTEP(4) GSTEP(5) GSTEP(6) GSTEP(7)
#undef GSTEP
#pragma unroll
            for (int r = 0; r < 16; ++r) { const int tt = tb * 32 + crow(r, hi); const float bb = bbv[r];
                bf16_t* op = ATTGM + (t0 + tt) * 1024 + 512 + c0;
                op[0] = f2bf(bf2f(u0[r]) * (o[0][r] * ng0 + bb)); op[32] = f2bf(bf2f(u1[r]) * (o[1][r] * ng1 + bb)); }
        }
    }
    __syncthreads();
}
constexpr int XA_K = 0, XA_V = 65536, XA_WS = 131072;
__device__ __forceinline__ void xattn_phase(LAS unsigned char* lds, const bf16_t* XQ, const bf16_t* XKV, bf16_t* XO) {
    const int tid = threadIdx.x, wid = tid >> 6, lane = tid & 63, r32 = lane & 31, hi = lane >> 5;
    LAS float* wsf = (LAS float*)(lds + XA_WS) + wid * 64;
    const int vb0 = (int)(uintptr_t)(lds + XA_V) + v_rd_base(lane);
    int staged = -1;
    for (int u = blockIdx.x; u < 32 * 32; u += gridDim.x) {
        const int bh = u & 31, tile = u >> 5, b = bh >> 2, h = bh & 3;
        if (bh != staged) {
            __syncthreads();
            const int sr = tid >> 4, sc = (tid & 15) * 8;
#pragma unroll
            for (int i = 0; i < 8; ++i) { const int key = i * 32 + sr; const bf16_t* src = XKV + (size_t)(b * NMEM + key) * 1024 + h * 128 + sc;
                const uint4 kv = *(const uint4*)src, vv = *(const uint4*)(src + 512);
                *(LAS u32x4*)(lds + XA_K + (key >> 6) * 16384 + KSWZ(key & 63, sc * 2)) = (u32x4){kv.x, kv.y, kv.z, kv.w};
                *(LAS u32x4*)(lds + XA_V + (key >> 6) * 16384 + v_st(key & 63, sc)) = (u32x4){vv.x, vv.y, vv.z, vv.w}; }
            __syncthreads(); staged = bh;
        }
        const size_t t0 = (size_t)b * SEQ + tile * 256 + wid * 32;
        bf16x8 qr[8];
#pragma unroll
        for (int d0 = 0; d0 < 8; ++d0) qr[d0] = *(const bf16x8*)(XQ + (t0 + r32) * 512 + h * 128 + d0 * 16 + hi * 8);
        float m_reg = 0.f, l_reg = 0.f; f32x16 o[4] = {}; f32x16 negm = {};
#pragma unroll
        for (int kt = 0; kt < 4; ++kt) {
            f32x16 p0, p1; float alpha; bf16x8 pa0, pa1, pa2, pa3;
            qkt128(p0, p1, lds + XA_K + kt * 16384, qr, negm, r32, hi);
            softmax_tile<true>(p0, p1, m_reg, l_reg, alpha, negm, kt == 0, pa0, pa1, pa2, pa3);
            if (__any(alpha < 1.f)) { if (hi == 0) wsf[r32] = alpha; asm volatile("s_waitcnt lgkmcnt(0)" ::: "memory");
#pragma unroll
                for (int r = 0; r < 16; ++r) { const float al = wsf[crow(r, hi)];
#pragma unroll
                    for (int d = 0; d < 4; ++d) o[d][r] *= al; }
                asm volatile("s_waitcnt lgkmcnt(0)" ::: "memory"); }
            const int vb = vb0 + kt * 16384;
            pv_one<0>(o[0], vb, pa0, pa1, pa2, pa3); pv_one<1>(o[1], vb, pa0, pa1, pa2, pa3); pv_one<2>(o[2], vb, pa0, pa1, pa2, pa3); pv_one<3>(o[3], vb, pa0, pa1, pa2, pa3);
        }
        if (hi == 0) wsf[32 + r32] = l_reg; asm volatile("s_waitcnt lgkmcnt(0)" ::: "memory");
#pragma unroll
        for (int r = 0; r < 16; ++r) { const int orow = crow(r, hi); const float rl = __builtin_amdgcn_rcpf(wsf[32 + orow]);
            bf16_t* op = XO + (t0 + orow) * 512 + h * 128 + r32;
#pragma unroll
            for (int d0 = 0; d0 < 4; ++d0) op[d0 * 32] = f2bf(o[d0][r] * rl); }
        asm volatile("s_waitcnt lgkmcnt(0)" ::: "memory");
    }
    __syncthreads();
}
}

namespace peer {
typedef unsigned u32x4 __attribute__((ext_vector_type(4)));
typedef short bf16x8 __attribute__((ext_vector_type(8)));
typedef float f32x16 __attribute__((ext_vector_type(16)));
typedef float f32x4 __attribute__((ext_vector_type(4)));
typedef __bf16 bf16x2 __attribute__((ext_vector_type(2)));
#define KSWZ(row, colB) ((row) * 256 + ((colB) ^ (((row) & 7) << 4)))
__device__ __forceinline__ int crow(int r, int hi) { return (r & 3) + 8 * (r >> 2) + 4 * hi; }
__device__ __forceinline__ unsigned ord_key(float f) { const unsigned b = __float_as_uint(f); return b ^ ((unsigned)((int)b >> 31) | 0x80000000u); }
__device__ __forceinline__ float ord_inv(unsigned o) { return __uint_as_float(o ^ ((unsigned)((int)(~o) >> 31) | 0x80000000u)); }
__device__ __forceinline__ unsigned selu(unsigned m, unsigned a, unsigned b) { return (a & m) | (b & ~m); }
__device__ __forceinline__ unsigned umax_(unsigned a, unsigned b) { return (int)a > (int)b ? a : b; }
__device__ __forceinline__ unsigned umin_(unsigned a, unsigned b) { return (int)a < (int)b ? a : b; }
template <int OFF, int A, int B> __device__ __forceinline__ void ce_desc(unsigned (&k)[64]) { const unsigned a = k[OFF + A], b = k[OFF + B]; k[OFF + A] = umax_(a, b); k[OFF + B] = umin_(a, b); }
template <int OFF> __device__ __forceinline__ void sort16_desc(unsigned (&k)[64]) {
#define CE(a, b) ce_desc<OFF, a, b>(k);
    CE(0,13) CE(1,12) CE(2,15) CE(3,14) CE(4,8) CE(5,6) CE(7,11) CE(9,10)
    CE(0,5) CE(1,7) CE(2,9) CE(3,4) CE(6,13) CE(8,14) CE(10,15) CE(11,12)
    CE(0,1) CE(2,3) CE(4,5) CE(6,8) CE(7,9) CE(10,11) CE(12,13) CE(14,15)
    CE(0,2) CE(1,3) CE(4,10) CE(5,11) CE(6,7) CE(8,9) CE(12,14) CE(13,15)
    CE(1,2) CE(3,12) CE(4,6) CE(5,7) CE(8,10) CE(9,11) CE(13,14)
    CE(1,4) CE(2,6) CE(5,8) CE(7,10) CE(9,13) CE(11,14)
    CE(2,4) CE(3,6) CE(9,12) CE(11,13)
    CE(3,5) CE(6,8) CE(7,9) CE(10,12)
    CE(3,4) CE(5,6) CE(7,8) CE(9,10) CE(11,12)
    CE(6,7) CE(8,9)
#undef CE
}
template <int OFF> __device__ __forceinline__ void merge16_desc(unsigned (&k)[64]) {
#pragma unroll
    for (int stride = 8; stride > 0; stride >>= 1)
#pragma unroll
        for (int i = 0; i < 16; ++i) { const int j = i ^ stride; if (j > i) { const unsigned a = k[OFF + i], b = k[OFF + j]; k[OFF + i] = umax_(a, b); k[OFF + j] = umin_(a, b); } }
}
template <int A, int B> __device__ __forceinline__ void top16_merge(unsigned (&k)[64]) {
#pragma unroll
    for (int i = 0; i < 16; ++i) k[A + i] = umax_(k[A + i], k[B + 15 - i]);
    merge16_desc<A>(k);
}
__device__ __forceinline__ void top16_of_64(unsigned (&k)[64]) {
    sort16_desc<0>(k); sort16_desc<16>(k); sort16_desc<32>(k); sort16_desc<48>(k);
    top16_merge<0, 16>(k); top16_merge<32, 48>(k); top16_merge<0, 32>(k);
}
__device__ __forceinline__ void top16_of_cand(unsigned (&k)[64]) {
    sort16_desc<0>(k); sort16_desc<16>(k); sort16_desc<32>(k); ce_desc<48, 0, 1>(k);
    top16_merge<0, 16>(k);
    k[46] = umax_(k[46], k[49]); k[47] = umax_(k[47], k[48]); merge16_desc<32>(k);
#pragma unroll
    for (int i = 0; i < 16; ++i) k[i] = umax_(k[i], k[32 + 15 - i]);
}
__device__ __forceinline__ void partner_merge(unsigned (&k)[64], int hi) {
    unsigned pr[16];
#pragma unroll
    for (int i = 0; i < 16; ++i) { const unsigned t = k[15 - i]; auto rr = __builtin_amdgcn_permlane32_swap(t, t, false, false); pr[i] = selu(0u - (unsigned)hi, rr[0], rr[1]); }
#pragma unroll
    for (int i = 0; i < 16; ++i) k[i] = umax_(k[i], pr[i]);
    merge16_desc<0>(k);
}
constexpr int cand_slot(int i, int j) { int n = 0; for (int a = 0; a < 16; ++a) for (int b = 0; b < 16; ++b) { if (a == i && b == j) return n; if ((a + 1) * (b + 1) <= 16) ++n; } return n; }
static_assert(cand_slot(15, 0) == 49, "50 candidates");
constexpr float TK_BIAS = 48.f;
__device__ __forceinline__ unsigned pos_key(float biased) { return __float_as_uint(biased); }
constexpr int TK_LDS_SK = 0, TK_LDS_IDX = 65536, TK_LDS_BYTES = 65536 + 8 * 32 * 32;
__device__ __forceinline__ void sk_tile(f32x16& p0, f32x16& p1, const LAS unsigned char* Ks, const bf16x8* qr, int r32, int hi) {
    p0 = f32x16{}; p1 = f32x16{};
#pragma unroll
    for (int d0 = 0; d0 < 8; ++d0) { const int cb = (d0 * 16 + hi * 8) * 2;
        const bf16x8 b0 = *(const LAS bf16x8*)(Ks + KSWZ(r32, cb)); const bf16x8 b1 = *(const LAS bf16x8*)(Ks + KSWZ(32 + r32, cb));
        p0 = __builtin_amdgcn_mfma_f32_32x32x16_bf16(b0, qr[d0], p0, 0, 0, 0); p1 = __builtin_amdgcn_mfma_f32_32x32x16_bf16(b1, qr[d0], p1, 0, 0, 0); }
}
__device__ __forceinline__ void topk_loadq(bf16x8 (&qa)[8], bf16x8 (&qb)[8], const bf16_t* QP, int t, int h, int hi) {
#pragma unroll
    for (int d0 = 0; d0 < 8; ++d0) { qa[d0] = *(const bf16x8*)(QP + (size_t)t * 2048 + h * 256 + d0 * 16 + hi * 8); qb[d0] = *(const bf16x8*)(QP + (size_t)t * 2048 + h * 256 + 128 + d0 * 16 + hi * 8); }
}
__device__ __forceinline__ void topk_half(unsigned (&top)[16], const LAS unsigned char* lds, const bf16x8 (&qr)[8], int p, int r32, int hi) {
    unsigned k[64];
#pragma unroll
    for (int tl = 0; tl < 2; ++tl) { f32x16 p0, p1; sk_tile(p0, p1, lds + TK_LDS_SK + (p * 2 + tl) * 16384, qr, r32, hi); p0 = p0 + TK_BIAS; p1 = p1 + TK_BIAS;
#pragma unroll
        for (int r = 0; r < 16; ++r) { k[tl * 32 + r] = (pos_key(p0[r]) & ~0x7Fu) | (unsigned)(tl * 64 + crow(r, hi)); k[tl * 32 + 16 + r] = (pos_key(p1[r]) & ~0x7Fu) | (unsigned)(tl * 64 + 32 + crow(r, hi)); } }
    top16_of_64(k); partner_merge(k, hi);
#pragma unroll
    for (int i = 0; i < 16; ++i) top[i] = k[i];
}
__device__ __forceinline__ void topk_phase(LAS unsigned char* lds, const bf16_t* QP, const bf16_t* SK, unsigned short* PID, float* PW) {
    const int tid = threadIdx.x, lane = tid & 63, wid = tid >> 6, r32 = lane & 31, hi = lane >> 5;
    LAS unsigned char* idxl = lds + TK_LDS_IDX + wid * 1024 + r32 * 32;
    int staged_h = -1;
    bf16x8 qa[8], qb[8];
    if ((int)blockIdx.x < 8 * 256) topk_loadq(qa, qb, QP, (int)(blockIdx.x >> 3) * 256 + wid * 32 + r32, blockIdx.x & 7, hi);
    for (int u = blockIdx.x; u < 8 * 256; u += gridDim.x) {
        const int h = u & 7, tile = u >> 3;
        if (h != staged_h) {
            __syncthreads();
            for (int pc = tid; pc < 4096; pc += 512) { const int row = pc >> 4, ch = pc & 15;
                const uint4 v = *(const uint4*)(SK + ((size_t)h * 256 + row) * 128 + ch * 8);
                *(LAS u32x4*)(lds + TK_LDS_SK + (row >> 6) * 16384 + KSWZ(row & 63, ch * 16)) = (u32x4){v.x, v.y, v.z, v.w}; }
            __syncthreads(); staged_h = h;
        }
        const int t = tile * 256 + wid * 32 + r32;
        const unsigned hm = 0u - (unsigned)hi;
        unsigned top0[16], top1[16];
        topk_half(top0, lds, qa, 0, r32, hi);
        topk_half(top1, lds, qb, 1, r32, hi);
        { const int un = (u + (int)gridDim.x < 8 * 256) ? u + (int)gridDim.x : u; topk_loadq(qa, qb, QP, (un >> 3) * 256 + wid * 32 + r32, un & 7, hi); }
        { unsigned w[4];
#pragma unroll
          for (int q = 0; q < 4; ++q) { const unsigned a0 = selu(hm, top1[4 * q], top0[4 * q]), a1 = selu(hm, top1[4 * q + 1], top0[4 * q + 1]), a2 = selu(hm, top1[4 * q + 2], top0[4 * q + 2]), a3 = selu(hm, top1[4 * q + 3], top0[4 * q + 3]);
              w[q] = (a0 & 0x7Fu) | ((a1 & 0x7Fu) << 8) | ((a2 & 0x7Fu) << 16) | ((a3 & 0x7Fu) << 24); }
          *(LAS u32x4*)(idxl + hi * 16) = (u32x4){w[0], w[1], w[2], w[3]}; }
        float f1[16], f2[16];
#pragma unroll
        for (int i = 0; i < 16; ++i) { f1[i] = __uint_as_float(top0[i] & ~0x7Fu); f2[i] = __uint_as_float(top1[i] & ~0x7Fu) - TK_BIAS; }
        unsigned k[64];
#pragma unroll
        for (int i = 0; i < 16; ++i)
#pragma unroll
            for (int j = 0; j < 16; ++j) if ((i + 1) * (j + 1) <= 16) k[cand_slot(i, j)] = (pos_key(f1[i] + f2[j]) & ~0xFFu) | (unsigned)(i * 16 + j);
        top16_of_cand(k);
        float sv[16], den = 0.f; const float s0 = __uint_as_float(k[0] & ~0xFFu);
#pragma unroll
        for (int i = 0; i < 16; ++i) { sv[i] = __expf(__uint_as_float(k[i] & ~0xFFu) - s0); den += sv[i]; }
        const float rden = 1.f / den;
        asm volatile("s_waitcnt lgkmcnt(0)" ::: "memory");
        int ids[8]; float ws_[8];
#pragma unroll
        for (int i = 0; i < 8; ++i) { const unsigned kk = selu(hm, k[8 + i], k[i]); const int ci = (kk >> 4) & 15, cj = kk & 15;
            const int i1 = *(const LAS unsigned char*)(idxl + ci), i2 = *(const LAS unsigned char*)(idxl + 16 + cj);
            ids[i] = i1 * 128 + i2; ws_[i] = __uint_as_float(selu(hm, __float_as_uint(sv[8 + i]), __float_as_uint(sv[i]))) * rden; }
        unsigned short* po = PID + ((size_t)t * 8 + h) * 16 + hi * 8; float* pw = PW + ((size_t)t * 8 + h) * 16 + hi * 8;
        *(uint4*)po = make_uint4((unsigned)ids[0] | ((unsigned)ids[1] << 16), (unsigned)ids[2] | ((unsigned)ids[3] << 16), (unsigned)ids[4] | ((unsigned)ids[5] << 16), (unsigned)ids[6] | ((unsigned)ids[7] << 16));
        *(float4*)pw = make_float4(ws_[0], ws_[1], ws_[2], ws_[3]); *(float4*)(pw + 4) = make_float4(ws_[4], ws_[5], ws_[6], ws_[7]);
        asm volatile("s_waitcnt lgkmcnt(0)" ::: "memory");
    }
    __syncthreads();
}

typedef float f32x2 __attribute__((ext_vector_type(2)));
template <int CTRL> __device__ __forceinline__ float dpp_f(float v) { return __builtin_bit_cast(float, __builtin_amdgcn_update_dpp(0, __builtin_bit_cast(int, v), CTRL, 0xf, 0xf, true)); }
__device__ __forceinline__ unsigned xcc_id() { return (unsigned)__builtin_amdgcn_s_getreg((3 << 11) | 20) & 7u; }
__device__ __forceinline__ float swapadd32(float a, float b) { auto rr = __builtin_amdgcn_permlane32_swap(__float_as_uint(a), __float_as_uint(b), false, false); return __uint_as_float(rr[0]) + __uint_as_float(rr[1]); }
__device__ __forceinline__ float swapadd16(float a, float b) { auto rr = __builtin_amdgcn_permlane16_swap(__float_as_uint(a), __float_as_uint(b), false, false); return __uint_as_float(rr[0]) + __uint_as_float(rr[1]); }
__device__ __forceinline__ void fp8x16_to_f32(const uint4 r, float (&f)[16]) {
    const unsigned w[4] = {r.x, r.y, r.z, r.w};
#pragma unroll
    for (int q = 0; q < 4; ++q) { const f32x2 lo = __builtin_amdgcn_cvt_pk_f32_fp8((int)w[q], false), hi = __builtin_amdgcn_cvt_pk_f32_fp8((int)w[q], true); f[4 * q] = lo.x; f[4 * q + 1] = lo.y; f[4 * q + 2] = hi.x; f[4 * q + 3] = hi.y; }
}
constexpr int PEER_ITEM_TOK = 64, PEER_NITEM = T_TOK / PEER_ITEM_TOK;
struct DnIn { unsigned idp; uint4 xa, xb; };
__device__ __forceinline__ void dn_s1(DnIn& I, const unsigned short* PID, const bf16_t* XB, size_t t, int slice, int lane, int l8) {
    I.idp = ((const unsigned*)PID)[t * 64 + lane];
    I.xa = *(const uint4*)(XB + t * 1024 + slice * 128 + l8 * 16); I.xb = *(const uint4*)(XB + t * 1024 + slice * 128 + l8 * 16 + 8);
}
template <int CTRL> __device__ __forceinline__ int dpp_i(int v) { return __builtin_amdgcn_update_dpp(0, v, CTRL, 0xf, 0xf, true); }
__device__ __forceinline__ void dn_quantx(unsigned (&xq)[4], float& sx, const DnIn& I) {
    const unsigned xw[8] = {I.xa.x, I.xa.y, I.xa.z, I.xa.w, I.xb.x, I.xb.y, I.xb.z, I.xb.w};
    float xf[16]; float am = 0.f;
#pragma unroll
    for (int q = 0; q < 8; ++q) { xf[2 * q] = __uint_as_float(xw[q] << 16); xf[2 * q + 1] = __uint_as_float(xw[q] & 0xffff0000u); am = fmaxf(am, fmaxf(fabsf(xf[2 * q]), fabsf(xf[2 * q + 1]))); }
    am = fmaxf(am, dpp_f<0xB1>(am)); am = fmaxf(am, dpp_f<0x4E>(am)); am = fmaxf(am, dpp_f<0x141>(am));
    const float inv = am > 0.f ? 127.f / am : 0.f; sx = am * (1.f / 127.f);
#pragma unroll
    for (int q = 0; q < 4; ++q) xq[q] = ((unsigned)__float2int_rn(xf[4 * q] * inv) & 0xffu) | (((unsigned)__float2int_rn(xf[4 * q + 1] * inv) & 0xffu) << 8) | (((unsigned)__float2int_rn(xf[4 * q + 2] * inv) & 0xffu) << 16) | ((unsigned)__float2int_rn(xf[4 * q + 3] * inv) << 24);
}
__device__ __forceinline__ void pe_s2(uint4 (&W)[16], unsigned idp, const unsigned char* wslice, unsigned loff, int g8) {
#pragma unroll
    for (int i = 0; i < 8; ++i) { const unsigned p0 = (unsigned)__shfl((int)idp, 4 * g8 + (i >> 1)), p1 = (unsigned)__shfl((int)idp, 32 + 4 * g8 + (i >> 1));
        const unsigned e0 = (i & 1) ? (p0 >> 16) : (p0 & 0xffffu), e1 = (i & 1) ? (p1 >> 16) : (p1 & 0xffffu);
        W[i] = *(const uint4*)(wslice + ((e0 << 7) + loff)); W[8 + i] = *(const uint4*)(wslice + ((e1 << 7) + loff)); }
}
__device__ __forceinline__ int reduce8x8(const int (&v)[8], bool b2, bool b1, bool b0) {
    int n[4], m[2];
#pragma unroll
    for (int j = 0; j < 4; ++j) n[j] = (b2 ? v[4 + j] : v[j]) + dpp_i<0x141>(b2 ? v[j] : v[4 + j]);
#pragma unroll
    for (int j = 0; j < 2; ++j) m[j] = (b1 ? n[2 + j] : n[j]) + dpp_i<0x4E>(b1 ? n[j] : n[2 + j]);
    return (b0 ? m[1] : m[0]) + dpp_i<0xB1>(b0 ? m[0] : m[1]);
}
__device__ __forceinline__ void dn_s3(const uint4 (&W)[16], const unsigned (&xq)[4], float sx, bf16_t* po, int lane, int l8) {
    const bool b2 = (l8 >> 2) & 1, b1 = (l8 >> 1) & 1, b0 = l8 & 1;
    int d[16];
#pragma unroll
    for (int i = 0; i < 16; ++i) { int a = __builtin_amdgcn_sdot4((int)W[i].x, (int)xq[0], 0, false); a = __builtin_amdgcn_sdot4((int)W[i].y, (int)xq[1], a, false);
        a = __builtin_amdgcn_sdot4((int)W[i].z, (int)xq[2], a, false); d[i] = __builtin_amdgcn_sdot4((int)W[i].w, (int)xq[3], a, false); }
    const int lo[8] = {d[0], d[1], d[2], d[3], d[4], d[5], d[6], d[7]}, hi[8] = {d[8], d[9], d[10], d[11], d[12], d[13], d[14], d[15]};
    const float r0 = (float)reduce8x8(lo, b2, b1, b0) * sx, r1 = (float)reduce8x8(hi, b2, b1, b0) * sx;
    const float n0 = dpp_f<0xB1>(r0), n1 = dpp_f<0xB1>(r1);
    if (!(lane & 1)) { ((unsigned*)po)[lane >> 1] = pk2(r0, n0); ((unsigned*)po)[32 + (lane >> 1)] = pk2(r1, n1); }
}
__device__ __forceinline__ void down_phase(const bf16_t* XB, const unsigned char* WDq, const unsigned short* PID, bf16_t* PARTD, unsigned* qctr) {
    const int lane = threadIdx.x & 63, g8 = lane >> 3, l8 = lane & 7;
    const unsigned xcc = xcc_id();
    for (int st = 0; st < 8; ++st) { const int slice = (int)((xcc + st) & 7u);
        const unsigned char* wslice = WDq + (size_t)slice * (16384 * 128); const unsigned loff = (unsigned)l8 * 16u;
        for (;;) { unsigned it_ = 0; if (lane == 0) it_ = __hip_atomic_fetch_add(qctr + slice * 64, 1u, __ATOMIC_RELAXED, __HIP_MEMORY_SCOPE_AGENT);
            const int item = (int)__builtin_amdgcn_readfirstlane(it_); if (item >= PEER_NITEM) break;
            const size_t t0 = (size_t)item * PEER_ITEM_TOK; bf16_t* pbase = PARTD + ((size_t)slice * T_TOK + t0) * 128;
            DnIn IA, IB; uint4 WA[16], WB[16]; unsigned xq[4]; float sx;
            dn_s1(IA, PID, XB, t0, slice, lane, l8); dn_s1(IB, PID, XB, t0 + 1, slice, lane, l8);
            pe_s2(WA, IA.idp, wslice, loff, g8);
#pragma unroll 1
            for (int k = 0; k < PEER_ITEM_TOK; k += 2) {
                const int k2 = (k + 2 < PEER_ITEM_TOK) ? k + 2 : PEER_ITEM_TOK - 1, k3 = (k + 3 < PEER_ITEM_TOK) ? k + 3 : PEER_ITEM_TOK - 1;
                dn_quantx(xq, sx, IA); dn_s1(IA, PID, XB, t0 + k2, slice, lane, l8); pe_s2(WB, IB.idp, wslice, loff, g8);
                dn_s3(WA, xq, sx, pbase + (size_t)k * 128, lane, l8);
                dn_quantx(xq, sx, IB); dn_s1(IB, PID, XB, t0 + k3, slice, lane, l8); pe_s2(WA, IA.idp, wslice, loff, g8);
                dn_s3(WB, xq, sx, pbase + (size_t)(k + 1) * 128, lane, l8);
            }
        }
    }
}
template <int B>
__device__ __forceinline__ void coef_batch(const bf16_t* __restrict__ PARTD, const float* __restrict__ SS, const LAS float* SD, const LAS float* SU, const unsigned short* __restrict__ PID, const float* __restrict__ PW, bf16_t* __restrict__ COEF,
                                           size_t tq0, size_t tstride, int sub, int j8) {
    u32x4 pv[B][8], e[B]; f32x4 sq[B], pw[B][2];
#pragma unroll
    for (int u = 0; u < B; ++u) { const size_t t = (tq0 + u * tstride) * 4 + sub;
        e[u] = *(const u32x4*)(PID + t * 128 + j8); pw[u][0] = *(const f32x4*)(PW + t * 128 + j8); pw[u][1] = *(const f32x4*)(PW + t * 128 + j8 + 4);
        sq[u] = *(const f32x4*)(SS + t * 16 + (j8 & 24) / 2);
#pragma unroll
        for (int x = 0; x < 8; ++x) pv[u][x] = *(const u32x4*)(PARTD + ((size_t)x * T_TOK + t) * 128 + j8); }
    float sd[B][8], su[B][8];
#pragma unroll
    for (int u = 0; u < B; ++u)
#pragma unroll
        for (int q = 0; q < 4; ++q) { const unsigned ea = e[u][q] & 0xffffu, eb = e[u][q] >> 16; sd[u][2 * q] = SD[ea]; sd[u][2 * q + 1] = SD[eb]; su[u][2 * q] = SU[ea]; su[u][2 * q + 1] = SU[eb]; }
#pragma unroll
    for (int u = 0; u < B; ++u) { const size_t t = (tq0 + u * tstride) * 4 + sub;
        float d[8];
#pragma unroll
        for (int q = 0; q < 8; ++q) d[q] = 0.f;
#pragma unroll
        for (int x = 0; x < 8; ++x)
#pragma unroll
            for (int q = 0; q < 4; ++q) { d[2 * q] += __uint_as_float(pv[u][x][q] << 16); d[2 * q + 1] += __uint_as_float(pv[u][x][q] & 0xffff0000u); }
        float ssum = (sq[u][0] + sq[u][1]) + (sq[u][2] + sq[u][3]); ssum += dpp_f<0xB1>(ssum); ssum += dpp_f<0x4E>(ssum);
        const float rstd = rsqrtf(ssum * (1.f / DM) + EPS);
        float o[8];
#pragma unroll
        for (int q = 0; q < 8; ++q) o[q] = pw[u][q >> 2][q & 3] * su[u][q] * gelu_tanh(d[q] * rstd * sd[u][q]);
        *(u32x4*)(COEF + t * 128 + j8) = (u32x4){pk2(o[0], o[1]), pk2(o[2], o[3]), pk2(o[4], o[5]), pk2(o[6], o[7])}; }
}
__device__ __forceinline__ void coef_phase(LAS unsigned char* lds, const bf16_t* __restrict__ PARTD, const float* __restrict__ SS, const float* __restrict__ SDg, const float* __restrict__ SUg, const unsigned short* __restrict__ PID, const float* __restrict__ PW, bf16_t* __restrict__ COEF) {
    const int lane = threadIdx.x & 63, wid = threadIdx.x >> 6, sub = lane >> 4, j8 = (lane & 15) * 8;
    LAS float* SD = (LAS float*)lds; LAS float* SU = SD + 16384;
    __syncthreads();
    for (int i = threadIdx.x; i < 16384 / 4; i += 512) { ((LAS f32x4*)SD)[i] = ((const f32x4*)SDg)[i]; ((LAS f32x4*)SU)[i] = ((const f32x4*)SUg)[i]; }
    __syncthreads();
    const size_t gw = blockIdx.x * 8 + wid, NGW = gridDim.x * 8;
    size_t tq = gw;
    for (; tq + 1 * NGW < T_TOK / 4; tq += 2 * NGW) coef_batch<2>(PARTD, SS, SD, SU, PID, PW, COEF, tq, NGW, sub, j8);
    for (; tq < T_TOK / 4; tq += NGW) coef_batch<1>(PARTD, SS, SD, SU, PID, PW, COEF, tq, NGW, sub, j8);
}
struct UpIn { unsigned idp, cfp, x2; };
__device__ __forceinline__ void up_s1(UpIn& I, const unsigned short* PID, const bf16_t* COEF, const bf16_t* xin, size_t t, int slice, int lane, int c0) {
    I.idp = ((const unsigned*)PID)[t * 64 + lane]; I.cfp = ((const unsigned*)COEF)[t * 64 + lane];
    I.x2 = *(const unsigned*)(xin + t * 1024 + slice * 128 + c0);
}
__device__ __forceinline__ void up_s3(const uint4 (&W)[16], unsigned cfp, unsigned x2, bf16_t* orow, float* ss3, int lane, int g8) {
    f32x2 ac2[8];
#pragma unroll
    for (int q = 0; q < 8; ++q) ac2[q] = (f32x2){0.f, 0.f};
#pragma unroll
    for (int i = 0; i < 16; ++i) { const unsigned cp = (unsigned)__shfl((int)cfp, (i < 8 ? 0 : 32) + 4 * g8 + ((i & 7) >> 1)); const float c = (i & 1) ? __uint_as_float(cp & 0xffff0000u) : __uint_as_float(cp << 16); const f32x2 c2 = {c, c}; const unsigned w[4] = {W[i].x, W[i].y, W[i].z, W[i].w};
#pragma unroll
        for (int q = 0; q < 4; ++q) { ac2[2 * q] = __builtin_elementwise_fma(__builtin_amdgcn_cvt_pk_f32_fp8((int)w[q], false), c2, ac2[2 * q]); ac2[2 * q + 1] = __builtin_elementwise_fma(__builtin_amdgcn_cvt_pk_f32_fp8((int)w[q], true), c2, ac2[2 * q + 1]); } }
    float acc[16];
#pragma unroll
    for (int q = 0; q < 8; ++q) { acc[2 * q] = ac2[q].x; acc[2 * q + 1] = ac2[q].y; }
    float a8[8], a4[4];
#pragma unroll
    for (int q = 0; q < 8; ++q) a8[q] = swapadd32(acc[q], acc[q + 8]);
#pragma unroll
    for (int q = 0; q < 4; ++q) a4[q] = swapadd16(a8[q], a8[q + 4]);
    const bool b3 = (lane >> 3) & 1;
    const float y0 = (b3 ? a4[2] : a4[0]) + dpp_f<0x128>(b3 ? a4[0] : a4[2]);
    const float y1 = (b3 ? a4[3] : a4[1]) + dpp_f<0x128>(b3 ? a4[1] : a4[3]);
    const float o0 = __uint_as_float(x2 << 16) + y0, o1 = __uint_as_float(x2 & 0xffff0000u) + y1;
    *(unsigned*)orow = pk2(o0, o1);
    const float ss = wave_sum(o0 * o0 + o1 * o1);
    if (lane == 0) *ss3 = ss;
}
__device__ __forceinline__ void up_phase(const unsigned char* WUq, const unsigned short* PID, const bf16_t* COEF, const bf16_t* xin, bf16_t* xout, float* SS3, unsigned* qctr) {
    const int lane = threadIdx.x & 63, g8 = lane >> 3, l8 = lane & 7;
    const int c0 = 16 * l8 + 8 * ((lane >> 5) & 1) + 4 * ((lane >> 4) & 1) + 2 * ((lane >> 3) & 1);
    const unsigned xcc = xcc_id();
    for (int st = 0; st < 8; ++st) { const int slice = (int)((xcc + st) & 7u);
        const unsigned char* wslice = WUq + (size_t)slice * (16384 * 128); const unsigned loff = (unsigned)l8 * 16u;
        for (;;) { unsigned it_ = 0; if (lane == 0) it_ = __hip_atomic_fetch_add(qctr + slice * 64, 1u, __ATOMIC_RELAXED, __HIP_MEMORY_SCOPE_AGENT);
            const int item = (int)__builtin_amdgcn_readfirstlane(it_); if (item >= PEER_NITEM) break;
            const size_t t0 = (size_t)item * PEER_ITEM_TOK;
            UpIn IA, IB; uint4 WA[16], WB[16];
            up_s1(IA, PID, COEF, xin, t0, slice, lane, c0); up_s1(IB, PID, COEF, xin, t0 + 1, slice, lane, c0);
            pe_s2(WA, IA.idp, wslice, loff, g8);
#pragma unroll 1
            for (int k = 0; k < PEER_ITEM_TOK; k += 2) {
                const int k2 = (k + 2 < PEER_ITEM_TOK) ? k + 2 : PEER_ITEM_TOK - 1, k3 = (k + 3 < PEER_ITEM_TOK) ? k + 3 : PEER_ITEM_TOK - 1;
                { const unsigned cp_ = IA.cfp; const unsigned xx = IA.x2;
                  up_s1(IA, PID, COEF, xin, t0 + k2, slice, lane, c0); pe_s2(WB, IB.idp, wslice, loff, g8);
                  up_s3(WA, cp_, xx, xout + (t0 + k) * 1024 + slice * 128 + c0, SS3 + (t0 + k) * 8 + slice, lane, g8); }
                { const unsigned cp_ = IB.cfp; const unsigned xx = IB.x2;
                  up_s1(IB, PID, COEF, xin, t0 + k3, slice, lane, c0); pe_s2(WA, IA.idp, wslice, loff, g8);
                  up_s3(WB, cp_, xx, xout + (t0 + k + 1) * 1024 + slice * 128 + c0, SS3 + (t0 + k + 1) * 8 + slice, lane, g8); }
            }
        }
    }
}
template <int B>
__device__ __forceinline__ void final_batch(const bf16_t* __restrict__ xin, const float* __restrict__ SS3, const float* __restrict__ fg, float* __restrict__ out, size_t t0, size_t tstride, int lane) {
    u32x4 v[B][2]; f32x4 sq[B][2];
#pragma unroll
    for (int u = 0; u < B; ++u) { const size_t t = t0 + u * tstride; sq[u][0] = *(const f32x4*)(SS3 + t * 8); sq[u][1] = *(const f32x4*)(SS3 + t * 8 + 4);
        v[u][0] = *(const u32x4*)(xin + t * 1024 + lane * 8); v[u][1] = *(const u32x4*)(xin + t * 1024 + 512 + lane * 8); }
    const f32x4 g00 = *(const f32x4*)(fg + lane * 8), g01 = *(const f32x4*)(fg + lane * 8 + 4), g10 = *(const f32x4*)(fg + 512 + lane * 8), g11 = *(const f32x4*)(fg + 516 + lane * 8);
#pragma unroll
    for (int u = 0; u < B; ++u) { const size_t t = t0 + u * tstride; const f32x4 s4 = sq[u][0] + sq[u][1];
        const float r2 = rsqrtf(((s4[0] + s4[1]) + (s4[2] + s4[3])) * (1.f / DM) + EPS);
#pragma unroll
        for (int q = 0; q < 2; ++q) { const u32x4 w = v[u][q]; const f32x4 ga = q ? g10 : g00, gb = q ? g11 : g01; float* op = out + t * 1024 + q * 512 + lane * 8;
            const f32x4 o0 = {__uint_as_float(w.x << 16) * r2 * ga[0], __uint_as_float(w.x & 0xffff0000u) * r2 * ga[1], __uint_as_float(w.y << 16) * r2 * ga[2], __uint_as_float(w.y & 0xffff0000u) * r2 * ga[3]};
            const f32x4 o1 = {__uint_as_float(w.z << 16) * r2 * gb[0], __uint_as_float(w.z & 0xffff0000u) * r2 * gb[1], __uint_as_float(w.w << 16) * r2 * gb[2], __uint_as_float(w.w & 0xffff0000u) * r2 * gb[3]};
            *(f32x4*)op = o0; *(f32x4*)(op + 4) = o1; } }
}
__device__ __forceinline__ void final_phase(const bf16_t* __restrict__ xin, const float* __restrict__ SS3, const float* __restrict__ fg, float* __restrict__ out) {
    const int lane = threadIdx.x & 63, wid = threadIdx.x >> 6;
    const size_t gw = blockIdx.x * 8 + wid, NGW = gridDim.x * 8;
    size_t t = gw;
    for (; t + 7 * NGW < T_TOK; t += 8 * NGW) final_batch<8>(xin, SS3, fg, out, t, NGW, lane);
    for (; t < T_TOK; t += NGW) final_batch<1>(xin, SS3, fg, out, t, NGW, lane);
}
#undef KSWZ
}


#define XB_TMO      128
#define XB_XCNT(j)  (256  + 64 * (j))
#define XB_XSUB(j)  (1280 + 64 * (j))
#define XB_XGEN(j)  (2304 + 64 * (j))
#define XB_TOP      3328
#define XB_TOPGEN   3392
#define XCD_BAR_WORDS 3456
#define XB_SPIN_CAP (1u << 22)
__device__ __forceinline__ unsigned xb_ld(unsigned* p)              { return __hip_atomic_load(p, __ATOMIC_RELAXED, __HIP_MEMORY_SCOPE_AGENT); }
__device__ __forceinline__ unsigned xb_add(unsigned* p, unsigned v) { return __hip_atomic_fetch_add(p, v, __ATOMIC_RELAXED, __HIP_MEMORY_SCOPE_AGENT); }
__device__ __forceinline__ unsigned xb_xcc_id() { return (unsigned)__builtin_amdgcn_s_getreg((3 << 11) | 20) & 0xFu; }
#define XB_SPIN(cond, bar) do { unsigned _sp = 0; while (cond) { __builtin_amdgcn_s_sleep(1); \
    if ((++_sp & 255u) == 0u) { if (xb_ld(&(bar)[XB_TMO])) break; if (_sp > XB_SPIN_CAP) { atomicAdd(&(bar)[XB_TMO], 1u); break; } } } } while (0)
struct XcdBarrier { unsigned* bar; unsigned x; volatile LAS unsigned* st; };
__device__ __forceinline__ XcdBarrier xcd_barrier_post(unsigned* bar, volatile LAS unsigned* st) {
    XcdBarrier b; b.bar = bar; b.x = xb_xcc_id(); b.st = st;
    if (threadIdx.x == 0) (void)xb_add(&bar[XB_XCNT(b.x)], 1u);
    return b;
}
__device__ __forceinline__ void xcd_barrier_complete(unsigned* bar, unsigned x, unsigned& nloc, unsigned& nx) {
    const unsigned G = gridDim.x * gridDim.y * gridDim.z;
    unsigned sum, cnt, mine, sp = 0u;
    for (;;) {
        sum = 0u; cnt = 0u; mine = 0u;
#pragma unroll
        for (unsigned j = 0; j < 16; ++j) { const unsigned c = xb_ld(&bar[XB_XCNT(j)]); sum += c; cnt += (c > 0u) ? 1u : 0u; mine = (j == x) ? c : mine; }
        if (sum == G) break;
        __builtin_amdgcn_s_sleep(1);
        if ((++sp & 255u) == 0u) { if (xb_ld(&bar[XB_TMO])) break; if (sp > XB_SPIN_CAP) { atomicAdd(&bar[XB_TMO], 1u); break; } }
    }
    nloc = mine > 0u ? mine : 1u; nx = cnt > 0u ? cnt : 1u;
}
__device__ __forceinline__ void xcd_barrier(const XcdBarrier& b) {
    asm volatile("s_waitcnt vmcnt(0)" ::: "memory");
    __syncthreads();
    if (threadIdx.x == 0) {
        unsigned* bar = b.bar;
        __builtin_amdgcn_s_waitcnt(0);
        unsigned nloc = b.st[0], nx = b.st[1];
        if (nloc == 0u) { xcd_barrier_complete(bar, b.x, nloc, nx); b.st[0] = nloc; b.st[1] = nx; }
        const unsigned old = xb_add(&bar[XB_XSUB(b.x)], 1u);
        const unsigned gen = old / nloc;
        if (old + 1u == (gen + 1u) * nloc) {
            __builtin_amdgcn_fence(__ATOMIC_RELEASE, "agent");
            asm volatile("s_waitcnt vmcnt(0)" ::: "memory");
            const unsigned og = xb_add(&bar[XB_TOP], 1u);
            const unsigned tg = og / nx;
            if (og + 1u == (tg + 1u) * nx) xb_add(&bar[XB_TOPGEN], 1u);
            else XB_SPIN(xb_ld(&bar[XB_TOPGEN]) == tg, bar);
            __builtin_amdgcn_fence(__ATOMIC_ACQUIRE, "agent");
            xb_add(&bar[XB_XGEN(b.x)], 1u);
            asm volatile("s_waitcnt vmcnt(0)" ::: "memory");
        } else {
            XB_SPIN(xb_ld(&bar[XB_XGEN(b.x)]) == gen, bar);
            __builtin_amdgcn_fence(__ATOMIC_ACQUIRE, "agent");
            asm volatile("s_waitcnt vmcnt(0)" ::: "memory");
        }
    }
    __syncthreads();
}

constexpr int NTHREADS = 512;
constexpr int LDS_BYTES = 147456;
constexpr int NPHASE = 16;

__global__ void __launch_bounds__(NTHREADS, 2) mega_fwd(Args a) {
    extern __shared__ __attribute__((aligned(16))) unsigned char lds_raw[];
    LAS unsigned char* lds = (LAS unsigned char*)lds_raw;
    cg::grid_group grid = cg::this_grid();
    const int lo = a.ph_lo, hi = a.ph_hi;
    volatile LAS unsigned* bst = (volatile LAS unsigned*)(lds + LDS_BYTES - 64);
    if (threadIdx.x < 2) bst[threadIdx.x] = 0u;
    __syncthreads();
    const XcdBarrier xbar = xcd_barrier_post((unsigned*)(a.ws + WS_CTL) + 16384 + a.li * 4096, bst);
#define IN(k) (lo <= (k) && (k) < hi)
#define SEAM(k) do { if (IN(k) && IN((k) + 1)) { if ((k) == 0) grid.sync(); else xcd_barrier(xbar); } } while (0)
#ifndef DUP_MASK
#define DUP_MASK 0u
#endif
#define REPS(k) for (int rep = 0, nrep = ((DUP_MASK >> (k)) & 1u) ? 2 : 1; rep < nrep; ++rep, (rep < nrep ? grid.sync() : (void)0))
    unsigned char* ws = a.ws;
#define BFP(off) ((bf16_t*)(ws + (off)))
#define FPP(off) ((float*)(ws + (off)))
    const int G = gridDim.x, cu = blockIdx.x;
    if (IN(0)) REPS(0) { p0_prologue(a, lds); }
    SEAM(0);
    if (IN(1)) REPS(1) {
        { pg8::Gemm g{BFP(WS_XN), BFP(WS_WIN_T), 1024, 1024, 1024}; pg8::StaticOrder S; S.init(T_TOK, IN_COLS, G, cu);
          pg8::EpiInProj E{BFP(WS_Q), BFP(WS_K), BFP(WS_V), BFP(WS_U), BFP(WS_GV), BFP(WS_GA), BFP(WS_GB), FPP(WS_KMP), (const float2*)(ws + WS_ROPE)};
          pg8::gemm_phase(lds, g, S, E); }
    }
    SEAM(1);
    if (IN(2)) REPS(2) { att::sel_phase(BFP(WS_Q), FPP(WS_KMP), (signed char*)(ws + WS_SEL));
                 att::gmlp_phase(lds, BFP(WS_U), BFP(WS_GV), BFP(WS_WM), a.in[5], a.in[7], BFP(WS_ATTGM)); }
    SEAM(2);
    if (IN(3)) REPS(3) {
        { pg8::Gemm g{BFP(WS_MN), BFP(WS_XAKV_T), 1024, 1024, 1024}; pg8::StaticOrder S; S.init(NB * NMEM, 1024, G, cu);
          pg8::EpiPlain E{BFP(WS_XKV), 1024};
          pg8::gemm_phase(lds, g, S, E); }
      att::moba_sel_phase(lds, BFP(WS_Q), BFP(WS_K), BFP(WS_V), (const signed char*)(ws + WS_SEL), BFP(WS_PART), FPP(WS_ML), (unsigned*)(ws + WS_CTL) + a.li * 8192 + 64 + rep); }
    SEAM(3);
    if (IN(4)) REPS(4) att::moba_own_phase(lds, BFP(WS_Q), BFP(WS_K), BFP(WS_V), (const signed char*)(ws + WS_SEL), BFP(WS_PART), FPP(WS_ML), BFP(WS_ATTGM));
    SEAM(4);
    if (IN(5)) REPS(5) {
        pg8::Gemm g{BFP(WS_ATTGM), BFP(WS_WAB_T), 1024, 1024, 1024}; pg8::StaticOrder S; S.init(T_TOK, 1024, G, cu);
        pg8::EpiMergedFused E{BFP(WS_GA), BFP(WS_GB), BFP(WS_MERGED)};
        pg8::gemm_phase<pg8::EpiMergedFused, pg8::StaticOrder, true>(lds, g, S, E);
    }
    SEAM(5);
    if (IN(6)) REPS(6) {
        pg8::Gemm g{BFP(WS_MERGED), BFP(WS_WOUT_T), 1024, 1024, 1024}; pg8::StaticOrder S; S.init(T_TOK, 1024, G, cu);
        pg8::EpiResid<false> E{a.in[0], BFP(WS_XB), FPP(WS_SS1)};
        pg8::gemm_phase(lds, g, S, E);
    }
    SEAM(6);
    if (IN(7)) REPS(7) {
        pg8::Gemm g{BFP(WS_XB), BFP(WS_XAQ_T), 1024, 1024, 1024}; pg8::StaticOrder S; S.init(T_TOK, 512, G, cu);
        pg8::EpiRowScale E{BFP(WS_XQ), 512, FPP(WS_SS1), C2X};
        pg8::gemm_phase(lds, g, S, E);
    }
    SEAM(7);
    if (IN(8)) REPS(8) att::xattn_phase(lds, BFP(WS_XQ), BFP(WS_XKV), BFP(WS_XO));
    SEAM(8);
    if (IN(9)) REPS(9) {
        pg8::Gemm g{BFP(WS_XO), BFP(WS_XAO_T), 512, 512, 512}; pg8::StaticOrder S; S.init(T_TOK, 1024, G, cu);
        pg8::EpiResid<true> E{nullptr, BFP(WS_XB), FPP(WS_SS2)};
        pg8::gemm_phase(lds, g, S, E);
    }
    SEAM(9);
    if (IN(10)) REPS(10) {
        pg8::Gemm g{BFP(WS_XB), BFP(WS_PQ_T), 1024, 1024, 1024}; pg8::StaticOrder S; S.init(T_TOK, 2048, G, cu);
        pg8::EpiRowScale E{BFP(WS_QP), 2048, FPP(WS_SS2), 1.f};
        pg8::gemm_phase(lds, g, S, E);
    }
    SEAM(10);
    if (IN(11)) REPS(11) peer::topk_phase(lds, BFP(WS_QP), BFP(WS_SK), (unsigned short*)(ws + WS_PID), FPP(WS_PW));
    SEAM(11);
    if (IN(12)) REPS(12) peer::down_phase(BFP(WS_XB), ws + WS_WD, (const unsigned short*)(ws + WS_PID), BFP(WS_PARTD), (unsigned*)(ws + WS_CTL) + a.li * 8192 + 1024 + rep * 512);
    SEAM(12);
    if (IN(13)) REPS(13) peer::coef_phase(lds, BFP(WS_PARTD), FPP(WS_SS2), FPP(WS_SD), FPP(WS_SU), (const unsigned short*)(ws + WS_PID), FPP(WS_PW), BFP(WS_COEF));
    SEAM(13);
    if (IN(14)) REPS(14) peer::up_phase(ws + WS_WU, (const unsigned short*)(ws + WS_PID), BFP(WS_COEF), BFP(WS_XB), (rep + 1 < nrep) ? BFP(WS_RD) : BFP(WS_XB), FPP(WS_SS3), (unsigned*)(ws + WS_CTL) + a.li * 8192 + 2048 + rep * 512);
    SEAM(14);
    if (IN(15)) REPS(15) peer::final_phase(BFP(WS_XB), FPP(WS_SS3), a.in[20], a.out);
#undef BFP
#undef FPP
#undef IN
#undef SEAM
}

__global__ void __launch_bounds__(256) nv_inproj_rope(const bf16_t* XN, const float* W, const float2* rope, bf16_t* Q, bf16_t* K) {
    const int r0 = blockIdx.x * 8, which = blockIdx.y, p = threadIdx.x, head = p >> 5, i = p & 31;
    const int c1 = which * 512 + head * 64 + i, c2 = c1 + 32;
    float a1[8], a2[8];
#pragma unroll
    for (int j = 0; j < 8; ++j) { a1[j] = 0.f; a2[j] = 0.f; }
    for (int k = 0; k < 1024; ++k) { const float w1 = W[(size_t)k * IN_COLS + c1], w2 = W[(size_t)k * IN_COLS + c2];
#pragma unroll
        for (int j = 0; j < 8; ++j) { const float x = bf2f(XN[(size_t)(r0 + j) * 1024 + k]); a1[j] += x * w1; a2[j] += x * w2; } }
    bf16_t* O = which ? K : Q; const float sc = which ? 1.f : C2M;
#pragma unroll
    for (int j = 0; j < 8; ++j) { const int r = r0 + j, pos = r & (SEQ - 1); const float2 cs = rope[pos * 32 + i];
        const float o1 = a1[j] * cs.x - a2[j] * cs.y, o2 = a2[j] * cs.x + a1[j] * cs.y;
        *(unsigned*)(O + (size_t)r * 512 + head * 64 + 2 * i) = pk2(o1 * sc, o2 * sc); }
}
__global__ void __launch_bounds__(256) nv_inproj_rest(const bf16_t* XN, const float* W, bf16_t* V, bf16_t* U, bf16_t* GV, bf16_t* GA, bf16_t* GB) {
    const int r0 = blockIdx.x * 8, n = 1024 + blockIdx.y * 256 + threadIdx.x;
    float acc[8];
#pragma unroll
    for (int j = 0; j < 8; ++j) acc[j] = 0.f;
    for (int k = 0; k < 1024; ++k) { const float w = W[(size_t)k * IN_COLS + n];
#pragma unroll
        for (int j = 0; j < 8; ++j) acc[j] += bf2f(XN[(size_t)(r0 + j) * 1024 + k]) * w; }
#pragma unroll
    for (int j = 0; j < 8; ++j) { const size_t r = r0 + j; const float v = acc[j];
        if (n < 1536) V[r * 512 + (n - 1024)] = f2bf(v);
        else if (n < 2048) U[r * 512 + (n - 1536)] = f2bf(gelu_tanh(v));
        else if (n < 2560) GV[r * 512 + (n - 2048)] = f2bf(gelu_tanh(v));
        else if (n < 3584) GA[r * 1024 + (n - 2560)] = f2bf(sigmoidf(v));
        else GB[r * 1024 + (n - 3584)] = f2bf(sigmoidf(v)); }
}
__global__ void __launch_bounds__(512) nv_kmean(const bf16_t* K, float* KMP) {
    const int blk = blockIdx.x, c = threadIdx.x; float s = 0.f;
    for (int r = 0; r < 256; ++r) s += bf2f(K[(size_t)(blk * 256 + r) * 512 + c]);
    KMP[(size_t)blk * 1024 + c] = s; KMP[(size_t)blk * 1024 + 512 + c] = 0.f;
}
template <int MODE>
__global__ void __launch_bounds__(256) nv_gemm(const bf16_t* A, int lda, const float* W, int ldw, int K, const float* kscale, bf16_t* O, int ldo, const float* SS, float cscale, float* res) {
    const int r0 = blockIdx.x * 8, n = blockIdx.y * 256 + threadIdx.x;
    float acc[8];
#pragma unroll
    for (int j = 0; j < 8; ++j) acc[j] = 0.f;
    for (int k = 0; k < K; ++k) { const float w = W[(size_t)k * ldw + n] * (kscale ? kscale[k] : 1.f);
#pragma unroll
        for (int j = 0; j < 8; ++j) acc[j] += bf2f(A[(size_t)(r0 + j) * lda + k]) * w; }
#pragma unroll
    for (int j = 0; j < 8; ++j) { const size_t r = r0 + j; float v = acc[j];
        if (MODE == 0) { float rs = 1.f; if (SS) { float s = 0.f; for (int q = 0; q < 16; ++q) s += SS[r * 16 + q]; rs = rsqrtf(s * (1.f / DM) + EPS); } O[r * ldo + n] = f2bf(v * rs * cscale); }
        else { const float x = res[r * ldo + n] + v; res[r * ldo + n] = x; O[r * ldo + n] = f2bf(x); } }
}
__global__ void __launch_bounds__(256) nv_wout(const bf16_t* A, const float* W, const float* x, float* out, bf16_t* XB) {
    const int r0 = blockIdx.x * 8, n = blockIdx.y * 256 + threadIdx.x;
    float acc[8];
#pragma unroll
    for (int j = 0; j < 8; ++j) acc[j] = 0.f;
    for (int k = 0; k < 1024; ++k) { const float w = W[(size_t)k * 1024 + n];
#pragma unroll
        for (int j = 0; j < 8; ++j) acc[j] += bf2f(A[(size_t)(r0 + j) * 1024 + k]) * w; }
#pragma unroll
    for (int j = 0; j < 8; ++j) { const size_t r = r0 + j; const float v = x[r * 1024 + n] + acc[j]; out[r * 1024 + n] = v; XB[r * 1024 + n] = f2bf(v); }
}
__global__ void __launch_bounds__(256) nv_merged(const bf16_t* AG, const float* Wa, const float* Wb, const bf16_t* GA, const bf16_t* GB, bf16_t* MG) {
    const int r0 = blockIdx.x * 8, n = blockIdx.y * 256 + threadIdx.x;
    float ya[8], yb[8];
#pragma unroll
    for (int j = 0; j < 8; ++j) { ya[j] = 0.f; yb[j] = 0.f; }
    for (int k = 0; k < 512; ++k) { const float wa = Wa[(size_t)k * 1024 + n], wb = Wb[(size_t)k * 1024 + n];
#pragma unroll
        for (int j = 0; j < 8; ++j) { ya[j] += bf2f(AG[(size_t)(r0 + j) * 1024 + k]) * wa; yb[j] += bf2f(AG[(size_t)(r0 + j) * 1024 + 512 + k]) * wb; } }
#pragma unroll
    for (int j = 0; j < 8; ++j) { const size_t r = r0 + j; MG[r * 1024 + n] = f2bf(bf2f(GA[r * 1024 + n]) * ya[j] + bf2f(GB[r * 1024 + n]) * yb[j]); }
}
__global__ void __launch_bounds__(256) nv_rowss(const float* X, float* SS) {
    const int lane = threadIdx.x & 63, row = blockIdx.x * 4 + (threadIdx.x >> 6); float s = 0.f;
    for (int j = 0; j < 16; ++j) { const float v = X[(size_t)row * 1024 + j * 64 + lane]; s += v * v; }
    s = wave_sum(s);
    if (lane < 16) SS[(size_t)row * 16 + lane] = lane == 0 ? s : 0.f;
}
__global__ void __launch_bounds__(256) nv_sel(const bf16_t* Q, const float* KMP, signed char* SEL) {
    const int idx = blockIdx.x * 256 + threadIdx.x, t = idx >> 3, h = idx & 7, b = t / SEQ, qb = (t % SEQ) / 256;
    float bv[3] = {-3e38f, -3e38f, -3e38f}; int bi[3] = {-1, -1, -1};
    for (int n = 0; n < qb; ++n) { float g = 0.f; const float* km = KMP + (size_t)(b * 32 + n) * 1024 + h * 64;
        for (int j = 0; j < 64; ++j) g += bf2f(Q[(size_t)t * 512 + h * 64 + j]) * (km[j] + km[512 + j]);
        if (g > bv[0]) { bv[2] = bv[1]; bi[2] = bi[1]; bv[1] = bv[0]; bi[1] = bi[0]; bv[0] = g; bi[0] = n; }
        else if (g > bv[1]) { bv[2] = bv[1]; bi[2] = bi[1]; bv[1] = g; bi[1] = n; }
        else if (g > bv[2]) { bv[2] = g; bi[2] = n; } }
    char4 o; o.x = (signed char)bi[0]; o.y = (signed char)bi[1]; o.z = (signed char)bi[2]; o.w = -1;
    ((char4*)SEL)[(size_t)(b * 8 + h) * SEQ + (t % SEQ)] = o;
}
__global__ void __launch_bounds__(256) nv_moba(const bf16_t* Q, const bf16_t* K, const bf16_t* V, const signed char* SEL, bf16_t* ATTGM) {
    const int lane = threadIdx.x & 63, idx = blockIdx.x * 4 + (threadIdx.x >> 6), t = idx >> 3, h = idx & 7, b = t / SEQ, pos = t % SEQ, qb = pos / 256;
    const float q = bf2f(Q[(size_t)t * 512 + h * 64 + lane]);
    float m = -3e38f, l = 0.f, o = 0.f;
    for (int s = 0; s < 4; ++s) {
        int n, cnt;
        if (s < 3) { n = SEL[((size_t)(b * 8 + h) * SEQ + pos) * 4 + s]; if (n < 0) continue; cnt = 256; } else { n = qb; cnt = pos - qb * 256 + 1; }
        const size_t base = (size_t)b * SEQ + (size_t)n * 256;
        for (int j = 0; j < cnt; ++j) {
            const float sc = wave_sum(q * bf2f(K[(base + j) * 512 + h * 64 + lane]));
            const float mn = fmaxf(m, sc), al = exp2f(m - mn), p = exp2f(sc - mn);
            l = l * al + p; o = o * al + p * bf2f(V[(base + j) * 512 + h * 64 + lane]); m = mn; } }
    ATTGM[(size_t)t * 1024 + h * 64 + lane] = f2bf(o / l);
}
__global__ void __launch_bounds__(256) nv_gvstat(const bf16_t* GV, float* RS) {
    const int lane = threadIdx.x & 63, row = blockIdx.x * 4 + (threadIdx.x >> 6); float s = 0.f;
    for (int j = 0; j < 8; ++j) { const float v = bf2f(GV[(size_t)row * 512 + j * 64 + lane]); s += v * v; }
    s = wave_sum(s);
    if (lane == 0) RS[row] = rsqrtf(s * (1.f / 512.f) + EPS);
}
__global__ void __launch_bounds__(256) nv_gmlp(const bf16_t* U, const bf16_t* GV, const float* RS, const float* ng, const float* w_s, const float* b_s, bf16_t* ATTGM) {
    const size_t idx = (size_t)blockIdx.x * 256 + threadIdx.x; const int t = (int)(idx >> 9), c = (int)(idx & 511), g = c >> 6, tt = t & 127, t0 = t - tt;
    float z = 0.f;
    for (int s = 0; s <= tt; ++s) z += w_s[((size_t)g * 128 + tt) * 128 + s] * (bf2f(GV[(size_t)(t0 + s) * 512 + c]) * RS[t0 + s] * ng[c]);
    z += b_s[g * 128 + tt];
    ATTGM[(size_t)t * 1024 + 512 + c] = f2bf(bf2f(U[(size_t)t * 512 + c]) * z);
}
__global__ void __launch_bounds__(256) nv_xattn(const bf16_t* XQ, const bf16_t* XKV, bf16_t* XO) {
    const int lane = threadIdx.x & 63, idx = blockIdx.x * 4 + (threadIdx.x >> 6), t = idx >> 2, h = idx & 3, b = t / SEQ;
    const float q0 = bf2f(XQ[(size_t)t * 512 + h * 128 + lane]), q1 = bf2f(XQ[(size_t)t * 512 + h * 128 + 64 + lane]);
    float m = -3e38f, l = 0.f, o0 = 0.f, o1 = 0.f;
    for (int j = 0; j < NMEM; ++j) { const bf16_t* kr = XKV + (size_t)(b * NMEM + j) * 1024 + h * 128;
        const float sc = wave_sum(q0 * bf2f(kr[lane]) + q1 * bf2f(kr[64 + lane]));
        const float mn = fmaxf(m, sc), al = exp2f(m - mn), p = exp2f(sc - mn);
        l = l * al + p; o0 = o0 * al + p * bf2f(kr[512 + lane]); o1 = o1 * al + p * bf2f(kr[512 + 64 + lane]); m = mn; }
    XO[(size_t)t * 512 + h * 128 + lane] = f2bf(o0 / l); XO[(size_t)t * 512 + h * 128 + 64 + lane] = f2bf(o1 / l);
}
__device__ __forceinline__ void wave_argmax(float v, int i, float& bv, int& bi) {
#pragma unroll
    for (int o = 1; o < 64; o <<= 1) { const float ov = __shfl_xor(v, o); const int oi = __shfl_xor(i, o); if (ov > v || (ov == v && oi < i)) { v = ov; i = oi; } }
    bv = v; bi = i;
}
__global__ void __launch_bounds__(256) nv_peer_topk(const bf16_t* QP, const float* SK, int* PID, float* PW) {
    __shared__ float sv[4][2][16]; __shared__ int si[4][2][16];
    const int lane = threadIdx.x & 63, w = threadIdx.x >> 6, idx = blockIdx.x * 4 + w, t = idx >> 3, h = idx & 7;
    for (int p = 0; p < 2; ++p) {
        const bf16_t* q = QP + (size_t)t * 2048 + h * 256 + p * 128; const float* k0 = SK + ((size_t)(h * 2 + p) * 128 + lane) * 128; const float* k1 = k0 + 64 * 128;
        float s0 = 0.f, s1 = 0.f;
        for (int d = 0; d < 128; ++d) { const float qq = bf2f(q[d]); s0 += qq * k0[d]; s1 += qq * k1[d]; }
        for (int r = 0; r < 16; ++r) { float v; int i; if (s0 >= s1) { v = s0; i = lane; } else { v = s1; i = lane + 64; }
            float bv; int bi; wave_argmax(v, i, bv, bi);
            if (bi == lane) s0 = -3e38f; if (bi == lane + 64) s1 = -3e38f;
            if (lane == 0) { sv[w][p][r] = bv; si[w][p][r] = bi; } }
    }
    __syncthreads();
    float c[4]; int ci[4];
#pragma unroll
    for (int j = 0; j < 4; ++j) { const int pos = lane * 4 + j, i1 = pos >> 4, i2 = pos & 15; c[j] = sv[w][0][i1] + sv[w][1][i2]; ci[j] = pos; }
    float mykeep = 0.f; int myid = 0;
    float top0 = 0.f, denom = 0.f;
    for (int r = 0; r < 16; ++r) { float v = c[0]; int i = ci[0];
#pragma unroll
        for (int j = 1; j < 4; ++j) if (c[j] > v) { v = c[j]; i = ci[j]; }
        float bv; int bi; wave_argmax(v, i, bv, bi);
#pragma unroll
        for (int j = 0; j < 4; ++j) if (ci[j] == bi) c[j] = -3e38f;
        if (r == 0) top0 = bv;
        const float e = __expf(bv - top0); denom += e;
        if (lane == r) { mykeep = e; myid = si[w][0][bi >> 4] * 128 + si[w][1][bi & 15]; } }
    if (lane < 16) { PID[(size_t)idx * 16 + lane] = myid; PW[(size_t)idx * 16 + lane] = mykeep / denom; }
}
__global__ void __launch_bounds__(256) nv_peer_ffn(const bf16_t* XB, const float* SS, const float* gffn, const float* WDn, const float* WUp, const int* PID, const float* PW, const float* fg, float* out) {
    __shared__ float coef[128]; __shared__ int eid[128]; __shared__ float red[4];
    const int t = blockIdx.x, tid = threadIdx.x, lane = tid & 63, w = tid >> 6;
    float s = 0.f; for (int q = 0; q < 16; ++q) s += SS[(size_t)t * 16 + q]; const float rstd = rsqrtf(s * (1.f / DM) + EPS);
    float xh[16];
#pragma unroll
    for (int j = 0; j < 16; ++j) xh[j] = bf2f(XB[(size_t)t * 1024 + j * 64 + lane]) * gffn[j * 64 + lane];
    for (int jj = 0; jj < 32; ++jj) { const int j = w * 32 + jj; const int e = PID[(size_t)t * 128 + j]; const float* wd = WDn + (size_t)e * 1024; float d = 0.f;
#pragma unroll
        for (int q = 0; q < 16; ++q) d += xh[q] * wd[q * 64 + lane];
        d = wave_sum(d) * rstd;
        if (lane == 0) { coef[j] = PW[(size_t)t * 128 + j] * gelu_tanh(d); eid[j] = e; } }
    __syncthreads();
    float y[4] = {0.f, 0.f, 0.f, 0.f};
    for (int j = 0; j < 128; ++j) { const float cf = coef[j]; const float4 u = *(const float4*)(WUp + (size_t)eid[j] * 1024 + tid * 4); y[0] += cf * u.x; y[1] += cf * u.y; y[2] += cf * u.z; y[3] += cf * u.w; }
    const float4 x2 = *(const float4*)(out + (size_t)t * 1024 + tid * 4);
    y[0] += x2.x; y[1] += x2.y; y[2] += x2.z; y[3] += x2.w;
    float ss = wave_sum(y[0] * y[0] + y[1] * y[1] + y[2] * y[2] + y[3] * y[3]);
    if (lane == 0) red[w] = ss;
    __syncthreads();
    const float r2 = rsqrtf((red[0] + red[1] + red[2] + red[3]) * (1.f / DM) + EPS);
    const float4 g = *(const float4*)(fg + tid * 4);
    *(float4*)(out + (size_t)t * 1024 + tid * 4) = make_float4(y[0] * r2 * g.x, y[1] * r2 * g.y, y[2] * r2 * g.z, y[3] * r2 * g.w);
}

#ifndef OPT_MASK
#define OPT_MASK 0xFFFFu
#endif

static void launch_mega(const Args& a0, int lo, int hi, int grid, hipStream_t stream, int li = 0) {
    Args a = a0; a.ph_lo = lo; a.ph_hi = hi; a.li = li;
    void* args[] = {&a};
    hipError_t e = hipLaunchCooperativeKernel((void*)mega_fwd, dim3(grid), dim3(NTHREADS), args, LDS_BYTES, stream);
    if (e != hipSuccess) fprintf(stderr, "cooperative launch failed: %s (grid %d)\n", hipGetErrorString(e), grid);
}

extern "C" void kernel_launch(void* const* d_in, const int* in_sizes, int n_in, void* d_out, int out_size, void* d_ws, size_t ws_size, hipStream_t stream) {
    static int grid = 0;
    if (grid == 0) {
        int dev = 0, cus = 0, per_cu = 0;
        (void)hipGetDevice(&dev);
        (void)hipDeviceGetAttribute(&cus, hipDeviceAttributeMultiprocessorCount, dev);
        (void)hipFuncSetAttribute((const void*)mega_fwd, hipFuncAttributeMaxDynamicSharedMemorySize, LDS_BYTES);
        (void)hipOccupancyMaxActiveBlocksPerMultiprocessor(&per_cu, (const void*)mega_fwd, NTHREADS, LDS_BYTES);
        if (n_in != 21 || ws_size < WS_END || out_size != T_TOK * DM || per_cu < 1) { fprintf(stderr, "kernel_launch: bad config n_in %d ws %zu out %d per_cu %d\n", n_in, ws_size, out_size, per_cu); grid = -1; return; }
        grid = cus;
    }
    if (grid < 0) return;
    (void)hipMemsetAsync((char*)d_ws + WS_CTL, 0, CTL_BYTES, stream);
    Args a{};
    for (int i = 0; i < 21; ++i) a.in[i] = (const float*)d_in[i];
    a.out = (float*)d_out; a.ws = (unsigned char*)d_ws;
    unsigned char* ws = (unsigned char*)d_ws;
    const unsigned mask = OPT_MASK;
#ifndef PROBE_LO
#define PROBE_LO 0
#define PROBE_HI 0
#endif
    if (PROBE_HI >= PROBE_LO && PROBE_HI > 0) { launch_mega(a, 0, PROBE_HI, grid, stream, 0); launch_mega(a, PROBE_LO, NPHASE, grid, stream, 1); return; }
    if (mask == (1u << NPHASE) - 1u) { launch_mega(a, 0, NPHASE, grid, stream); return; }
#define BF(off) ((bf16_t*)(ws + (off)))
#define FP(off) ((float*)(ws + (off)))
    for (int ph = 0; ph < NPHASE; ++ph) {
        if (mask & (1u << ph)) { int hi = ph + 1; while (hi < NPHASE && (mask & (1u << hi))) ++hi; launch_mega(a, ph, hi, grid, stream); ph = hi - 1; continue; }
        switch (ph) {
        case 1:
            nv_inproj_rope<<<dim3(T_TOK / 8, 2), 256, 0, stream>>>(BF(WS_XN), a.in[3], (const float2*)(ws + WS_ROPE), BF(WS_Q), BF(WS_K));
            nv_inproj_rest<<<dim3(T_TOK / 8, 14), 256, 0, stream>>>(BF(WS_XN), a.in[3], BF(WS_V), BF(WS_U), BF(WS_GV), BF(WS_GA), BF(WS_GB));
            nv_kmean<<<256, 512, 0, stream>>>(BF(WS_K), FP(WS_KMP));
            nv_gemm<0><<<dim3(NB * NMEM / 8, 4), 256, 0, stream>>>(BF(WS_MN), 1024, a.in[13], 1024, 1024, nullptr, BF(WS_XKV), 1024, nullptr, 1.f, nullptr);
            break;
        case 2:
            nv_sel<<<T_TOK * 8 / 256, 256, 0, stream>>>(BF(WS_Q), FP(WS_KMP), (signed char*)(ws + WS_SEL));
            nv_gvstat<<<T_TOK / 4, 256, 0, stream>>>(BF(WS_GV), FP(WS_RS));
            nv_gmlp<<<T_TOK * 512 / 256, 256, 0, stream>>>(BF(WS_U), BF(WS_GV), FP(WS_RS), a.in[5], a.in[6], a.in[7], BF(WS_ATTGM));
            break;
        case 3:
            break;
        case 4:
            nv_moba<<<T_TOK * 8 / 4, 256, 0, stream>>>(BF(WS_Q), BF(WS_K), BF(WS_V), (const signed char*)(ws + WS_SEL), BF(WS_ATTGM));
            break;
        case 5:
            nv_merged<<<dim3(T_TOK / 8, 4), 256, 0, stream>>>(BF(WS_ATTGM), a.in[4], a.in[8], BF(WS_GA), BF(WS_GB), BF(WS_MERGED));
            break;
        case 6:
            nv_wout<<<dim3(T_TOK / 8, 4), 256, 0, stream>>>(BF(WS_MERGED), a.in[9], a.in[0], a.out, BF(WS_XB));
            nv_rowss<<<T_TOK / 4, 256, 0, stream>>>(a.out, FP(WS_SS1));
            break;
        case 7:
            nv_gemm<0><<<dim3(T_TOK / 8, 2), 256, 0, stream>>>(BF(WS_XB), 1024, a.in[12], 512, 1024, a.in[10], BF(WS_XQ), 512, FP(WS_SS1), C2X, nullptr);
            break;
        case 8:
            nv_xattn<<<T_TOK * 4 / 4, 256, 0, stream>>>(BF(WS_XQ), BF(WS_XKV), BF(WS_XO));
            break;
        case 9:
            nv_gemm<1><<<dim3(T_TOK / 8, 4), 256, 0, stream>>>(BF(WS_XO), 512, a.in[14], 1024, 512, nullptr, BF(WS_XB), 1024, nullptr, 1.f, a.out);
            nv_rowss<<<T_TOK / 4, 256, 0, stream>>>(a.out, FP(WS_SS2));
            break;
        case 10:
            nv_gemm<0><<<dim3(T_TOK / 8, 8), 256, 0, stream>>>(BF(WS_XB), 1024, a.in[16], 2048, 1024, a.in[15], BF(WS_QP), 2048, FP(WS_SS2), 1.f, nullptr);
            break;
        case 11:
            nv_peer_topk<<<T_TOK * 8 / 4, 256, 0, stream>>>(BF(WS_QP), a.in[17], (int*)(ws + WS_PID), FP(WS_PW));
            break;
        case 12:
            nv_peer_ffn<<<T_TOK, 256, 0, stream>>>(BF(WS_XB), FP(WS_SS2), a.in[15], a.in[18], a.in[19], (const int*)(ws + WS_PID), FP(WS_PW), a.in[20], a.out);
            break;
        default: break;
        }
    }
#undef BF
#undef FP
}
```

```cpp
#include <hip/hip_runtime.h>
#include <hip/hip_cooperative_groups.h>
#include <cstdio>
#include <cstdint>
namespace cg = cooperative_groups;

constexpr int T_TOK = 65536, DM = 1024, NB = 8, SEQ = 8192, NMEM = 256;
constexpr int IN_COLS = 4608;
constexpr float EPS = 1e-6f;
constexpr float LOG2E = 1.4426950408889634f;
constexpr float C2M = 0.125f * LOG2E;
constexpr float C2X = 0.08838834764831845f * LOG2E;

typedef unsigned short bf16_t;
#define LAS __attribute__((address_space(3)))

constexpr size_t MiB = 1u << 20;
constexpr size_t WS_CTL = 0, CTL_BYTES = 1 * MiB;
constexpr size_t WS_ROPE = 1 * MiB;
constexpr size_t WS_WIN_T = 3 * MiB;
constexpr size_t WS_WAB_T = 12 * MiB;
constexpr size_t WS_WOUT_T = 14 * MiB;
constexpr size_t WS_XAQ_T = 16 * MiB;
constexpr size_t WS_XAKV_T = 17 * MiB;
constexpr size_t WS_XAO_T = 19 * MiB;
constexpr size_t WS_PQ_T = 20 * MiB;
constexpr size_t WS_SK = 24 * MiB;
constexpr size_t WS_WM = 24 * MiB + 512 * 1024;
constexpr size_t WS_MN = 25 * MiB;
constexpr size_t WS_XKV = 29 * MiB;
constexpr size_t WS_KMP = 33 * MiB;
constexpr size_t WS_SS1 = 34 * MiB;
constexpr size_t WS_SS2 = 38 * MiB;
constexpr size_t WS_SEL = 42 * MiB;
constexpr size_t WS_WD = 44 * MiB;
constexpr size_t WS_SD = 60 * MiB;
constexpr size_t WS_SU = 61 * MiB;
constexpr size_t WS_WU = 76 * MiB;
constexpr size_t WS_SS3 = 92 * MiB;
constexpr size_t WS_RS0 = 96 * MiB;
constexpr size_t WS_RA = 108 * MiB;
constexpr size_t WS_XN = WS_RA, WS_PART = WS_RA, WS_ML = WS_RA + 192 * MiB, WS_MERGED = WS_RA;
constexpr size_t WS_RB = 316 * MiB;
constexpr size_t WS_Q = WS_RB, WS_K = WS_RB + 64 * MiB, WS_V = WS_RB + 128 * MiB, WS_XB = WS_RB, WS_XQ = WS_V;
constexpr size_t WS_RC = 508 * MiB;
constexpr size_t WS_U = WS_RC, WS_GV = WS_RC + 64 * MiB, WS_XO = WS_U, WS_PID = WS_GV, WS_PW = WS_GV + 32 * MiB;
constexpr size_t WS_RD = 636 * MiB;
constexpr size_t WS_GA = WS_RD, WS_GB = WS_RD + 128 * MiB, WS_QP = WS_RD;
constexpr size_t WS_RE = 892 * MiB;
constexpr size_t WS_ATTGM = WS_RE, WS_COEF = WS_RE;
constexpr size_t WS_PARTD = WS_RD;
constexpr size_t WS_END = 1020 * MiB;
constexpr size_t WS_RS = WS_SS2;

__device__ __forceinline__ float bf2f(bf16_t v) { return __uint_as_float((unsigned)v << 16); }
__device__ __forceinline__ bf16_t f2bf(float f) { unsigned u = __float_as_uint(f); return (bf16_t)((u + 0x7fffu + ((u >> 16) & 1u)) >> 16); }
__device__ __forceinline__ unsigned pk2(float lo, float hi) { return (unsigned)f2bf(lo) | ((unsigned)f2bf(hi) << 16); }
__device__ __forceinline__ float gelu_tanh(float x) { const float u = 0.7978845608028654f * (x + 0.044715f * x * x * x); return x / (1.f + __expf(-2.f * u)); }
__device__ __forceinline__ float sigmoidf(float x) { return 1.f / (1.f + __expf(-x)); }
template <int CTRL> __device__ __forceinline__ float dppf_(float v) { return __builtin_bit_cast(float, __builtin_amdgcn_update_dpp(0, __builtin_bit_cast(int, v), CTRL, 0xf, 0xf, true)); }
__device__ __forceinline__ float wave_sum(float v) {
    v += dppf_<0xB1>(v); v += dppf_<0x4E>(v); v += dppf_<0x141>(v); v += dppf_<0x140>(v);
    { auto rr = __builtin_amdgcn_permlane16_swap(__float_as_uint(v), __float_as_uint(v), false, false); v = __uint_as_float(rr[0]) + __uint_as_float(rr[1]); }
    { auto rr = __builtin_amdgcn_permlane32_swap(__float_as_uint(v), __float_as_uint(v), false, false); v = __uint_as_float(rr[0]) + __uint_as_float(rr[1]); }
    return v;
}
__device__ __forceinline__ float wave_max(float v) {
#pragma unroll
    for (int o = 1; o < 64; o <<= 1) v = fmaxf(v, __shfl_xor(v, o));
    return v;
}
__device__ __forceinline__ int qk_store_col(int d) { return 2 * (d & 31) + (d >> 5); }

struct Args { const float* in[21]; float* out; unsigned char* ws; int ph_lo, ph_hi, li, pad; };

template <bool QKPERM>
__device__ __forceinline__ void p0_transpose_item(const float* W, int ldw, int K, int Ncols, bf16_t* WT, int ldt, int col_off, const float* kscale, LAS float* scr, int item, int lane) {
    const int nblk = Ncols / 32, kb = item / nblk, nb = item % nblk, k0 = 64 * kb, n0 = 32 * nb;
#pragma unroll 8
    for (int i = 0; i < 32; ++i) { const int kk = 2 * i + (lane >> 5); float v = W[(size_t)(k0 + kk) * ldw + n0 + (lane & 31)]; if (kscale) v *= kscale[k0 + kk]; scr[kk * 33 + (lane & 31)] = v; }
    asm volatile("s_waitcnt lgkmcnt(0)" ::: "memory");
    const int c = lane & 7;
#pragma unroll
    for (int j = 0; j < 4; ++j) { const int n = (lane >> 3) + 8 * j; const LAS float* s = scr + (8 * c) * 33 + n;
        uint4 o; o.x = pk2(s[0 * 33], s[1 * 33]); o.y = pk2(s[2 * 33], s[3 * 33]); o.z = pk2(s[4 * 33], s[5 * 33]); o.w = pk2(s[6 * 33], s[7 * 33]);
        int nn = n0 + n;
        if (QKPERM) { if (nn < 1024) nn = (nn & ~63) + qk_store_col(nn & 63); }
        *(uint4*)(WT + (size_t)nn * ldt + col_off + k0 + 8 * c) = o; }
    asm volatile("s_waitcnt lgkmcnt(0)" ::: "memory");
}
template <int B>
__device__ __forceinline__ void rms_rows_to_bf16(const float* __restrict__ X, const float* __restrict__ g, bf16_t* __restrict__ O, size_t m0, size_t mstride, int lane, float* __restrict__ RS = nullptr) {
    float4 v[B][4];
#pragma unroll
    for (int u = 0; u < B; ++u) { const float4* xr = (const float4*)(X + (m0 + u * mstride) * DM) + lane;
#pragma unroll
        for (int j = 0; j < 4; ++j) v[u][j] = xr[64 * j]; }
    float4 gg[4];
#pragma unroll
    for (int j = 0; j < 4; ++j) gg[j] = RS ? make_float4(1.f, 1.f, 1.f, 1.f) : ((const float4*)g + lane)[64 * j];
#pragma unroll
    for (int u = 0; u < B; ++u) { float s = 0.f;
#pragma unroll
        for (int j = 0; j < 4; ++j) s += (v[u][j].x * v[u][j].x + v[u][j].y * v[u][j].y) + (v[u][j].z * v[u][j].z + v[u][j].w * v[u][j].w);
        const float ms = wave_sum(s) * (1.f / DM) + EPS; const float rstd = rsqrtf(ms);
        if (RS && lane == 0) RS[m0 + u * mstride] = sqrtf(ms);
        uint2* o8 = (uint2*)(O + (m0 + u * mstride) * DM) + lane;
#pragma unroll
        for (int j = 0; j < 4; ++j) { uint2 o; o.x = pk2(v[u][j].x * rstd * gg[j].x, v[u][j].y * rstd * gg[j].y); o.y = pk2(v[u][j].z * rstd * gg[j].z, v[u][j].w * rstd * gg[j].w); o8[64 * j] = o; } }
}
__device__ __forceinline__ void p0_prologue(const Args& a, LAS unsigned char* lds) {
    const int tid = threadIdx.x, lane = tid & 63, wave = tid >> 6;
    const int gw = blockIdx.x * 8 + wave, NGW = gridDim.x * 8;
    unsigned char* ws = a.ws;
    LAS float* scr = (LAS float*)(lds + wave * 16384);
    constexpr int I_IN = (1024 / 64) * (IN_COLS / 32), I_A = (512 / 64) * (1024 / 32), I_O = (1024 / 64) * (1024 / 32), I_XQ = (1024 / 64) * (512 / 32), I_KV = I_O, I_XO = (512 / 64) * (1024 / 32), I_PQ = (1024 / 64) * (2048 / 32);
    constexpr int NITEMS = I_IN + 2 * I_A + I_O + I_XQ + I_KV + I_XO + I_PQ;
    for (int it = gw; it < NITEMS; it += NGW) {
        int r = it;
        if (r < I_IN) { p0_transpose_item<true>(a.in[3], IN_COLS, 1024, IN_COLS, (bf16_t*)(ws + WS_WIN_T), 1024, 0, a.in[2], scr, r, lane); continue; } r -= I_IN;
        if (r < I_A) { p0_transpose_item<false>(a.in[4], 1024, 512, 1024, (bf16_t*)(ws + WS_WAB_T), 1024, 0, nullptr, scr, r, lane); continue; } r -= I_A;
        if (r < I_A) { p0_transpose_item<false>(a.in[8], 1024, 512, 1024, (bf16_t*)(ws + WS_WAB_T), 1024, 512, nullptr, scr, r, lane); continue; } r -= I_A;
        if (r < I_O) { p0_transpose_item<false>(a.in[9], 1024, 1024, 1024, (bf16_t*)(ws + WS_WOUT_T), 1024, 0, nullptr, scr, r, lane); continue; } r -= I_O;
        if (r < I_XQ) { p0_transpose_item<false>(a.in[12], 512, 1024, 512, (bf16_t*)(ws + WS_XAQ_T), 1024, 0, a.in[10], scr, r, lane); continue; } r -= I_XQ;
        if (r < I_KV) { p0_transpose_item<false>(a.in[13], 1024, 1024, 1024, (bf16_t*)(ws + WS_XAKV_T), 1024, 0, nullptr, scr, r, lane); continue; } r -= I_KV;
        if (r < I_XO) { p0_transpose_item<false>(a.in[14], 1024, 512, 1024, (bf16_t*)(ws + WS_XAO_T), 512, 0, nullptr, scr, r, lane); continue; } r -= I_XO;
        p0_transpose_item<false>(a.in[16], 2048, 1024, 2048, (bf16_t*)(ws + WS_PQ_T), 1024, 0, a.in[15], scr, r, lane);
    }
    const size_t gt = (size_t)blockIdx.x * blockDim.x + tid, GT = (size_t)gridDim.x * blockDim.x;
    {
        const float* s = a.in[17]; bf16_t* d = (bf16_t*)(ws + WS_SK);
        for (size_t i = gt; i < 8 * 2 * 128 * 128 / 4; i += GT) { const float4 v = ((const float4*)s)[i]; uint2 o; o.x = pk2(v.x, v.y); o.y = pk2(v.z, v.w); ((uint2*)d)[i] = o; }
    }
    {
        const float* s = a.in[6]; bf16_t* d = (bf16_t*)(ws + WS_WM);
        for (size_t i = gt; i < 8 * 128 * 128; i += GT) { const int ss = i & 127, tt = (i >> 7) & 127; d[i] = f2bf(ss <= tt ? s[i] : 0.f); }
    }
    {
        float2* d = (float2*)(ws + WS_ROPE);
        for (size_t i = gt; i < 8192 * 32; i += GT) { const int p = (int)(i >> 5), k = (int)(i & 31);
            const float freq = powf(10000.0f, -(float)k / 32.0f); const float ang = (float)p * freq; float sn, cs; sincosf(ang, &sn, &cs); d[i] = make_float2(cs, sn); }
    }
    for (int r0 = gw; r0 < 2 * 16384; r0 += 4 * NGW) {
        float v[4][16];
#pragma unroll
        for (int u = 0; u < 4; ++u) { const int r = r0 + u * NGW; if (r < 2 * 16384) { const int which = r >> 14, e = r & 16383; const float* src = (which ? a.in[19] : a.in[18]) + (size_t)e * 1024 + lane * 16;
#pragma unroll
            for (int q = 0; q < 4; ++q) { const float4 t4 = *(const float4*)(src + 4 * q); v[u][4 * q] = t4.x; v[u][4 * q + 1] = t4.y; v[u][4 * q + 2] = t4.z; v[u][4 * q + 3] = t4.w; } } }
#pragma unroll
        for (int u = 0; u < 4; ++u) { const int r = r0 + u * NGW; if (r < 2 * 16384) { const int which = r >> 14, e = r & 16383;
            if (!which) {
#pragma unroll
                for (int q = 0; q < 4; ++q) { const float4 g4 = *(const float4*)(a.in[15] + lane * 16 + 4 * q); v[u][4 * q] *= g4.x; v[u][4 * q + 1] *= g4.y; v[u][4 * q + 2] *= g4.z; v[u][4 * q + 3] *= g4.w; } }
            float am = 0.f;
#pragma unroll
            for (int q = 0; q < 16; ++q) am = fmaxf(am, fabsf(v[u][q]));
            am = wave_max(am);
            const float qmax = which ? 440.f : 127.f;
            const float inv = am > 0.f ? qmax / am : 0.f;
            if (lane == 0) ((float*)(ws + (which ? WS_SU : WS_SD)))[e] = am > 0.f ? am / qmax : 1.f;
            unsigned w[4];
            if (which) {
#pragma unroll
                for (int q = 0; q < 4; ++q) { int pk = __builtin_amdgcn_cvt_pk_fp8_f32(v[u][4 * q] * inv, v[u][4 * q + 1] * inv, 0, false); pk = __builtin_amdgcn_cvt_pk_fp8_f32(v[u][4 * q + 2] * inv, v[u][4 * q + 3] * inv, pk, true); w[q] = (unsigned)pk; }
            } else {
#pragma unroll
                for (int q = 0; q < 4; ++q) w[q] = ((unsigned)__float2int_rn(v[u][4 * q] * inv) & 0xffu) | (((unsigned)__float2int_rn(v[u][4 * q + 1] * inv) & 0xffu) << 8) | (((unsigned)__float2int_rn(v[u][4 * q + 2] * inv) & 0xffu) << 16) | ((unsigned)__float2int_rn(v[u][4 * q + 3] * inv) << 24);
            }
            *(uint4*)(ws + (which ? WS_WU : WS_WD) + (size_t)(lane >> 3) * (16384 * 128) + (size_t)e * 128 + (lane & 7) * 16) = make_uint4(w[0], w[1], w[2], w[3]); } }
    }
    { size_t m = gw;
      for (; m + 3 * (size_t)NGW < T_TOK; m += 4 * (size_t)NGW) rms_rows_to_bf16<4>(a.in[0], nullptr, (bf16_t*)a.out, m, NGW, lane, (float*)(ws + WS_RS0));
      for (; m < T_TOK; m += NGW) rms_rows_to_bf16<1>(a.in[0], nullptr, (bf16_t*)a.out, m, NGW, lane, (float*)(ws + WS_RS0)); }
    for (size_t m = gw; m < NB * NMEM; m += NGW) rms_rows_to_bf16<1>(a.in[1], a.in[11], (bf16_t*)(ws + WS_MN), m, NGW, lane);
}


namespace pg8 {
typedef short bf16x8 __attribute__((ext_vector_type(8)));
typedef float f32x4 __attribute__((ext_vector_type(4)));
typedef unsigned u32x4 __attribute__((ext_vector_type(4)));
constexpr int BM = 256, BK = 64, HALF = 128, HTB = HALF * BK * 2, STAGE_BYTES = 8 * HTB, NXCD = 8, WGM = 8;
__host__ __device__ __forceinline__ int lds_byte(int r, int c) { const int st = (r >> 4) * 2 + (c >> 5), rr = r & 15, cc = c & 31, ob = rr * 64 + cc * 2; return st * 1024 + (ob ^ (((ob >> 9) & 1) << 5)); }
__host__ __device__ __forceinline__ void stage_rc(int b, int& R, int& C) { const int st = b / 1024, sb = b % 1024, swz = sb ^ (((sb >> 9) & 1) << 5); R = (st >> 1) * 16 + swz / 64; C = (st & 1) * 32 + (swz % 64) / 2; }
__host__ __device__ __forceinline__ int perm32(int rho) { const int n = rho >> 4, i = rho & 15; return 8 * (i >> 2) + 4 * n + (i & 3); }
struct Unit { int pm, pn, kofs, var; };
struct Gemm { const bf16_t* A; const bf16_t* Bt; int lda, ldb, K; };
struct StaticOrder {
    int nM, nN, nwg, G, c, NV, kvar;
    __device__ void init(int M, int N, int G_, int c_, int NV_ = 1, int kvar_ = 0) { nM = M / BM; nN = N / BM; nwg = nM * nN; G = G_; c = c_; NV = NV_; kvar = kvar_; }
    __device__ bool next(int i, Unit& u) const {
        const int it = i / NV, v = i - it * NV;
        const long L = (long)it * G + c; if (L >= nwg) return false;
        int wgid = (int)L; { const int q = nwg / NXCD, r = nwg % NXCD, xcd = wgid % NXCD, off = wgid / NXCD; wgid = (xcd < r ? xcd * (q + 1) : r * (q + 1) + (xcd - r) * q) + off; }
        const int nig = WGM * nN, gid = wgid / nig, fm = gid * WGM, gsz = (nM - fm) < WGM ? (nM - fm) : WGM;
        u.pm = fm + ((wgid % nig) % gsz); u.pn = (wgid % nig) / gsz; u.kofs = v * kvar; u.var = v; return true;
    }
};
__device__ __forceinline__ unsigned cvt_pk_bf16(float lo, float hi) { unsigned r; asm volatile("v_cvt_pk_bf16_f32 %0, %1, %2" : "=v"(r) : "v"(lo), "v"(hi)); return r; }
__device__ __forceinline__ u32x4 pack8(const f32x4 a, const f32x4 b) { u32x4 w; w.x = cvt_pk_bf16(a[0], a[1]); w.y = cvt_pk_bf16(a[2], a[3]); w.z = cvt_pk_bf16(b[0], b[1]); w.w = cvt_pk_bf16(b[2], b[3]); return w; }
__device__ __forceinline__ void unpack8(const u32x4 w, f32x4& a, f32x4& b) {
    a[0] = __uint_as_float(w.x << 16); a[1] = __uint_as_float(w.x & 0xffff0000u); a[2] = __uint_as_float(w.y << 16); a[3] = __uint_as_float(w.y & 0xffff0000u);
    b[0] = __uint_as_float(w.z << 16); b[1] = __uint_as_float(w.z & 0xffff0000u); b[2] = __uint_as_float(w.w << 16); b[3] = __uint_as_float(w.w & 0xffff0000u); }

template <class Epi, class Sched, bool MIDHOOK = false>
__device__ __forceinline__ void gemm_phase(LAS unsigned char* lds, const Gemm g, const Sched& S, const Epi& E) {
    const int tid = threadIdx.x, wid = __builtin_amdgcn_readfirstlane(tid >> 6), lane = tid & 63, wr = wid >> 2, wc = wid & 3, fr = lane & 15, fq = lane >> 4;
    const int nt = g.K / BK;
    unsigned voffA[2], voffB[2];
#pragma unroll
    for (int i = 0; i < 2; ++i) { int R, C; stage_rc(tid * 16 + i * 8192, R, C); const int Rb = (R & ~31) + perm32(R & 31);
        voffA[i] = (unsigned)(R * g.lda + C) * 2u; voffB[i] = (unsigned)(Rb * g.ldb + C) * 2u; }
    const size_t kstep = (size_t)(BK * 2);
    const size_t hstepA = (size_t)HALF * g.lda * 2, hstepB = (size_t)HALF * g.ldb * 2;
    const size_t tstepA = 2 * hstepA, tstepB = 2 * hstepB;
    const unsigned ldsw = (unsigned)wid * 1024u;
    const int aoff = lds_byte(wr * 64 + fr, fq * 8), boff = lds_byte(wc * 32 + fr, fq * 8);
#define PG8_SA(b, h) (((b) * 2 + (h)) * HTB)
#define PG8_SB(b, h) ((4 + (b) * 2 + (h)) * HTB)
#define PG8_STAGE(bufoff, gbase, voff) do { _Pragma("unroll") for (int _i = 0; _i < 2; ++_i) \
        __builtin_amdgcn_global_load_lds((const unsigned*)((const char*)(gbase) + (voff)[_i]), (LAS unsigned*)(lds + (bufoff) + ldsw + _i * 8192), 16, 0, 0); } while (0)
#define PG8_LDA(dst, b, h) do { _Pragma("unroll") for (int m = 0; m < 4; ++m) _Pragma("unroll") for (int k = 0; k < 2; ++k) dst[m][k] = *(const LAS bf16x8*)(lds + PG8_SA(b, h) + aoff + m * 2048 + k * 1024); } while (0)
#define PG8_LDB(dst, b, h) do { _Pragma("unroll") for (int n = 0; n < 2; ++n) _Pragma("unroll") for (int k = 0; k < 2; ++k) dst[n][k] = *(const LAS bf16x8*)(lds + PG8_SB(b, h) + boff + n * 2048 + k * 1024); } while (0)
#define PG8_MMA(ai, bj, At, Bt) do { __builtin_amdgcn_s_setprio(1); _Pragma("unroll") for (int m = 0; m < 4; ++m) _Pragma("unroll") for (int n = 0; n < 2; ++n) _Pragma("unroll") for (int k = 0; k < 2; ++k) \
        acc[ai][bj][m][n] = __builtin_amdgcn_mfma_f32_16x16x32_bf16(Bt[n][k], At[m][k], acc[ai][bj][m][n], 0, 0, 0); __builtin_amdgcn_s_setprio(0); } while (0)
#define PG8_WAIT_V(n) asm volatile("s_waitcnt vmcnt(" #n ")" ::: "memory")
#define PG8_WAIT_L(n) asm volatile("s_waitcnt lgkmcnt(" #n ")" ::: "memory")
#define PG8_BAR __builtin_amdgcn_s_barrier()
#define PG8_SCHED __builtin_amdgcn_sched_barrier(0)
    Unit cur, nxt; int ui = 0;
    if (!S.next(0, cur)) return;
    f32x4 acc[2][2][4][2];
#pragma unroll
    for (int a = 0; a < 2; ++a)
#pragma unroll
        for (int b = 0; b < 2; ++b)
#pragma unroll
            for (int m = 0; m < 4; ++m)
#pragma unroll
                for (int n = 0; n < 2; ++n) acc[a][b][m][n] = (f32x4){0.f, 0.f, 0.f, 0.f};
    bf16x8 At[4][2], B0[2][2], B1[2][2];
    const char* cA = (const char*)g.A + (size_t)cur.pm * tstepA + (size_t)cur.kofs * 2; const char* cB = (const char*)g.Bt + (size_t)cur.pn * tstepB + (size_t)cur.kofs * 2;
    PG8_STAGE(PG8_SB(0, 0), cB, voffB); PG8_STAGE(PG8_SB(0, 1), cB + hstepB, voffB); PG8_STAGE(PG8_SA(0, 0), cA, voffA); PG8_STAGE(PG8_SA(0, 1), cA + hstepA, voffA);
    if (wr == 1) PG8_BAR;
    PG8_WAIT_V(2); PG8_BAR;
    PG8_STAGE(PG8_SB(1, 0), cB + kstep, voffB); PG8_STAGE(PG8_SA(1, 0), cA + kstep, voffA); PG8_STAGE(PG8_SB(1, 1), cB + hstepB + kstep, voffB);
    PG8_WAIT_V(6); PG8_BAR;
    for (;;) {
        const bool has_next = S.next(ui + 1, nxt);
        const char* nA = has_next ? (const char*)g.A + (size_t)nxt.pm * tstepA + (size_t)nxt.kofs * 2 : cA; const char* nB = has_next ? (const char*)g.Bt + (size_t)nxt.pn * tstepB + (size_t)nxt.kofs * 2 : cB;
#define PG8_KPAIR(t) do { \
            const bool last = (t == nt - 2); \
            const char* a1 = cA + (size_t)(t + 1) * kstep; \
            const char* a2 = last ? nA : cA + (size_t)(t + 2) * kstep; const char* b2 = last ? nB : cB + (size_t)(t + 2) * kstep; \
            const char* a3 = a2 + kstep; const char* b3 = b2 + kstep; \
            PG8_LDB(B0, 0, 0); PG8_LDB(B1, 0, 1); PG8_SCHED; PG8_LDA(At, 0, 0); PG8_STAGE(PG8_SA(1, 1), a1 + hstepA, voffA); \
            PG8_WAIT_V(8); PG8_WAIT_L(0); PG8_BAR; PG8_MMA(0, 0, At, B0); PG8_MMA(0, 1, At, B1); PG8_BAR; PG8_SCHED; \
            PG8_LDA(At, 0, 1); PG8_STAGE(PG8_SB(0, 0), b2, voffB); PG8_STAGE(PG8_SB(0, 1), b2 + hstepB, voffB); PG8_STAGE(PG8_SA(0, 0), a2, voffA); \
            PG8_WAIT_V(8); PG8_WAIT_L(0); PG8_BAR; PG8_MMA(1, 0, At, B0); PG8_MMA(1, 1, At, B1); PG8_BAR; PG8_SCHED; \
            PG8_LDB(B0, 1, 0); PG8_LDB(B1, 1, 1); PG8_SCHED; PG8_LDA(At, 1, 0); PG8_STAGE(PG8_SA(0, 1), a2 + hstepA, voffA); \
            PG8_WAIT_V(8); PG8_WAIT_L(0); PG8_BAR; PG8_MMA(0, 0, At, B0); PG8_MMA(0, 1, At, B1); PG8_BAR; PG8_SCHED; \
            PG8_LDA(At, 1, 1); PG8_STAGE(PG8_SB(1, 0), b3, voffB); PG8_STAGE(PG8_SB(1, 1), b3 + hstepB, voffB); PG8_STAGE(PG8_SA(1, 0), a3, voffA); \
            PG8_WAIT_V(8); PG8_WAIT_L(0); PG8_BAR; PG8_MMA(1, 0, At, B0); PG8_MMA(1, 1, At, B1); PG8_BAR; PG8_SCHED; \
        } while (0)
        if constexpr (MIDHOOK) {
            for (int t = 0; t < nt / 2; t += 2) PG8_KPAIR(t);
            E.mid(acc, cur, wr, wc, fr, fq);
            for (int t = nt / 2; t < nt; t += 2) PG8_KPAIR(t);
        } else {
            for (int t = 0; t < nt; t += 2) PG8_KPAIR(t);
        }
#undef PG8_KPAIR
        if (wr == 0) PG8_BAR;
        E(acc, cur, wr, wc, fr, fq);
        if (!has_next) break;
#pragma unroll
        for (int a = 0; a < 2; ++a)
#pragma unroll
            for (int b = 0; b < 2; ++b)
#pragma unroll
                for (int m = 0; m < 4; ++m)
#pragma unroll
                    for (int n = 0; n < 2; ++n) acc[a][b][m][n] = (f32x4){0.f, 0.f, 0.f, 0.f};
        cur = nxt; cA = nA; cB = nB; ++ui;
        if (wr == 1) PG8_BAR;
    }
    PG8_WAIT_V(0);
    PG8_BAR;
#undef PG8_SA
#undef PG8_SB
#undef PG8_STAGE
#undef PG8_LDA
#undef PG8_LDB
#undef PG8_MMA
#undef PG8_WAIT_V
#undef PG8_WAIT_L
#undef PG8_BAR
#undef PG8_SCHED
}

#define EPI_ROWS() const int row0 = u.pm * BM + wr * 64 + fr; const int cw = wc * 32 + 8 * fq
template <int ACT>
__device__ __forceinline__ void store_act(const f32x4 (&acc)[2][2][4][2], bf16_t* O, int ldc, int colt, int row0, int cw) {
#pragma unroll
    for (int ai = 0; ai < 2; ++ai)
#pragma unroll
        for (int m = 0; m < 4; ++m) { bf16_t* rowp = O + (size_t)(row0 + ai * HALF + m * 16) * ldc + colt + cw;
#pragma unroll
            for (int bj = 0; bj < 2; ++bj) { f32x4 v0 = acc[ai][bj][m][0], v1 = acc[ai][bj][m][1];
                if (ACT == 1) {
#pragma unroll
                    for (int e = 0; e < 4; ++e) { v0[e] = gelu_tanh(v0[e]); v1[e] = gelu_tanh(v1[e]); } }
                if (ACT == 2) {
#pragma unroll
                    for (int e = 0; e < 4; ++e) { v0[e] = sigmoidf(v0[e]); v1[e] = sigmoidf(v1[e]); } }
                *(u32x4*)(rowp + bj * HALF) = pack8(v0, v1); } }
}
struct EpiPlain { bf16_t* O; int ldc;
    __device__ __forceinline__ void operator()(const f32x4 (&acc)[2][2][4][2], const Unit& u, int wr, int wc, int fr, int fq) const { EPI_ROWS(); store_act<0>(acc, O, ldc, u.pn * BM, row0, cw); } };
struct EpiInProj { bf16_t *Q, *K, *V, *U, *GV, *GA, *GB; float* KMP; const float2* rope;
    __device__ __forceinline__ void operator()(const f32x4 (&acc)[2][2][4][2], const Unit& u, int wr, int wc, int fr, int fq) const {
        EPI_ROWS(); const int pn = u.pn;
        if (pn < 4) {
            const bool isk = pn >= 2; bf16_t* O = isk ? K : Q; const float sc = isk ? 1.f : C2M; const int ct = (pn & 1) * 256;
            const int i0 = ((wc & 1) * 32 + 8 * fq) >> 1;
            f32x4 ks[2][2];
#pragma unroll
            for (int bj = 0; bj < 2; ++bj) { ks[bj][0] = (f32x4){0.f, 0.f, 0.f, 0.f}; ks[bj][1] = (f32x4){0.f, 0.f, 0.f, 0.f}; }
            f32x4 tt[2][4][2];
#pragma unroll
            for (int ai = 0; ai < 2; ++ai)
#pragma unroll
                for (int m = 0; m < 4; ++m) { const int pos = (row0 + ai * HALF + m * 16) & (SEQ - 1); tt[ai][m][0] = *(const f32x4*)(rope + pos * 32 + i0); tt[ai][m][1] = *(const f32x4*)(rope + pos * 32 + i0 + 2); }
#pragma unroll
            for (int ai = 0; ai < 2; ++ai)
#pragma unroll
                for (int m = 0; m < 4; ++m) { const int r = row0 + ai * HALF + m * 16;
                    const f32x4 t0 = tt[ai][m][0], t1 = tt[ai][m][1];
#pragma unroll
                    for (int bj = 0; bj < 2; ++bj) { const f32x4 v0 = acc[ai][bj][m][0], v1 = acc[ai][bj][m][1]; f32x4 o0, o1;
                        o0[0] = v0[0] * t0[0] - v0[1] * t0[1]; o0[1] = v0[1] * t0[0] + v0[0] * t0[1];
                        o0[2] = v0[2] * t0[2] - v0[3] * t0[3]; o0[3] = v0[3] * t0[2] + v0[2] * t0[3];
                        o1[0] = v1[0] * t1[0] - v1[1] * t1[1]; o1[1] = v1[1] * t1[0] + v1[0] * t1[1];
                        o1[2] = v1[2] * t1[2] - v1[3] * t1[3]; o1[3] = v1[3] * t1[2] + v1[2] * t1[3];
                        if (isk) { ks[bj][0] += o0; ks[bj][1] += o1; }
                        *(u32x4*)(O + (size_t)r * 512 + ct + bj * HALF + cw) = pack8(o0 * sc, o1 * sc); } }
            if (isk) {
#pragma unroll
                for (int bj = 0; bj < 2; ++bj)
#pragma unroll
                    for (int n = 0; n < 2; ++n)
#pragma unroll
                        for (int e = 0; e < 4; ++e) { float v = ks[bj][n][e]; v += __shfl_xor(v, 1); v += __shfl_xor(v, 2); v += __shfl_xor(v, 4); v += __shfl_xor(v, 8); ks[bj][n][e] = v; }
                if (fr == 0) {
#pragma unroll
                    for (int bj = 0; bj < 2; ++bj)
#pragma unroll
                        for (int n = 0; n < 2; ++n) *(f32x4*)(KMP + ((size_t)u.pm * 2 + wr) * 512 + ct + bj * HALF + cw + 4 * n) = ks[bj][n]; }
            }
        } else if (pn < 6) store_act<0>(acc, V, 512, (pn - 4) * BM, row0, cw);
        else if (pn < 8) store_act<1>(acc, U, 512, (pn - 6) * BM, row0, cw);
        else if (pn < 10) store_act<1>(acc, GV, 512, (pn - 8) * BM, row0, cw);
        else if (pn < 14) store_act<2>(acc, GA, 1024, (pn - 10) * BM, row0, cw);
        else store_act<2>(acc, GB, 1024, (pn - 14) * BM, row0, cw);
    } };
struct EpiMerged { const bf16_t *GA, *GB; bf16_t* MG;
    __device__ __forceinline__ void operator()(const f32x4 (&acc)[2][2][4][2], const Unit& u, int wr, int wc, int fr, int fq) const {
        EPI_ROWS(); const bf16_t* G = u.var ? GB : GA;
#pragma unroll
        for (int ai = 0; ai < 2; ++ai) {
            u32x4 gq[4][2], pq[4][2];
#pragma unroll
            for (int m = 0; m < 4; ++m)
#pragma unroll
                for (int bj = 0; bj < 2; ++bj) { const size_t off = (size_t)(row0 + ai * HALF + m * 16) * 1024 + u.pn * BM + cw + bj * HALF; gq[m][bj] = *(const u32x4*)(G + off); if (u.var) pq[m][bj] = *(const u32x4*)(MG + off); }
#pragma unroll
            for (int m = 0; m < 4; ++m)
#pragma unroll
                for (int bj = 0; bj < 2; ++bj) { const size_t off = (size_t)(row0 + ai * HALF + m * 16) * 1024 + u.pn * BM + cw + bj * HALF; f32x4 g0, g1; unpack8(gq[m][bj], g0, g1);
                    f32x4 v0 = acc[ai][bj][m][0] * g0, v1 = acc[ai][bj][m][1] * g1;
                    if (u.var) { f32x4 p0, p1; unpack8(pq[m][bj], p0, p1); v0 += p0; v1 += p1; }
                    *(u32x4*)(MG + off) = pack8(v0, v1); }
        }
    } };
struct EpiMergedFused { const bf16_t *GA, *GB; bf16_t* MG;
    __device__ __forceinline__ void mid(f32x4 (&acc)[2][2][4][2], const Unit& u, int wr, int wc, int fr, int fq) const {
        EPI_ROWS();
#pragma unroll
        for (int ai = 0; ai < 2; ++ai)
#pragma unroll
            for (int mh = 0; mh < 2; ++mh) {
                u32x4 ga[2][2], gb[2][2];
#pragma unroll
                for (int mm = 0; mm < 2; ++mm)
#pragma unroll
                    for (int bj = 0; bj < 2; ++bj) { const size_t off = (size_t)(row0 + ai * HALF + (mh * 2 + mm) * 16) * 1024 + u.pn * BM + cw + bj * HALF; ga[mm][bj] = *(const u32x4*)(GA + off); gb[mm][bj] = *(const u32x4*)(GB + off); }
#pragma unroll
                for (int mm = 0; mm < 2; ++mm)
#pragma unroll
                    for (int bj = 0; bj < 2; ++bj) { const int m = mh * 2 + mm; f32x4 a0, a1, b0, b1; unpack8(ga[mm][bj], a0, a1); unpack8(gb[mm][bj], b0, b1);
#pragma unroll
                        for (int e = 0; e < 4; ++e) { acc[ai][bj][m][0][e] *= a0[e] * __builtin_amdgcn_rcpf(fmaxf(b0[e], 1e-30f)); acc[ai][bj][m][1][e] *= a1[e] * __builtin_amdgcn_rcpf(fmaxf(b1[e], 1e-30f)); } }
                asm volatile("" ::: "memory");
            }
    }
    __device__ __forceinline__ void operator()(const f32x4 (&acc)[2][2][4][2], const Unit& u, int wr, int wc, int fr, int fq) const {
        EPI_ROWS();
#pragma unroll
        for (int ai = 0; ai < 2; ++ai) {
            u32x4 gb[4][2];
#pragma unroll
            for (int m = 0; m < 4; ++m)
#pragma unroll
                for (int bj = 0; bj < 2; ++bj) gb[m][bj] = *(const u32x4*)(GB + (size_t)(row0 + ai * HALF + m * 16) * 1024 + u.pn * BM + cw + bj * HALF);
#pragma unroll
            for (int m = 0; m < 4; ++m)
#pragma unroll
                for (int bj = 0; bj < 2; ++bj) { f32x4 b0, b1; unpack8(gb[m][bj], b0, b1);
                    *(u32x4*)(MG + (size_t)(row0 + ai * HALF + m * 16) * 1024 + u.pn * BM + cw + bj * HALF) = pack8(acc[ai][bj][m][0] * b0, acc[ai][bj][m][1] * b1); }
        }
    } };
template <int RESBF> struct EpiResid { const float* res; const bf16_t* XNR; bf16_t* XB; float* SS;
    __device__ __forceinline__ void operator()(const f32x4 (&acc)[2][2][4][2], const Unit& u, int wr, int wc, int fr, int fq) const {
        EPI_ROWS();
#pragma unroll
        for (int ai = 0; ai < 2; ++ai) {
            f32x4 xr[4][2][2];
#pragma unroll
            for (int m = 0; m < 4; ++m)
#pragma unroll
                for (int bj = 0; bj < 2; ++bj) { const size_t off = (size_t)(row0 + ai * HALF + m * 16) * 1024 + u.pn * BM + cw + bj * HALF;
                    if (RESBF) { const u32x4 w = *(const u32x4*)((RESBF == 2 ? XNR : XB) + off); xr[m][bj][0] = __builtin_bit_cast(f32x4, w); }
                    else { xr[m][bj][0] = *(const f32x4*)(res + off); xr[m][bj][1] = *(const f32x4*)(res + off + 4); } }
#pragma unroll
            for (int m = 0; m < 4; ++m) { const int r = row0 + ai * HALF + m * 16; float ss = 0.f; const float rsc = RESBF == 2 ? res[r] : 1.f;
#pragma unroll
                for (int bj = 0; bj < 2; ++bj) { const size_t off = (size_t)r * 1024 + u.pn * BM + cw + bj * HALF; f32x4 x0, x1;
                    if (RESBF) { unpack8(__builtin_bit_cast(u32x4, xr[m][bj][0]), x0, x1); if (RESBF == 2) { x0 *= rsc; x1 *= rsc; } } else { x0 = xr[m][bj][0]; x1 = xr[m][bj][1]; }
                    const f32x4 v0 = acc[ai][bj][m][0] + x0, v1 = acc[ai][bj][m][1] + x1;
                    *(u32x4*)(XB + off) = pack8(v0, v1);
                    ss += (v0[0] * v0[0] + v0[1] * v0[1]) + (v0[2] * v0[2] + v0[3] * v0[3]) + (v1[0] * v1[0] + v1[1] * v1[1]) + (v1[2] * v1[2] + v1[3] * v1[3]); }
                ss += __shfl_xor(ss, 16); ss += __shfl_xor(ss, 32);
                if (fq == 0) SS[(size_t)r * 16 + u.pn * 4 + wc] = ss; }
        }
    } };
struct EpiRowScale { bf16_t* O; int ldc; const float* SS; float cscale;
    __device__ __forceinline__ void operator()(const f32x4 (&acc)[2][2][4][2], const Unit& u, int wr, int wc, int fr, int fq) const {
        EPI_ROWS();
        f32x4 sq[2][4];
#pragma unroll
        for (int ai = 0; ai < 2; ++ai)
#pragma unroll
            for (int m = 0; m < 4; ++m) sq[ai][m] = *(const f32x4*)(SS + (size_t)(row0 + ai * HALF + m * 16) * 16 + 4 * fq);
#pragma unroll
        for (int ai = 0; ai < 2; ++ai)
#pragma unroll
            for (int m = 0; m < 4; ++m) { const int r = row0 + ai * HALF + m * 16; const f32x4 s4 = sq[ai][m];
                float st = (s4[0] + s4[1]) + (s4[2] + s4[3]); st += __shfl_xor(st, 16); st += __shfl_xor(st, 32);
                const float rs = rsqrtf(st * (1.f / DM) + EPS) * cscale;
                bf16_t* rowp = O + (size_t)r * ldc + u.pn * BM + cw;
#pragma unroll
                for (int bj = 0; bj < 2; ++bj) *(u32x4*)(rowp + bj * HALF) = pack8(acc[ai][bj][m][0] * rs, acc[ai][bj][m][1] * rs); }
    } };
#undef EPI_ROWS
}


namespace att {
typedef unsigned u32x4 __attribute__((ext_vector_type(4)));
typedef float f32x4 __attribute__((ext_vector_type(4)));
typedef short bf16x8 __attribute__((ext_vector_type(8)));
typedef short s16x4 __attribute__((ext_vector_type(4)));
typedef float f32x16 __attribute__((ext_vector_type(16)));
typedef float f32x8 __attribute__((ext_vector_type(8)));
typedef float f32x2 __attribute__((ext_vector_type(2)));
#define KSWZ(row, colB) ((row) * 256 + ((colB) ^ (((row) & 7) << 4)))
#define SBAR() __builtin_amdgcn_sched_barrier(0)
constexpr float THR2 = 8.f;
__device__ __forceinline__ int crow(int r, int hi) { return (r & 3) + 8 * (r >> 2) + 4 * hi; }
__device__ __forceinline__ unsigned cvtpk(float lo, float hi) { unsigned r; asm volatile("v_cvt_pk_bf16_f32 %0, %1, %2" : "=v"(r) : "v"(lo), "v"(hi)); return r; }
template <bool SWAPK>
__device__ __forceinline__ void softmax_tile(f32x16& p0, f32x16& p1, float& m_reg, float& l_reg, float& alpha, f32x16& negm, bool first, bf16x8& pa0, bf16x8& pa1, bf16x8& pa2, bf16x8& pa3) {
    float pmax = p0[0];
#pragma unroll
    for (int r = 1; r < 16; ++r) pmax = fmaxf(pmax, p0[r]);
#pragma unroll
    for (int r = 0; r < 16; ++r) pmax = fmaxf(pmax, p1[r]);
    { auto rr = __builtin_amdgcn_permlane32_swap(__float_as_uint(pmax), __float_as_uint(pmax), false, false); pmax = fmaxf(__uint_as_float(rr[0]), __uint_as_float(rr[1])); }
    alpha = 1.f;
    if (first || !__all(pmax <= THR2)) {
        const float d = first ? pmax : fmaxf(pmax, 0.f);
        m_reg += d; alpha = first ? 1.f : __builtin_amdgcn_exp2f(-d);
#pragma unroll
        for (int r = 0; r < 16; ++r) { p0[r] -= d; p1[r] -= d; negm[r] = -m_reg; }
    }
#pragma unroll
    for (int r = 0; r < 16; ++r) { p0[r] = __builtin_amdgcn_exp2f(p0[r]); p1[r] = __builtin_amdgcn_exp2f(p1[r]); }
    float ps;
    { const f32x16 s16 = p0 + p1;
      const f32x8 s8 = s16.lo + s16.hi; const f32x4 s4 = s8.lo + s8.hi; const f32x2 s2 = s4.lo + s4.hi; ps = s2[0] + s2[1]; }
    { auto rr = __builtin_amdgcn_permlane32_swap(__float_as_uint(ps), __float_as_uint(ps), false, false); ps = __uint_as_float(rr[0]) + __uint_as_float(rr[1]); }
    l_reg = l_reg * alpha + ps;
#define PK4(P, BASE, OUT) do { unsigned a0 = cvtpk(P[BASE + 0], P[BASE + 1]), a1 = cvtpk(P[BASE + 2], P[BASE + 3]); \
    unsigned b0 = cvtpk(P[BASE + 4], P[BASE + 5]), b1 = cvtpk(P[BASE + 6], P[BASE + 7]); \
    auto r0 = __builtin_amdgcn_permlane32_swap(a0, b0, false, false); auto r1 = __builtin_amdgcn_permlane32_swap(a1, b1, false, false); \
    u32x4 w = {r0[0], r1[0], r0[1], r1[1]}; OUT = __builtin_bit_cast(bf16x8, w); } while (0)
#define PKD(P, BASE, OUT) do { u32x4 w = {cvtpk(P[BASE + 0], P[BASE + 1]), cvtpk(P[BASE + 2], P[BASE + 3]), cvtpk(P[BASE + 4], P[BASE + 5]), cvtpk(P[BASE + 6], P[BASE + 7])}; OUT = __builtin_bit_cast(bf16x8, w); } while (0)
    if (SWAPK) { PK4(p0, 0, pa0); PK4(p0, 8, pa1); PK4(p1, 0, pa2); PK4(p1, 8, pa3); }
    else { PKD(p0, 0, pa0); PKD(p0, 8, pa1); PKD(p1, 0, pa2); PKD(p1, 8, pa3); }
#undef PKD
#undef PK4
}
__device__ __forceinline__ void qkt128(f32x16& p0, f32x16& p1, const LAS unsigned char* Ks, const bf16x8* qr, const f32x16& negm, int r32, int hi) {
    p0 = negm; p1 = negm;
#pragma unroll
    for (int d0 = 0; d0 < 8; ++d0) { const int cb = (d0 * 16 + hi * 8) * 2;
        const bf16x8 b0 = *(const LAS bf16x8*)(Ks + KSWZ(r32, cb)); const bf16x8 b1 = *(const LAS bf16x8*)(Ks + KSWZ(32 + r32, cb));
        p0 = __builtin_amdgcn_mfma_f32_32x32x16_bf16(b0, qr[d0], p0, 0, 0, 0); p1 = __builtin_amdgcn_mfma_f32_32x32x16_bf16(b1, qr[d0], p1, 0, 0, 0); }
}
__device__ __forceinline__ int v_st(int k, int c) { const int kk = (k & ~0xC) | ((k & 4) << 1) | ((k & 8) >> 1); return ((kk >> 3) * 4 + (c >> 5)) * 512 + ((kk & 7) * 32 + (c & 31)) * 2; }
__device__ __forceinline__ int v_rd_base(int lane) { return ((lane & 3) << 3) | (((lane >> 2) & 3) << 6) | (((lane >> 4) & 1) << 5) | (((lane >> 5) & 1) << 8); }
constexpr int v_rd_off(int d0, int ks, int half) { return d0 * 512 + ks * 4096 + half * 2048; }
template <int OFF> __device__ __forceinline__ s16x4 tr_read(int vb) { s16x4 r; asm volatile("ds_read_b64_tr_b16 %0, %1 offset:%2" : "=&v"(r) : "v"(vb), "i"(OFF) : "memory"); return r; }
template <int D0> __device__ __forceinline__ void pv_one(f32x16& od, int vb, bf16x8 pa0, bf16x8 pa1, bf16x8 pa2, bf16x8 pa3) {
    const s16x4 l0 = tr_read<v_rd_off(D0, 0, 0)>(vb), h0 = tr_read<v_rd_off(D0, 0, 1)>(vb), l1 = tr_read<v_rd_off(D0, 1, 0)>(vb), h1 = tr_read<v_rd_off(D0, 1, 1)>(vb);
    const s16x4 l2 = tr_read<v_rd_off(D0, 2, 0)>(vb), h2 = tr_read<v_rd_off(D0, 2, 1)>(vb), l3 = tr_read<v_rd_off(D0, 3, 0)>(vb), h3 = tr_read<v_rd_off(D0, 3, 1)>(vb);
    asm volatile("s_waitcnt lgkmcnt(0)" ::: "memory"); SBAR();
#define PK(L, H) (bf16x8){L[0], L[1], L[2], L[3], H[0], H[1], H[2], H[3]}
    od = __builtin_amdgcn_mfma_f32_32x32x16_bf16(pa0, PK(l0, h0), od, 0, 0, 0);
    od = __builtin_amdgcn_mfma_f32_32x32x16_bf16(pa1, PK(l1, h1), od, 0, 0, 0);
    od = __builtin_amdgcn_mfma_f32_32x32x16_bf16(pa2, PK(l2, h2), od, 0, 0, 0);
    od = __builtin_amdgcn_mfma_f32_32x32x16_bf16(pa3, PK(l3, h3), od, 0, 0, 0);
#undef PK
}

__device__ __forceinline__ void qkt64(f32x16& p0, f32x16& p1, const LAS unsigned char* Kt, const bf16x8* qr, const f32x16& negm, int r32, int hi) {
    const LAS unsigned char* kb = Kt + hi * 1024 + r32 * 16;
    p0 = negm; p1 = negm;
#pragma unroll
    for (int d0 = 0; d0 < 4; ++d0) { const bf16x8 b0 = *(const LAS bf16x8*)(kb + d0 * 2048), b1 = *(const LAS bf16x8*)(kb + d0 * 2048 + 512);
        p0 = __builtin_amdgcn_mfma_f32_32x32x16_bf16(b0, qr[d0], p0, 0, 0, 0); p1 = __builtin_amdgcn_mfma_f32_32x32x16_bf16(b1, qr[d0], p1, 0, 0, 0); }
}
template <int D0> __device__ __forceinline__ void pv64_one(f32x16& od, int vb, bf16x8 pa0, bf16x8 pa1, bf16x8 pa2, bf16x8 pa3) {
    const s16x4 l0 = tr_read<D0 * 4096 + 0>(vb), h0 = tr_read<D0 * 4096 + 512>(vb), l1 = tr_read<D0 * 4096 + 1024>(vb), h1 = tr_read<D0 * 4096 + 1536>(vb);
    const s16x4 l2 = tr_read<D0 * 4096 + 2048>(vb), h2 = tr_read<D0 * 4096 + 2560>(vb), l3 = tr_read<D0 * 4096 + 3072>(vb), h3 = tr_read<D0 * 4096 + 3584>(vb);
    asm volatile("s_waitcnt lgkmcnt(0)" ::: "memory"); SBAR();
#define PK(L, H) (bf16x8){L[0], L[1], L[2], L[3], H[0], H[1], H[2], H[3]}
    od = __builtin_amdgcn_mfma_f32_32x32x16_bf16(pa0, PK(l0, h0), od, 0, 0, 0);
    od = __builtin_amdgcn_mfma_f32_32x32x16_bf16(pa1, PK(l1, h1), od, 0, 0, 0);
    od = __builtin_amdgcn_mfma_f32_32x32x16_bf16(pa2, PK(l2, h2), od, 0, 0, 0);
    od = __builtin_amdgcn_mfma_f32_32x32x16_bf16(pa3, PK(l3, h3), od, 0, 0, 0);
#undef PK
}
constexpr int MB_K = 0, MB_V = 32768, MB_LIST = 65536, MB_WS = 81920, MB_MISC = 90112, MB_STG = 91136;
struct KVRegs { uint4 k[4], v[4]; };
__device__ __forceinline__ void moba_kv_load(KVRegs& R, const bf16_t* K, const bf16_t* V, size_t row0, int h, int tid) {
#pragma unroll
    for (int i = 0; i < 4; ++i) { const int key = tid & 255, ch = (tid >> 8) + 2 * i; R.k[i] = *(const uint4*)(K + (row0 + key) * 512 + h * 64 + ch * 8); }
#pragma unroll
    for (int i = 0; i < 4; ++i) { const int pc = tid + 512 * i, key = pc >> 3, c8 = pc & 7; R.v[i] = *(const uint4*)(V + (row0 + key) * 512 + h * 64 + c8 * 8); }
}
__device__ __forceinline__ void moba_kv_store(LAS unsigned char* lds, const KVRegs& R, int tid) {
#pragma unroll
    for (int i = 0; i < 4; ++i) { const int key = tid & 255, ch = (tid >> 8) + 2 * i;
        *(LAS u32x4*)(lds + MB_K + (key >> 6) * 8192 + ch * 1024 + (key & 63) * 16) = (u32x4){R.k[i].x, R.k[i].y, R.k[i].z, R.k[i].w}; }
#pragma unroll
    for (int i = 0; i < 4; ++i) { const int pc = tid + 512 * i, key = pc >> 3, c8 = pc & 7;
        *(LAS u32x4*)(lds + MB_V + (key >> 6) * 8192 + (c8 >> 2) * 4096 + ((key >> 4) & 3) * 1024 + (key & 15) * 64 + (c8 & 3) * 16) = (u32x4){R.v[i].x, R.v[i].y, R.v[i].z, R.v[i].w}; }
}
__device__ __forceinline__ void rescale_o2(f32x16 (&o)[2], float alpha, LAS float* wsf, int r32, int hi) {
    if (__any(alpha < 1.f)) { if (hi == 0) wsf[r32] = alpha; asm volatile("s_waitcnt lgkmcnt(0)" ::: "memory");
#pragma unroll
        for (int r = 0; r < 16; ++r) { const float al = wsf[crow(r, hi)]; o[0][r] *= al; o[1][r] *= al; }
        asm volatile("s_waitcnt lgkmcnt(0)" ::: "memory"); }
}
__device__ __forceinline__ void top3_insert(float v, int i, float& v0, int& i0, float& v1, int& i1, float& v2, int& i2) {
    const bool g0 = v > v0, g1 = v > v1, g2 = v > v2;
    v2 = g1 ? v1 : (g2 ? v : v2); i2 = g1 ? i1 : (g2 ? i : i2);
    v1 = g0 ? v0 : (g1 ? v : v1); i1 = g0 ? i0 : (g1 ? i : i1);
    v0 = g0 ? v : v0; i0 = g0 ? i : i0;
}
__device__ __forceinline__ void sel_phase(const bf16_t* __restrict__ Q, const float* __restrict__ KMP, signed char* __restrict__ SEL) {
    const int tid = threadIdx.x, lane = tid & 63, wid = tid >> 6, r32 = lane & 31, hi = lane >> 5;
    const int gw = blockIdx.x * 8 + wid, NGW = gridDim.x * 8;
    for (int wu = gw; wu < 64 * 32; wu += NGW) {
        const int bh = wu & 63, qb = wu >> 6, b = bh >> 3, h = bh & 7;
        if (qb == 0) {
#pragma unroll
            for (int g = 0; g < 4; ++g) ((unsigned*)SEL)[(size_t)(b * 8 + h) * SEQ + g * 64 + lane] = 0xffffffffu;
            continue;
        }
        bf16x8 ka[4];
        { const float* kp = KMP + (size_t)(b * 32 + r32) * 1024 + h * 64 + hi * 8;
#pragma unroll
          for (int ks = 0; ks < 4; ++ks) { const f32x4 a0 = *(const f32x4*)(kp + ks * 16), a1 = *(const f32x4*)(kp + ks * 16 + 4), c0 = *(const f32x4*)(kp + 512 + ks * 16), c1 = *(const f32x4*)(kp + 512 + ks * 16 + 4);
              const f32x4 s0 = (a0 + c0) * (1.f / 256.f), s1 = (a1 + c1) * (1.f / 256.f);
              const u32x4 w = {cvtpk(s0[0], s0[1]), cvtpk(s0[2], s0[3]), cvtpk(s1[0], s1[1]), cvtpk(s1[2], s1[3])}; ka[ks] = __builtin_bit_cast(bf16x8, w); } }
#pragma unroll 1
        for (int gp = 0; gp < 2; ++gp) {
            bf16x8 qf[4][4];
#pragma unroll
            for (int g = 0; g < 4; ++g)
#pragma unroll
                for (int ks = 0; ks < 4; ++ks) qf[g][ks] = *(const bf16x8*)(Q + ((size_t)b * SEQ + qb * 256 + (gp * 4 + g) * 32 + r32) * 512 + h * 64 + ks * 16 + hi * 8);
#pragma unroll
            for (int g = 0; g < 4; ++g) {
                f32x16 acc = {};
#pragma unroll
                for (int ks = 0; ks < 4; ++ks) acc = __builtin_amdgcn_mfma_f32_32x32x16_bf16(ka[ks], qf[g][ks], acc, 0, 0, 0);
                float v0 = -3e38f, v1 = -3e38f, v2 = -3e38f; int i0 = -1, i1 = -1, i2 = -1;
#pragma unroll
                for (int r = 0; r < 16; ++r) { const int n = crow(r, hi); if (n < qb) top3_insert(acc[r], n, v0, i0, v1, i1, v2, i2); }
                float pv[3] = {v0, v1, v2}; int pi[3] = {i0, i1, i2};
#pragma unroll
                for (int k = 0; k < 3; ++k) { auto rv = __builtin_amdgcn_permlane32_swap(__float_as_uint(pv[k]), __float_as_uint(pv[k]), false, false); auto ri = __builtin_amdgcn_permlane32_swap((unsigned)pi[k], (unsigned)pi[k], false, false);
                    const float ov = __uint_as_float(hi ? rv[0] : rv[1]); const int oi = (int)(hi ? ri[0] : ri[1]);
                    if (oi >= 0) top3_insert(ov, oi, v0, i0, v1, i1, v2, i2); }
                if (hi == 0) ((unsigned*)SEL)[(size_t)(b * 8 + h) * SEQ + qb * 256 + (gp * 4 + g) * 32 + r32] = (unsigned)(i0 & 0xff) | ((unsigned)(i1 & 0xff) << 8) | ((unsigned)(i2 & 0xff) << 16) | 0xff000000u;
            }
        }
    }
}
__device__ __forceinline__ void moba_sel_phase(LAS unsigned char* lds, const bf16_t* Q, const bf16_t* K, const bf16_t* V, const signed char* SEL, bf16_t* PART, float* ML, unsigned* qctr) {
    const int tid = threadIdx.x, wid = tid >> 6, lane = tid & 63, r32 = lane & 31, hi = lane >> 5;
    LAS float* wsf = (LAS float*)(lds + MB_WS + wid * 1024); LAS int* wsd = (LAS int*)(wsf + 64);
    LAS unsigned* misc = (LAS unsigned*)(lds + MB_MISC); LAS unsigned short* list = (LAS unsigned short*)(lds + MB_LIST);
    const int vb0 = (int)(uintptr_t)(lds + MB_V) + ((lane >> 4) & 1) * 32 + (lane & 3) * 8 + (4 * hi + ((lane & 15) >> 2)) * 64;
    constexpr int NU = 31 * 64;
    if (tid == 0) misc[2] = __hip_atomic_fetch_add(qctr, 1u, __ATOMIC_RELAXED, __HIP_MEMORY_SCOPE_AGENT);
    __syncthreads();
    int u = (int)misc[2];
    KVRegs R;
    if (u < NU) moba_kv_load(R, K, V, (size_t)((u & 63) >> 3) * SEQ + (size_t)(u >> 6) * 256, u & 7, tid);
    while (u < NU) {
        const int n = u >> 6, bh = u & 63, b = bh >> 3, h = bh & 7;
        __syncthreads();
        moba_kv_store(lds, R, tid);
        if (tid == 0) { misc[1] = 0u; misc[2] = __hip_atomic_fetch_add(qctr, 1u, __ATOMIC_RELAXED, __HIP_MEMORY_SCOPE_AGENT); }
        unsigned sv[16];
#pragma unroll
        for (int i = 0; i < 16; ++i) { const int pos = 256 * (n + 1) + i * 512 + tid; sv[i] = ((const unsigned*)SEL)[(size_t)(b * 8 + h) * SEQ + (pos < SEQ ? pos : SEQ - 1)]; }
        __syncthreads();
#pragma unroll
        for (int i = 0; i < 16; ++i) { const int base = 256 * (n + 1) + i * 512;
            if (base < SEQ) { const int pos = base + tid; int slot = -1;
                if (pos < SEQ) slot = ((sv[i] & 0xff) == (unsigned)n) ? 0 : (((sv[i] >> 8) & 0xff) == (unsigned)n) ? 1 : (((sv[i] >> 16) & 0xff) == (unsigned)n) ? 2 : -1;
                const unsigned long long bal = __ballot(slot >= 0);
                const int tot = __popcll(bal), pre = __popcll(bal & ((1ull << lane) - 1ull));
                unsigned off = 0; if (lane == 0 && tot) off = __hip_atomic_fetch_add(misc + 1, (unsigned)tot, __ATOMIC_RELAXED, __HIP_MEMORY_SCOPE_WORKGROUP);
                off = __builtin_amdgcn_readfirstlane(off);
                if (slot >= 0) list[off + pre] = (unsigned short)((pos << 2) | slot); } }
        __syncthreads();
        const int unext = (int)misc[2];
        if (unext < NU) moba_kv_load(R, K, V, (size_t)((unext & 63) >> 3) * SEQ + (size_t)(unext >> 6) * 256, unext & 7, tid);
        const int cnt = (int)misc[1], nbatch = (cnt + 31) >> 5;
        unsigned en = 0; bf16x8 qn[4];
        if (wid < nbatch) { const int li0 = wid * 32 + r32; en = list[li0 < cnt ? li0 : cnt - 1];
#pragma unroll
            for (int d0 = 0; d0 < 4; ++d0) qn[d0] = *(const bf16x8*)(Q + ((size_t)b * SEQ + (en >> 2)) * 512 + h * 64 + d0 * 16 + hi * 8); }
        for (int bt = wid; bt < nbatch; bt += 8) {
            const int li = bt * 32 + r32; const bool valid = li < cnt; const unsigned e = en;
            const int pos = e >> 2, slot = e & 3; const size_t t = (size_t)b * SEQ + pos;
            bf16x8 qr[4];
#pragma unroll
            for (int d0 = 0; d0 < 4; ++d0) qr[d0] = qn[d0];
            { const int btn = (bt + 8 < nbatch) ? bt + 8 : bt; const int lin = btn * 32 + r32; en = list[lin < cnt ? lin : cnt - 1];
#pragma unroll
              for (int d0 = 0; d0 < 4; ++d0) qn[d0] = *(const bf16x8*)(Q + ((size_t)b * SEQ + (en >> 2)) * 512 + h * 64 + d0 * 16 + hi * 8); }
            float m_reg = 0.f, l_reg = 0.f; f32x16 o[2] = {}; f32x16 negm = {};
#pragma unroll
            for (int kt = 0; kt < 4; ++kt) {
                f32x16 p0, p1; float alpha; bf16x8 pa0, pa1, pa2, pa3;
                qkt64(p0, p1, lds + MB_K + kt * 8192, qr, negm, r32, hi);
                softmax_tile<false>(p0, p1, m_reg, l_reg, alpha, negm, kt == 0, pa0, pa1, pa2, pa3);
                rescale_o2(o, alpha, wsf, r32, hi);
                pv64_one<0>(o[0], vb0 + kt * 8192, pa0, pa1, pa2, pa3); pv64_one<1>(o[1], vb0 + kt * 8192, pa0, pa1, pa2, pa3);
            }
            const int dst = valid ? (int)((t * 8 + h) * 3 + slot) : -1;
            if (hi == 0) { wsf[32 + r32] = l_reg; wsd[r32] = dst; if (valid) *(float2*)(ML + (size_t)dst * 2) = make_float2(m_reg, l_reg); }
            asm volatile("s_waitcnt lgkmcnt(0)" ::: "memory");
            LAS bf16_t* stg = (LAS bf16_t*)(lds + MB_STG + wid * 4096);
#pragma unroll
            for (int r = 0; r < 16; ++r) { const int orow = crow(r, hi); const float rl = __builtin_amdgcn_rcpf(wsf[32 + orow]);
                stg[orow * 64 + r32] = f2bf(o[0][r] * rl); stg[orow * 64 + 32 + r32] = f2bf(o[1][r] * rl); }
            asm volatile("s_waitcnt lgkmcnt(0)" ::: "memory");
#pragma unroll
            for (int i = 0; i < 4; ++i) { const int row = i * 8 + (lane >> 3), pcs = lane & 7; const u32x4 v = *(const LAS u32x4*)(stg + row * 64 + pcs * 8); const int dd = wsd[row];
                if (dd >= 0) *(u32x4*)(PART + (size_t)dd * 64 + pcs * 8) = v; }
            asm volatile("s_waitcnt lgkmcnt(0)" ::: "memory");
        }
        u = unext;
    }
}
__device__ __forceinline__ void moba_own_phase(LAS unsigned char* lds, const bf16_t* Q, const bf16_t* K, const bf16_t* V, const signed char* SEL, const bf16_t* PART, const float* ML, bf16_t* ATT) {
    const int tid = threadIdx.x, wid = tid >> 6, lane = tid & 63, r32 = lane & 31, hi = lane >> 5;
    LAS float* wsf = (LAS float*)(lds + MB_WS + wid * 1024);
    const int vb0 = (int)(uintptr_t)(lds + MB_V) + ((lane >> 4) & 1) * 32 + (lane & 3) * 8 + (4 * hi + ((lane & 15) >> 2)) * 64;
    KVRegs R;
    if ((int)blockIdx.x < 64 * 32) moba_kv_load(R, K, V, (size_t)((blockIdx.x & 63) >> 3) * SEQ + (size_t)(blockIdx.x >> 6) * 256, blockIdx.x & 7, tid);
    for (int u = blockIdx.x; u < 64 * 32; u += gridDim.x) {
        const int bh = u & 63, n = u >> 6, b = bh >> 3, h = bh & 7;
        __syncthreads();
        moba_kv_store(lds, R, tid);
        __syncthreads();
        { const int un = u + gridDim.x; if (un < 64 * 32) moba_kv_load(R, K, V, (size_t)((un & 63) >> 3) * SEQ + (size_t)(un >> 6) * 256, un & 7, tid); }
        const size_t t0 = (size_t)b * SEQ + (size_t)n * 256 + wid * 32, t = t0 + r32;
        bf16x8 qr[4];
#pragma unroll
        for (int d0 = 0; d0 < 4; ++d0) qr[d0] = *(const bf16x8*)(Q + t * 512 + h * 64 + d0 * 16 + hi * 8);
        float m_reg = 0.f, l_reg = 0.f; f32x16 o[2] = {}; f32x16 negm = {};
        const int ntile = (wid >> 1) + 1, rowa = wid * 32 + r32;
#pragma unroll
        for (int kt = 0; kt < 4; ++kt) { if (kt >= ntile) break;
            f32x16 p0, p1; float alpha; bf16x8 pa0, pa1, pa2, pa3;
            qkt64(p0, p1, lds + MB_K + kt * 8192, qr, negm, r32, hi);
            if (kt == ntile - 1) {
#pragma unroll
                for (int r = 0; r < 16; ++r) { const int ka = 64 * kt + crow(r, hi); if (ka > rowa) p0[r] = -1e30f; if (ka + 32 > rowa) p1[r] = -1e30f; } }
            softmax_tile<false>(p0, p1, m_reg, l_reg, alpha, negm, kt == 0, pa0, pa1, pa2, pa3);
            rescale_o2(o, alpha, wsf, r32, hi);
            pv64_one<0>(o[0], vb0 + kt * 8192, pa0, pa1, pa2, pa3); pv64_one<1>(o[1], vb0 + kt * 8192, pa0, pa1, pa2, pa3);
        }
        u32x4 pr[4][3];
#pragma unroll
        for (int i = 0; i < 4; ++i) { const int row = i * 8 + (lane >> 3), pcs = lane & 7;
#pragma unroll
            for (int q = 0; q < 3; ++q) pr[i][q] = *(const u32x4*)(PART + (((t0 + row) * 8 + h) * 3 + q) * 64 + pcs * 8); }
        const unsigned sv = ((const unsigned*)SEL)[(size_t)(b * 8 + h) * SEQ + n * 256 + wid * 32 + r32];
        float2 mlv[3];
#pragma unroll
        for (int i = 0; i < 3; ++i) mlv[i] = *(const float2*)(ML + ((t * 8 + h) * 3 + i) * 2);
        float mi[3], li[3]; float M = m_reg;
#pragma unroll
        for (int i = 0; i < 3; ++i) { const bool v = ((sv >> (8 * i)) & 0x80u) == 0u; mi[i] = v ? mlv[i].x : -1e30f; li[i] = v ? mlv[i].y : 0.f; M = fmaxf(M, mi[i]); }
        const float wo = __builtin_amdgcn_exp2f(m_reg - M); float L = l_reg * wo; float wi[3];
#pragma unroll
        for (int i = 0; i < 3; ++i) { wi[i] = li[i] * __builtin_amdgcn_exp2f(mi[i] - M); L += wi[i]; }
        const float rL = 1.f / L;
        if (hi == 0) { wsf[32 + r32] = wo * rL; wsf[64 + r32] = wi[0] * rL; wsf[96 + r32] = wi[1] * rL; wsf[128 + r32] = wi[2] * rL; }
        asm volatile("s_waitcnt lgkmcnt(0)" ::: "memory");
        LAS bf16_t* stg = (LAS bf16_t*)(lds + MB_STG + wid * 4096);
#pragma unroll
        for (int r = 0; r < 16; ++r) { const int orow = crow(r, hi); const float a0 = wsf[32 + orow];
            stg[orow * 64 + r32] = f2bf(o[0][r] * a0); stg[orow * 64 + 32 + r32] = f2bf(o[1][r] * a0); }
        asm volatile("s_waitcnt lgkmcnt(0)" ::: "memory");
#pragma unroll
        for (int i = 0; i < 4; ++i) { const int row = i * 8 + (lane >> 3), pcs = lane & 7;
            const u32x4 own = *(const LAS u32x4*)(stg + row * 64 + pcs * 8); const float a1 = wsf[64 + row], a2 = wsf[96 + row], a3 = wsf[128 + row];
            float v[8];
#pragma unroll
            for (int q = 0; q < 4; ++q) { v[2 * q] = __uint_as_float(own[q] << 16); v[2 * q + 1] = __uint_as_float(own[q] & 0xffff0000u); }
#pragma unroll
            for (int q = 0; q < 4; ++q) {
                v[2 * q]     += (a1 != 0.f ? a1 * __uint_as_float(pr[i][0][q] << 16) : 0.f) + (a2 != 0.f ? a2 * __uint_as_float(pr[i][1][q] << 16) : 0.f) + (a3 != 0.f ? a3 * __uint_as_float(pr[i][2][q] << 16) : 0.f);
                v[2 * q + 1] += (a1 != 0.f ? a1 * __uint_as_float(pr[i][0][q] & 0xffff0000u) : 0.f) + (a2 != 0.f ? a2 * __uint_as_float(pr[i][1][q] & 0xffff0000u) : 0.f) + (a3 != 0.f ? a3 * __uint_as_float(pr[i][2][q] & 0xffff0000u) : 0.f); }
            *(u32x4*)(ATT + (t0 + row) * 1024 + h * 64 + pcs * 8) = (u32x4){pk2(v[0], v[1]), pk2(v[2], v[3]), pk2(v[4], v[5]), pk2(v[6], v[7])}; }
        asm volatile("s_waitcnt lgkmcnt(0)" ::: "memory");
    }
    __syncthreads();
}
__device__ __forceinline__ void gmlp_phase(LAS unsigned char* lds, const bf16_t* U, const bf16_t* GV, const bf16_t* WM, const float* ng, const float* bs, bf16_t* ATTGM) {
    const int tid = threadIdx.x, wid = tid >> 6, lane = tid & 63, r32 = lane & 31, hi = lane >> 5;
    const int tb = wid & 3, hf = wid >> 2;
    for (int c = blockIdx.x; c < T_TOK / 128; c += gridDim.x) {
        const size_t t0 = (size_t)c * 128;
        __syncthreads();
        {
            uint4 v[16];
#pragma unroll
            for (int i = 0; i < 16; ++i) v[i] = *(const uint4*)(GV + (t0 + wid * 16 + i) * 512 + lane * 8);
#pragma unroll
            for (int i = 0; i < 16; ++i) { const int sidx = wid * 16 + i;
                float f[8]; f[0] = __uint_as_float(v[i].x << 16); f[1] = __uint_as_float(v[i].x & 0xffff0000u); f[2] = __uint_as_float(v[i].y << 16); f[3] = __uint_as_float(v[i].y & 0xffff0000u);
                f[4] = __uint_as_float(v[i].z << 16); f[5] = __uint_as_float(v[i].z & 0xffff0000u); f[6] = __uint_as_float(v[i].w << 16); f[7] = __uint_as_float(v[i].w & 0xffff0000u);
                float ss = 0.f;
#pragma unroll
                for (int e = 0; e < 8; ++e) ss += f[e] * f[e];
                const float rs = rsqrtf(wave_sum(ss) * (1.f / 512.f) + EPS);
                const u32x4 w = {cvtpk(f[0] * rs, f[1] * rs), cvtpk(f[2] * rs, f[3] * rs), cvtpk(f[4] * rs, f[5] * rs), cvtpk(f[6] * rs, f[7] * rs)};
                *(LAS u32x4*)(lds + (lane >> 4) * 32768 + (sidx >> 6) * 16384 + v_st(sidx & 63, (lane & 15) * 8)) = w; }
        }
        __syncthreads();
#pragma unroll 1
        for (int slab = 0; slab < 4; ++slab) {
            const int g = slab * 2 + hf;
            bf16x8 pa[8];
#pragma unroll
            for (int ks = 0; ks < 8; ++ks) pa[ks] = *(const bf16x8*)(WM + ((size_t)(g * 128 + tb * 32 + r32)) * 128 + ks * 16 + hi * 8);
            f32x16 o[2] = {};
            const int vb = (int)(uintptr_t)lds + slab * 32768 + hf * 1024 + v_rd_base(lane);
            const int c0 = slab * 128 + hf * 64 + r32;
            const float ng0 = ng[c0], ng1 = ng[c0 + 32];
            float bbv[16]; bf16_t u0[16], u1[16];
#pragma unroll
            for (int r = 0; r < 16; ++r) { const int tt = tb * 32 + crow(r, hi); bbv[r] = bs[g * 128 + tt]; const bf16_t* up = U + (t0 + tt) * 512 + c0; u0[r] = up[0]; u1[r] = up[32]; }
#define GSTEP(KS) if ((KS) <= 2 * tb + 1) { \
                const s16x4 l0 = tr_read<((KS) >> 2) * 16384 + v_rd_off(0, (KS) & 3, 0)>(vb), h0 = tr_read<((KS) >> 2) * 16384 + v_rd_off(0, (KS) & 3, 1)>(vb); \
                const s16x4 l1 = tr_read<((KS) >> 2) * 16384 + v_rd_off(1, (KS) & 3, 0)>(vb), h1 = tr_read<((KS) >> 2) * 16384 + v_rd_off(1, (KS) & 3, 1)>(vb); \
                asm volatile("s_waitcnt lgkmcnt(0)" ::: "memory"); SBAR(); \
                o[0] = __builtin_amdgcn_mfma_f32_32x32x16_bf16(pa[KS], ((bf16x8){l0[0], l0[1], l0[2], l0[3], h0[0], h0[1], h0[2], h0[3]}), o[0], 0, 0, 0); \
                o[1] = __builtin_amdgcn_mfma_f32_32x32x16_bf16(pa[KS], ((bf16x8){l1[0], l1[1], l1[2], l1[3], h1[0], h1[1], h1[2], h1[3]}), o[1], 0, 0, 0); }
            GSTEP(0) GSTEP(1) GSTEP(2) GSTEP(3) GSTEP(4) GSTEP(5) GSTEP(6) GSTEP(7)
#undef GSTEP
#pragma unroll
            for (int r = 0; r < 16; ++r) { const int tt = tb * 32 + crow(r, hi); const float bb = bbv[r];
                bf16_t* op = ATTGM + (t0 + tt) * 1024 + 512 + c0;
                op[0] = f2bf(bf2f(u0[r]) * (o[0][r] * ng0 + bb)); op[32] = f2bf(bf2f(u1[r]) * (o[1][r] * ng1 + bb)); }
        }
    }
    __syncthreads();
}
constexpr int XA_K = 0, XA_V = 65536, XA_WS = 131072;
__device__ __forceinline__ void xattn_phase(LAS unsigned char* lds, const bf16_t* XQ, const bf16_t* XKV, bf16_t* XO) {
    const int tid = threadIdx.x, wid = tid >> 6, lane = tid & 63, r32 = lane & 31, hi = lane >> 5;
    LAS float* wsf = (LAS float*)(lds + XA_WS) + wid * 64;
    const int vb0 = (int)(uintptr_t)(lds + XA_V) + v_rd_base(lane);
    int staged = -1;
    for (int u = blockIdx.x; u < 32 * 32; u += gridDim.x) {
        const int bh = u & 31, tile = u >> 5, b = bh >> 2, h = bh & 3;
        if (bh != staged) {
            __syncthreads();
            const int sr = tid >> 4, sc = (tid & 15) * 8;
#pragma unroll
            for (int i = 0; i < 8; ++i) { const int key = i * 32 + sr; const bf16_t* src = XKV + (size_t)(b * NMEM + key) * 1024 + h * 128 + sc;
                const uint4 kv = *(const uint4*)src, vv = *(const uint4*)(src + 512);
                *(LAS u32x4*)(lds + XA_K + (key >> 6) * 16384 + KSWZ(key & 63, sc * 2)) = (u32x4){kv.x, kv.y, kv.z, kv.w};
                *(LAS u32x4*)(lds + XA_V + (key >> 6) * 16384 + v_st(key & 63, sc)) = (u32x4){vv.x, vv.y, vv.z, vv.w}; }
            __syncthreads(); staged = bh;
        }
        const size_t t0 = (size_t)b * SEQ + tile * 256 + wid * 32;
        bf16x8 qr[8];
#pragma unroll
        for (int d0 = 0; d0 < 8; ++d0) qr[d0] = *(const bf16x8*)(XQ + (t0 + r32) * 512 + h * 128 + d0 * 16 + hi * 8);
        float m_reg = 0.f, l_reg = 0.f; f32x16 o[4] = {}; f32x16 negm = {};
#pragma unroll
        for (int kt = 0; kt < 4; ++kt) {
            f32x16 p0, p1; float alpha; bf16x8 pa0, pa1, pa2, pa3;
            qkt128(p0, p1, lds + XA_K + kt * 16384, qr, negm, r32, hi);
            softmax_tile<true>(p0, p1, m_reg, l_reg, alpha, negm, kt == 0, pa0, pa1, pa2, pa3);
            if (__any(alpha < 1.f)) { if (hi == 0) wsf[r32] = alpha; asm volatile("s_waitcnt lgkmcnt(0)" ::: "memory");
#pragma unroll
                for (int r = 0; r < 16; ++r) { const float al = wsf[crow(r, hi)];
#pragma unroll
                    for (int d = 0; d < 4; ++d) o[d][r] *= al; }
                asm volatile("s_waitcnt lgkmcnt(0)" ::: "memory"); }
            const int vb = vb0 + kt * 16384;
            pv_one<0>(o[0], vb, pa0, pa1, pa2, pa3); pv_one<1>(o[1], vb, pa0, pa1, pa2, pa3); pv_one<2>(o[2], vb, pa0, pa1, pa2, pa3); pv_one<3>(o[3], vb, pa0, pa1, pa2, pa3);
        }
        if (hi == 0) wsf[32 + r32] = l_reg; asm volatile("s_waitcnt lgkmcnt(0)" ::: "memory");
#pragma unroll
        for (int r = 0; r < 16; ++r) { const int orow = crow(r, hi); const float rl = __builtin_amdgcn_rcpf(wsf[32 + orow]);
            bf16_t* op = XO + (t0 + orow) * 512 + h * 128 + r32;
#pragma unroll
            for (int d0 = 0; d0 < 4; ++d0) op[d0 * 32] = f2bf(o[d0][r] * rl); }
        asm volatile("s_waitcnt lgkmcnt(0)" ::: "memory");
    }
    __syncthreads();
}
}

namespace peer {
typedef unsigned u32x4 __attribute__((ext_vector_type(4)));
typedef short bf16x8 __attribute__((ext_vector_type(8)));
typedef float f32x16 __attribute__((ext_vector_type(16)));
typedef float f32x4 __attribute__((ext_vector_type(4)));
typedef __bf16 bf16x2 __attribute__((ext_vector_type(2)));
#define KSWZ(row, colB) ((row) * 256 + ((colB) ^ (((row) & 7) << 4)))
__device__ __forceinline__ int crow(int r, int hi) { return (r & 3) + 8 * (r >> 2) + 4 * hi; }
__device__ __forceinline__ unsigned ord_key(float f) { const unsigned b = __float_as_uint(f); return b ^ ((unsigned)((int)b >> 31) | 0x80000000u); }
__device__ __forceinline__ float ord_inv(unsigned o) { return __uint_as_float(o ^ ((unsigned)((int)(~o) >> 31) | 0x80000000u)); }
__device__ __forceinline__ unsigned selu(unsigned m, unsigned a, unsigned b) { return (a & m) | (b & ~m); }
__device__ __forceinline__ unsigned umax_(unsigned a, unsigned b) { return (int)a > (int)b ? a : b; }
__device__ __forceinline__ unsigned umin_(unsigned a, unsigned b) { return (int)a < (int)b ? a : b; }
template <int OFF, int A, int B> __device__ __forceinline__ void ce_desc(unsigned (&k)[64]) { const unsigned a = k[OFF + A], b = k[OFF + B]; k[OFF + A] = umax_(a, b); k[OFF + B] = umin_(a, b); }
template <int OFF> __device__ __forceinline__ void sort16_desc(unsigned (&k)[64]) {
#define CE(a, b) ce_desc<OFF, a, b>(k);
    CE(0,13) CE(1,12) CE(2,15) CE(3,14) CE(4,8) CE(5,6) CE(7,11) CE(9,10)
    CE(0,5) CE(1,7) CE(2,9) CE(3,4) CE(6,13) CE(8,14) CE(10,15) CE(11,12)
    CE(0,1) CE(2,3) CE(4,5) CE(6,8) CE(7,9) CE(10,11) CE(12,13) CE(14,15)
    CE(0,2) CE(1,3) CE(4,10) CE(5,11) CE(6,7) CE(8,9) CE(12,14) CE(13,15)
    CE(1,2) CE(3,12) CE(4,6) CE(5,7) CE(8,10) CE(9,11) CE(13,14)
    CE(1,4) CE(2,6) CE(5,8) CE(7,10) CE(9,13) CE(11,14)
    CE(2,4) CE(3,6) CE(9,12) CE(11,13)
    CE(3,5) CE(6,8) CE(7,9) CE(10,12)
    CE(3,4) CE(5,6) CE(7,8) CE(9,10) CE(11,12)
    CE(6,7) CE(8,9)
#undef CE
}
template <int OFF> __device__ __forceinline__ void merge16_desc(unsigned (&k)[64]) {
#pragma unroll
    for (int stride = 8; stride > 0; stride >>= 1)
#pragma unroll
        for (int i = 0; i < 16; ++i) { const int j = i ^ stride; if (j > i) { const unsigned a = k[OFF + i], b = k[OFF + j]; k[OFF + i] = umax_(a, b); k[OFF + j] = umin_(a, b); } }
}
template <int A, int B> __device__ __forceinline__ void top16_merge(unsigned (&k)[64]) {
#pragma unroll
    for (int i = 0; i < 16; ++i) k[A + i] = umax_(k[A + i], k[B + 15 - i]);
    merge16_desc<A>(k);
}
__device__ __forceinline__ void top16_of_64(unsigned (&k)[64]) {
    sort16_desc<0>(k); sort16_desc<16>(k); sort16_desc<32>(k); sort16_desc<48>(k);
    top16_merge<0, 16>(k); top16_merge<32, 48>(k); top16_merge<0, 32>(k);
}
__device__ __forceinline__ void top16_of_cand(unsigned (&k)[64]) {
    sort16_desc<0>(k); sort16_desc<16>(k); sort16_desc<32>(k); ce_desc<48, 0, 1>(k);
    top16_merge<0, 16>(k);
    k[46] = umax_(k[46], k[49]); k[47] = umax_(k[47], k[48]); merge16_desc<32>(k);
#pragma unroll
    for (int i = 0; i < 16; ++i) k[i] = umax_(k[i], k[32 + 15 - i]);
}
__device__ __forceinline__ void partner_merge(unsigned (&k)[64], int hi) {
    unsigned pr[16];
#pragma unroll
    for (int i = 0; i < 16; ++i) { const unsigned t = k[15 - i]; auto rr = __builtin_amdgcn_permlane32_swap(t, t, false, false); pr[i] = selu(0u - (unsigned)hi, rr[0], rr[1]); }
#pragma unroll
    for (int i = 0; i < 16; ++i) k[i] = umax_(k[i], pr[i]);
    merge16_desc<0>(k);
}
constexpr int cand_slot(int i, int j) { int n = 0; for (int a = 0; a < 16; ++a) for (int b = 0; b < 16; ++b) { if (a == i && b == j) return n; if ((a + 1) * (b + 1) <= 16) ++n; } return n; }
static_assert(cand_slot(15, 0) == 49, "50 candidates");
constexpr float TK_BIAS = 48.f;
__device__ __forceinline__ unsigned pos_key(float biased) { return __float_as_uint(biased); }
constexpr int TK_LDS_SK = 0, TK_LDS_IDX = 65536, TK_LDS_BYTES = 65536 + 8 * 32 * 32;
__device__ __forceinline__ void sk_tile(f32x16& p0, f32x16& p1, const LAS unsigned char* Ks, const bf16x8* qr, int r32, int hi) {
    p0 = f32x16{}; p1 = f32x16{};
#pragma unroll
    for (int d0 = 0; d0 < 8; ++d0) { const int cb = (d0 * 16 + hi * 8) * 2;
        const bf16x8 b0 = *(const LAS bf16x8*)(Ks + KSWZ(r32, cb)); const bf16x8 b1 = *(const LAS bf16x8*)(Ks + KSWZ(32 + r32, cb));
        p0 = __builtin_amdgcn_mfma_f32_32x32x16_bf16(b0, qr[d0], p0, 0, 0, 0); p1 = __builtin_amdgcn_mfma_f32_32x32x16_bf16(b1, qr[d0], p1, 0, 0, 0); }
}
__device__ __forceinline__ void topk_loadq(bf16x8 (&qa)[8], bf16x8 (&qb)[8], const bf16_t* QP, int t, int h, int hi) {
#pragma unroll
    for (int d0 = 0; d0 < 8; ++d0) { qa[d0] = *(const bf16x8*)(QP + (size_t)t * 2048 + h * 256 + d0 * 16 + hi * 8); qb[d0] = *(const bf16x8*)(QP + (size_t)t * 2048 + h * 256 + 128 + d0 * 16 + hi * 8); }
}
__device__ __forceinline__ void topk_half(unsigned (&top)[16], const LAS unsigned char* lds, const bf16x8 (&qr)[8], int p, int r32, int hi) {
    unsigned k[64];
#pragma unroll
    for (int tl = 0; tl < 2; ++tl) { f32x16 p0, p1; sk_tile(p0, p1, lds + TK_LDS_SK + (p * 2 + tl) * 16384, qr, r32, hi); p0 = p0 + TK_BIAS; p1 = p1 + TK_BIAS;
#pragma unroll
        for (int r = 0; r < 16; ++r) { k[tl * 32 + r] = (pos_key(p0[r]) & ~0x7Fu) | (unsigned)(tl * 64 + crow(r, hi)); k[tl * 32 + 16 + r] = (pos_key(p1[r]) & ~0x7Fu) | (unsigned)(tl * 64 + 32 + crow(r, hi)); } }
    top16_of_64(k); partner_merge(k, hi);
#pragma unroll
    for (int i = 0; i < 16; ++i) top[i] = k[i];
}
__device__ __forceinline__ void topk_phase(LAS unsigned char* lds, const bf16_t* QP, const bf16_t* SK, unsigned short* PID, float* PW) {
    const int tid = threadIdx.x, lane = tid & 63, wid = tid >> 6, r32 = lane & 31, hi = lane >> 5;
    LAS unsigned char* idxl = lds + TK_LDS_IDX + wid * 1024 + r32 * 32;
    int staged_h = -1;
    bf16x8 qa[8], qb[8];
    if ((int)blockIdx.x < 8 * 256) topk_loadq(qa, qb, QP, (int)(blockIdx.x >> 3) * 256 + wid * 32 + r32, blockIdx.x & 7, hi);
    for (int u = blockIdx.x; u < 8 * 256; u += gridDim.x) {
        const int h = u & 7, tile = u >> 3;
        if (h != staged_h) {
            __syncthreads();
            for (int pc = tid; pc < 4096; pc += 512) { const int row = pc >> 4, ch = pc & 15;
                const uint4 v = *(const uint4*)(SK + ((size_t)h * 256 + row) * 128 + ch * 8);
                *(LAS u32x4*)(lds + TK_LDS_SK + (row >> 6) * 16384 + KSWZ(row & 63, ch * 16)) = (u32x4){v.x, v.y, v.z, v.w}; }
            __syncthreads(); staged_h = h;
        }
        const int t = tile * 256 + wid * 32 + r32;
        const unsigned hm = 0u - (unsigned)hi;
        unsigned top0[16], top1[16];
        topk_half(top0, lds, qa, 0, r32, hi);
        topk_half(top1, lds, qb, 1, r32, hi);
        { const int un = (u + (int)gridDim.x < 8 * 256) ? u + (int)gridDim.x : u; topk_loadq(qa, qb, QP, (un >> 3) * 256 + wid * 32 + r32, un & 7, hi); }
        { unsigned w[4];
#pragma unroll
          for (int q = 0; q < 4; ++q) { const unsigned a0 = selu(hm, top1[4 * q], top0[4 * q]), a1 = selu(hm, top1[4 * q + 1], top0[4 * q + 1]), a2 = selu(hm, top1[4 * q + 2], top0[4 * q + 2]), a3 = selu(hm, top1[4 * q + 3], top0[4 * q + 3]);
              w[q] = (a0 & 0x7Fu) | ((a1 & 0x7Fu) << 8) | ((a2 & 0x7Fu) << 16) | ((a3 & 0x7Fu) << 24); }
          *(LAS u32x4*)(idxl + hi * 16) = (u32x4){w[0], w[1], w[2], w[3]}; }
        float f1[16], f2[16];
#pragma unroll
        for (int i = 0; i < 16; ++i) { f1[i] = __uint_as_float(top0[i] & ~0x7Fu); f2[i] = __uint_as_float(top1[i] & ~0x7Fu) - TK_BIAS; }
        unsigned k[64];
#pragma unroll
        for (int i = 0; i < 16; ++i)
#pragma unroll
            for (int j = 0; j < 16; ++j) if ((i + 1) * (j + 1) <= 16) k[cand_slot(i, j)] = (pos_key(f1[i] + f2[j]) & ~0xFFu) | (unsigned)(i * 16 + j);
        top16_of_cand(k);
        float sv[16], den = 0.f; const float s0 = __uint_as_float(k[0] & ~0xFFu);
#pragma unroll
        for (int i = 0; i < 16; ++i) { sv[i] = __expf(__uint_as_float(k[i] & ~0xFFu) - s0); den += sv[i]; }
        const float rden = 1.f / den;
        asm volatile("s_waitcnt lgkmcnt(0)" ::: "memory");
        int ids[8]; float ws_[8];
#pragma unroll
        for (int i = 0; i < 8; ++i) { const unsigned kk = selu(hm, k[8 + i], k[i]); const int ci = (kk >> 4) & 15, cj = kk & 15;
            const int i1 = *(const LAS unsigned char*)(idxl + ci), i2 = *(const LAS unsigned char*)(idxl + 16 + cj);
            ids[i] = i1 * 128 + i2; ws_[i] = __uint_as_float(selu(hm, __float_as_uint(sv[8 + i]), __float_as_uint(sv[i]))) * rden; }
        unsigned short* po = PID + ((size_t)t * 8 + h) * 16 + hi * 8; float* pw = PW + ((size_t)t * 8 + h) * 16 + hi * 8;
        *(uint4*)po = make_uint4((unsigned)ids[0] | ((unsigned)ids[1] << 16), (unsigned)ids[2] | ((unsigned)ids[3] << 16), (unsigned)ids[4] | ((unsigned)ids[5] << 16), (unsigned)ids[6] | ((unsigned)ids[7] << 16));
        *(float4*)pw = make_float4(ws_[0], ws_[1], ws_[2], ws_[3]); *(float4*)(pw + 4) = make_float4(ws_[4], ws_[5], ws_[6], ws_[7]);
        asm volatile("s_waitcnt lgkmcnt(0)" ::: "memory");
    }
    __syncthreads();
}

typedef float f32x2 __attribute__((ext_vector_type(2)));
template <int CTRL> __device__ __forceinline__ float dpp_f(float v) { return __builtin_bit_cast(float, __builtin_amdgcn_update_dpp(0, __builtin_bit_cast(int, v), CTRL, 0xf, 0xf, true)); }
__device__ __forceinline__ unsigned xcc_id() { return (unsigned)__builtin_amdgcn_s_getreg((3 << 11) | 20) & 7u; }
__device__ __forceinline__ float swapadd32(float a, float b) { auto rr = __builtin_amdgcn_permlane32_swap(__float_as_uint(a), __float_as_uint(b), false, false); return __uint_as_float(rr[0]) + __uint_as_float(rr[1]); }
__device__ __forceinline__ float swapadd16(float a, float b) { auto rr = __builtin_amdgcn_permlane16_swap(__float_as_uint(a), __float_as_uint(b), false, false); return __uint_as_float(rr[0]) + __uint_as_float(rr[1]); }
__device__ __forceinline__ void fp8x16_to_f32(const uint4 r, float (&f)[16]) {
    const unsigned w[4] = {r.x, r.y, r.z, r.w};
#pragma unroll
    for (int q = 0; q < 4; ++q) { const f32x2 lo = __builtin_amdgcn_cvt_pk_f32_fp8((int)w[q], false), hi = __builtin_amdgcn_cvt_pk_f32_fp8((int)w[q], true); f[4 * q] = lo.x; f[4 * q + 1] = lo.y; f[4 * q + 2] = hi.x; f[4 * q + 3] = hi.y; }
}
constexpr int PEER_ITEM_TOK = 64, PEER_NITEM = T_TOK / PEER_ITEM_TOK;
struct DnIn { unsigned idp; uint4 xa, xb; };
__device__ __forceinline__ void dn_s1(DnIn& I, const unsigned short* PID, const bf16_t* XB, size_t t, int slice, int lane, int l8) {
    I.idp = ((const unsigned*)PID)[t * 64 + lane];
    I.xa = *(const uint4*)(XB + t * 1024 + slice * 128 + l8 * 16); I.xb = *(const uint4*)(XB + t * 1024 + slice * 128 + l8 * 16 + 8);
}
template <int CTRL> __device__ __forceinline__ int dpp_i(int v) { return __builtin_amdgcn_update_dpp(0, v, CTRL, 0xf, 0xf, true); }
__device__ __forceinline__ void dn_quantx(unsigned (&xq)[4], float& sx, const DnIn& I) {
    const unsigned xw[8] = {I.xa.x, I.xa.y, I.xa.z, I.xa.w, I.xb.x, I.xb.y, I.xb.z, I.xb.w};
    float xf[16]; float am = 0.f;
#pragma unroll
    for (int q = 0; q < 8; ++q) { xf[2 * q] = __uint_as_float(xw[q] << 16); xf[2 * q + 1] = __uint_as_float(xw[q] & 0xffff0000u); am = fmaxf(am, fmaxf(fabsf(xf[2 * q]), fabsf(xf[2 * q + 1]))); }
    am = fmaxf(am, dpp_f<0xB1>(am)); am = fmaxf(am, dpp_f<0x4E>(am)); am = fmaxf(am, dpp_f<0x141>(am));
    const float inv = am > 0.f ? 127.f / am : 0.f; sx = am * (1.f / 127.f);
#pragma unroll
    for (int q = 0; q < 4; ++q) xq[q] = ((unsigned)__float2int_rn(xf[4 * q] * inv) & 0xffu) | (((unsigned)__float2int_rn(xf[4 * q + 1] * inv) & 0xffu) << 8) | (((unsigned)__float2int_rn(xf[4 * q + 2] * inv) & 0xffu) << 16) | ((unsigned)__float2int_rn(xf[4 * q + 3] * inv) << 24);
}
__device__ __forceinline__ void pe_s2(uint4 (&W)[16], unsigned idp, const unsigned char* wslice, unsigned loff, int g8) {
#pragma unroll
    for (int i = 0; i < 8; ++i) { const unsigned p0 = (unsigned)__shfl((int)idp, 4 * g8 + (i >> 1)), p1 = (unsigned)__shfl((int)idp, 32 + 4 * g8 + (i >> 1));
        const unsigned e0 = (i & 1) ? (p0 >> 16) : (p0 & 0xffffu), e1 = (i & 1) ? (p1 >> 16) : (p1 & 0xffffu);
        W[i] = *(const uint4*)(wslice + ((e0 << 7) + loff)); W[8 + i] = *(const uint4*)(wslice + ((e1 << 7) + loff)); }
}
__device__ __forceinline__ int reduce8x8(const int (&v)[8], bool b2, bool b1, bool b0) {
    int n[4], m[2];
#pragma unroll
    for (int j = 0; j < 4; ++j) n[j] = (b2 ? v[4 + j] : v[j]) + dpp_i<0x141>(b2 ? v[j] : v[4 + j]);
#pragma unroll
    for (int j = 0; j < 2; ++j) m[j] = (b1 ? n[2 + j] : n[j]) + dpp_i<0x4E>(b1 ? n[j] : n[2 + j]);
    return (b0 ? m[1] : m[0]) + dpp_i<0xB1>(b0 ? m[0] : m[1]);
}
__device__ __forceinline__ void dn_s3(const uint4 (&W)[16], const unsigned (&xq)[4], float sx, bf16_t* po, int lane, int l8) {
    const bool b2 = (l8 >> 2) & 1, b1 = (l8 >> 1) & 1, b0 = l8 & 1;
    int d[16];
#pragma unroll
    for (int i = 0; i < 16; ++i) { int a = __builtin_amdgcn_sdot4((int)W[i].x, (int)xq[0], 0, false); a = __builtin_amdgcn_sdot4((int)W[i].y, (int)xq[1], a, false);
        a = __builtin_amdgcn_sdot4((int)W[i].z, (int)xq[2], a, false); d[i] = __builtin_amdgcn_sdot4((int)W[i].w, (int)xq[3], a, false); }
    const int lo[8] = {d[0], d[1], d[2], d[3], d[4], d[5], d[6], d[7]}, hi[8] = {d[8], d[9], d[10], d[11], d[12], d[13], d[14], d[15]};
    const float r0 = (float)reduce8x8(lo, b2, b1, b0) * sx, r1 = (float)reduce8x8(hi, b2, b1, b0) * sx;
    const float n0 = dpp_f<0xB1>(r0), n1 = dpp_f<0xB1>(r1);
    if (!(lane & 1)) { ((unsigned*)po)[lane >> 1] = pk2(r0, n0); ((unsigned*)po)[32 + (lane >> 1)] = pk2(r1, n1); }
}
__device__ __forceinline__ void down_phase(const bf16_t* XB, const unsigned char* WDq, const unsigned short* PID, bf16_t* PARTD, unsigned* qctr) {
    const int lane = threadIdx.x & 63, g8 = lane >> 3, l8 = lane & 7;
    const unsigned xcc = xcc_id();
    for (int st = 0; st < 8; ++st) { const int slice = (int)((xcc + st) & 7u);
        const unsigned char* wslice = WDq + (size_t)slice * (16384 * 128); const unsigned loff = (unsigned)l8 * 16u;
        for (;;) { unsigned it_ = 0; if (lane == 0) it_ = __hip_atomic_fetch_add(qctr + slice * 64, 1u, __ATOMIC_RELAXED, __HIP_MEMORY_SCOPE_AGENT);
            const int item = (int)__builtin_amdgcn_readfirstlane(it_); if (item >= PEER_NITEM) break;
            const size_t t0 = (size_t)item * PEER_ITEM_TOK; bf16_t* pbase = PARTD + ((size_t)slice * T_TOK + t0) * 128;
            DnIn IA, IB; uint4 WA[16], WB[16]; unsigned xq[4]; float sx;
            dn_s1(IA, PID, XB, t0, slice, lane, l8); dn_s1(IB, PID, XB, t0 + 1, slice, lane, l8);
            pe_s2(WA, IA.idp, wslice, loff, g8);
#pragma unroll 1
            for (int k = 0; k < PEER_ITEM_TOK; k += 2) {
                const int k2 = (k + 2 < PEER_ITEM_TOK) ? k + 2 : PEER_ITEM_TOK - 1, k3 = (k + 3 < PEER_ITEM_TOK) ? k + 3 : PEER_ITEM_TOK - 1;
                dn_quantx(xq, sx, IA); dn_s1(IA, PID, XB, t0 + k2, slice, lane, l8); pe_s2(WB, IB.idp, wslice, loff, g8);
                dn_s3(WA, xq, sx, pbase + (size_t)k * 128, lane, l8);
                dn_quantx(xq, sx, IB); dn_s1(IB, PID, XB, t0 + k3, slice, lane, l8); pe_s2(WA, IA.idp, wslice, loff, g8);
                dn_s3(WB, xq, sx, pbase + (size_t)(k + 1) * 128, lane, l8);
            }
        }
    }
}
template <int B>
__device__ __forceinline__ void coef_batch(const bf16_t* __restrict__ PARTD, const float* __restrict__ SS, const LAS float* SD, const LAS float* SU, const unsigned short* __restrict__ PID, const float* __restrict__ PW, bf16_t* __restrict__ COEF,
                                           size_t tq0, size_t tstride, int sub, int j8) {
    u32x4 pv[B][8], e[B]; f32x4 sq[B], pw[B][2];
#pragma unroll
    for (int u = 0; u < B; ++u) { const size_t t = (tq0 + u * tstride) * 4 + sub;
        e[u] = *(const u32x4*)(PID + t * 128 + j8); pw[u][0] = *(const f32x4*)(PW + t * 128 + j8); pw[u][1] = *(const f32x4*)(PW + t * 128 + j8 + 4);
        sq[u] = *(const f32x4*)(SS + t * 16 + (j8 & 24) / 2);
#pragma unroll
        for (int x = 0; x < 8; ++x) pv[u][x] = *(const u32x4*)(PARTD + ((size_t)x * T_TOK + t) * 128 + j8); }
    float sd[B][8], su[B][8];
#pragma unroll
    for (int u = 0; u < B; ++u)
#pragma unroll
        for (int q = 0; q < 4; ++q) { const unsigned ea = e[u][q] & 0xffffu, eb = e[u][q] >> 16; sd[u][2 * q] = SD[ea]; sd[u][2 * q + 1] = SD[eb]; su[u][2 * q] = SU[ea]; su[u][2 * q + 1] = SU[eb]; }
#pragma unroll
    for (int u = 0; u < B; ++u) { const size_t t = (tq0 + u * tstride) * 4 + sub;
        float d[8];
#pragma unroll
        for (int q = 0; q < 8; ++q) d[q] = 0.f;
#pragma unroll
        for (int x = 0; x < 8; ++x)
#pragma unroll
            for (int q = 0; q < 4; ++q) { d[2 * q] += __uint_as_float(pv[u][x][q] << 16); d[2 * q + 1] += __uint_as_float(pv[u][x][q] & 0xffff0000u); }
        float ssum = (sq[u][0] + sq[u][1]) + (sq[u][2] + sq[u][3]); ssum += dpp_f<0xB1>(ssum); ssum += dpp_f<0x4E>(ssum);
        const float rstd = rsqrtf(ssum * (1.f / DM) + EPS);
        float o[8];
#pragma unroll
        for (int q = 0; q < 8; ++q) o[q] = pw[u][q >> 2][q & 3] * su[u][q] * gelu_tanh(d[q] * rstd * sd[u][q]);
        *(u32x4*)(COEF + t * 128 + j8) = (u32x4){pk2(o[0], o[1]), pk2(o[2], o[3]), pk2(o[4], o[5]), pk2(o[6], o[7])}; }
}
__device__ __forceinline__ void coef_phase(LAS unsigned char* lds, const bf16_t* __restrict__ PARTD, const float* __restrict__ SS, const float* __restrict__ SDg, const float* __restrict__ SUg, const unsigned short* __restrict__ PID, const float* __restrict__ PW, bf16_t* __restrict__ COEF) {
    const int lane = threadIdx.x & 63, wid = threadIdx.x >> 6, sub = lane >> 4, j8 = (lane & 15) * 8;
    LAS float* SD = (LAS float*)lds; LAS float* SU = SD + 16384;
    __syncthreads();
    for (int i = threadIdx.x; i < 16384 / 4; i += 512) { ((LAS f32x4*)SD)[i] = ((const f32x4*)SDg)[i]; ((LAS f32x4*)SU)[i] = ((const f32x4*)SUg)[i]; }
    __syncthreads();
    const size_t gw = blockIdx.x * 8 + wid, NGW = gridDim.x * 8;
    size_t tq = gw;
    for (; tq + 1 * NGW < T_TOK / 4; tq += 2 * NGW) coef_batch<2>(PARTD, SS, SD, SU, PID, PW, COEF, tq, NGW, sub, j8);
    for (; tq < T_TOK / 4; tq += NGW) coef_batch<1>(PARTD, SS, SD, SU, PID, PW, COEF, tq, NGW, sub, j8);
}
struct UpIn { unsigned idp, cfp, x2; };
__device__ __forceinline__ void up_s1(UpIn& I, const unsigned short* PID, const bf16_t* COEF, const bf16_t* xin, size_t t, int slice, int lane, int c0) {
    I.idp = ((const unsigned*)PID)[t * 64 + lane]; I.cfp = ((const unsigned*)COEF)[t * 64 + lane];
    I.x2 = *(const unsigned*)(xin + t * 1024 + slice * 128 + c0);
}
__device__ __forceinline__ void up_s3(const uint4 (&W)[16], unsigned cfp, unsigned x2, bf16_t* orow, float* ss3, int lane, int g8) {
    f32x2 ac2[8];
#pragma unroll
    for (int q = 0; q < 8; ++q) ac2[q] = (f32x2){0.f, 0.f};
#pragma unroll
    for (int i = 0; i < 16; ++i) { const unsigned cp = (unsigned)__shfl((int)cfp, (i < 8 ? 0 : 32) + 4 * g8 + ((i & 7) >> 1)); const float c = (i & 1) ? __uint_as_float(cp & 0xffff0000u) : __uint_as_float(cp << 16); const f32x2 c2 = {c, c}; const unsigned w[4] = {W[i].x, W[i].y, W[i].z, W[i].w};
#pragma unroll
        for (int q = 0; q < 4; ++q) { ac2[2 * q] = __builtin_elementwise_fma(__builtin_amdgcn_cvt_pk_f32_fp8((int)w[q], false), c2, ac2[2 * q]); ac2[2 * q + 1] = __builtin_elementwise_fma(__builtin_amdgcn_cvt_pk_f32_fp8((int)w[q], true), c2, ac2[2 * q + 1]); } }
    float acc[16];
#pragma unroll
    for (int q = 0; q < 8; ++q) { acc[2 * q] = ac2[q].x; acc[2 * q + 1] = ac2[q].y; }
    float a8[8], a4[4];
#pragma unroll
    for (int q = 0; q < 8; ++q) a8[q] = swapadd32(acc[q], acc[q + 8]);
#pragma unroll
    for (int q = 0; q < 4; ++q) a4[q] = swapadd16(a8[q], a8[q + 4]);
    const bool b3 = (lane >> 3) & 1;
    const float y0 = (b3 ? a4[2] : a4[0]) + dpp_f<0x128>(b3 ? a4[0] : a4[2]);
    const float y1 = (b3 ? a4[3] : a4[1]) + dpp_f<0x128>(b3 ? a4[1] : a4[3]);
    const float o0 = __uint_as_float(x2 << 16) + y0, o1 = __uint_as_float(x2 & 0xffff0000u) + y1;
    *(unsigned*)orow = pk2(o0, o1);
    const float ss = wave_sum(o0 * o0 + o1 * o1);
    if (lane == 0) *ss3 = ss;
}
__device__ __forceinline__ void up_phase(const unsigned char* WUq, const unsigned short* PID, const bf16_t* COEF, const bf16_t* xin, bf16_t* xout, float* SS3, unsigned* qctr) {
    const int lane = threadIdx.x & 63, g8 = lane >> 3, l8 = lane & 7;
    const int c0 = 16 * l8 + 8 * ((lane >> 5) & 1) + 4 * ((lane >> 4) & 1) + 2 * ((lane >> 3) & 1);
    const unsigned xcc = xcc_id();
    for (int st = 0; st < 8; ++st) { const int slice = (int)((xcc + st) & 7u);
        const unsigned char* wslice = WUq + (size_t)slice * (16384 * 128); const unsigned loff = (unsigned)l8 * 16u;
        for (;;) { unsigned it_ = 0; if (lane == 0) it_ = __hip_atomic_fetch_add(qctr + slice * 64, 1u, __ATOMIC_RELAXED, __HIP_MEMORY_SCOPE_AGENT);
            const int item = (int)__builtin_amdgcn_readfirstlane(it_); if (item >= PEER_NITEM) break;
            const size_t t0 = (size_t)item * PEER_ITEM_TOK;
            UpIn IA, IB; uint4 WA[16], WB[16];
            up_s1(IA, PID, COEF, xin, t0, slice, lane, c0); up_s1(IB, PID, COEF, xin, t0 + 1, slice, lane, c0);
            pe_s2(WA, IA.idp, wslice, loff, g8);
#pragma unroll 1
            for (int k = 0; k < PEER_ITEM_TOK; k += 2) {
                const int k2 = (k + 2 < PEER_ITEM_TOK) ? k + 2 : PEER_ITEM_TOK - 1, k3 = (k + 3 < PEER_ITEM_TOK) ? k + 3 : PEER_ITEM_TOK - 1;
                { const unsigned cp_ = IA.cfp; const unsigned xx = IA.x2;
                  up_s1(IA, PID, COEF, xin, t0 + k2, slice, lane, c0); pe_s2(WB, IB.idp, wslice, loff, g8);
                  up_s3(WA, cp_, xx, xout + (t0 + k) * 1024 + slice * 128 + c0, SS3 + (t0 + k) * 8 + slice, lane, g8); }
                { const unsigned cp_ = IB.cfp; const unsigned xx = IB.x2;
                  up_s1(IB, PID, COEF, xin, t0 + k3, slice, lane, c0); pe_s2(WA, IA.idp, wslice, loff, g8);
                  up_s3(WB, cp_, xx, xout + (t0 + k + 1) * 1024 + slice * 128 + c0, SS3 + (t0 + k + 1) * 8 + slice, lane, g8); }
            }
        }
    }
}
template <int B>
__device__ __forceinline__ void final_batch(const bf16_t* __restrict__ xin, const float* __restrict__ SS3, const float* __restrict__ fg, float* __restrict__ out, size_t t0, size_t tstride, int lane) {
    u32x4 v[B][2]; f32x4 sq[B][2];
#pragma unroll
    for (int u = 0; u < B; ++u) { const size_t t = t0 + u * tstride; sq[u][0] = *(const f32x4*)(SS3 + t * 8); sq[u][1] = *(const f32x4*)(SS3 + t * 8 + 4);
        v[u][0] = *(const u32x4*)(xin + t * 1024 + lane * 8); v[u][1] = *(const u32x4*)(xin + t * 1024 + 512 + lane * 8); }
    const f32x4 g00 = *(const f32x4*)(fg + lane * 8), g01 = *(const f32x4*)(fg + lane * 8 + 4), g10 = *(const f32x4*)(fg + 512 + lane * 8), g11 = *(const f32x4*)(fg + 516 + lane * 8);
#pragma unroll
    for (int u = 0; u < B; ++u) { const size_t t = t0 + u * tstride; const f32x4 s4 = sq[u][0] + sq[u][1];
        const float r2 = rsqrtf(((s4[0] + s4[1]) + (s4[2] + s4[3])) * (1.f / DM) + EPS);
#pragma unroll
        for (int q = 0; q < 2; ++q) { const u32x4 w = v[u][q]; const f32x4 ga = q ? g10 : g00, gb = q ? g11 : g01; float* op = out + t * 1024 + q * 512 + lane * 8;
            const f32x4 o0 = {__uint_as_float(w.x << 16) * r2 * ga[0], __uint_as_float(w.x & 0xffff0000u) * r2 * ga[1], __uint_as_float(w.y << 16) * r2 * ga[2], __uint_as_float(w.y & 0xffff0000u) * r2 * ga[3]};
            const f32x4 o1 = {__uint_as_float(w.z << 16) * r2 * gb[0], __uint_as_float(w.z & 0xffff0000u) * r2 * gb[1], __uint_as_float(w.w << 16) * r2 * gb[2], __uint_as_float(w.w & 0xffff0000u) * r2 * gb[3]};
            *(f32x4*)op = o0; *(f32x4*)(op + 4) = o1; } }
}
__device__ __forceinline__ void final_phase(const bf16_t* __restrict__ xin, const float* __restrict__ SS3, const float* __restrict__ fg, float* __restrict__ out) {
    const int lane = threadIdx.x & 63, wid = threadIdx.x >> 6;
    const size_t gw = blockIdx.x * 8 + wid, NGW = gridDim.x * 8;
    size_t t = gw;
    for (; t + 7 * NGW < T_TOK; t += 8 * NGW) final_batch<8>(xin, SS3, fg, out, t, NGW, lane);
    for (; t < T_TOK; t += NGW) final_batch<1>(xin, SS3, fg, out, t, NGW, lane);
}
#undef KSWZ
}


#define XB_TMO      128
#define XB_XCNT(j)  (256  + 64 * (j))
#define XB_XSUB(j)  (1280 + 64 * (j))
#define XB_XGEN(j)  (2304 + 64 * (j))
#define XB_TOP      3328
#define XB_TOPGEN   3392
#define XCD_BAR_WORDS 3456
#define XB_SPIN_CAP (1u << 22)
__device__ __forceinline__ unsigned xb_ld(unsigned* p)              { return __hip_atomic_load(p, __ATOMIC_RELAXED, __HIP_MEMORY_SCOPE_AGENT); }
__device__ __forceinline__ unsigned xb_add(unsigned* p, unsigned v) { return __hip_atomic_fetch_add(p, v, __ATOMIC_RELAXED, __HIP_MEMORY_SCOPE_AGENT); }
__device__ __forceinline__ unsigned xb_xcc_id() { return (unsigned)__builtin_amdgcn_s_getreg((3 << 11) | 20) & 0xFu; }
#define XB_SPIN(cond, bar) do { unsigned _sp = 0; while (cond) { __builtin_amdgcn_s_sleep(1); \
    if ((++_sp & 255u) == 0u) { if (xb_ld(&(bar)[XB_TMO])) break; if (_sp > XB_SPIN_CAP) { atomicAdd(&(bar)[XB_TMO], 1u); break; } } } } while (0)
struct XcdBarrier { unsigned* bar; unsigned x; volatile LAS unsigned* st; };
__device__ __forceinline__ XcdBarrier xcd_barrier_post(unsigned* bar, volatile LAS unsigned* st) {
    XcdBarrier b; b.bar = bar; b.x = xb_xcc_id(); b.st = st;
    if (threadIdx.x == 0) (void)xb_add(&bar[XB_XCNT(b.x)], 1u);
    return b;
}
__device__ __forceinline__ void xcd_barrier_complete(unsigned* bar, unsigned x, unsigned& nloc, unsigned& nx) {
    const unsigned G = gridDim.x * gridDim.y * gridDim.z;
    unsigned sum, cnt, mine, sp = 0u;
    for (;;) {
        sum = 0u; cnt = 0u; mine = 0u;
#pragma unroll
        for (unsigned j = 0; j < 16; ++j) { const unsigned c = xb_ld(&bar[XB_XCNT(j)]); sum += c; cnt += (c > 0u) ? 1u : 0u; mine = (j == x) ? c : mine; }
        if (sum == G) break;
        __builtin_amdgcn_s_sleep(1);
        if ((++sp & 255u) == 0u) { if (xb_ld(&bar[XB_TMO])) break; if (sp > XB_SPIN_CAP) { atomicAdd(&bar[XB_TMO], 1u); break; } }
    }
    nloc = mine > 0u ? mine : 1u; nx = cnt > 0u ? cnt : 1u;
}
__device__ __forceinline__ void xcd_barrier(const XcdBarrier& b) {
    asm volatile("s_waitcnt vmcnt(0)" ::: "memory");
    __syncthreads();
    if (threadIdx.x == 0) {
        unsigned* bar = b.bar;
        __builtin_amdgcn_s_waitcnt(0);
        unsigned nloc = b.st[0], nx = b.st[1];
        if (nloc == 0u) { xcd_barrier_complete(bar, b.x, nloc, nx); b.st[0] = nloc; b.st[1] = nx; }
        const unsigned old = xb_add(&bar[XB_XSUB(b.x)], 1u);
        const unsigned gen = old / nloc;
        if (old + 1u == (gen + 1u) * nloc) {
            __builtin_amdgcn_fence(__ATOMIC_RELEASE, "agent");
            asm volatile("s_waitcnt vmcnt(0)" ::: "memory");
            const unsigned og = xb_add(&bar[XB_TOP], 1u);
            const unsigned tg = og / nx;
            if (og + 1u == (tg + 1u) * nx) xb_add(&bar[XB_TOPGEN], 1u);
            else XB_SPIN(xb_ld(&bar[XB_TOPGEN]) == tg, bar);
            __builtin_amdgcn_fence(__ATOMIC_ACQUIRE, "agent");
            xb_add(&bar[XB_XGEN(b.x)], 1u);
            asm volatile("s_waitcnt vmcnt(0)" ::: "memory");
        } else {
            XB_SPIN(xb_ld(&bar[XB_XGEN(b.x)]) == gen, bar);
            __builtin_amdgcn_fence(__ATOMIC_ACQUIRE, "agent");
            asm volatile("s_waitcnt vmcnt(0)" ::: "memory");
        }
    }
    __syncthreads();
}

constexpr int NTHREADS = 512;
constexpr int LDS_BYTES = 147456;
constexpr int NPHASE = 16;

__global__ void __launch_bounds__(NTHREADS, 2) mega_fwd(Args a) {
    extern __shared__ __attribute__((aligned(16))) unsigned char lds_raw[];
    LAS unsigned char* lds = (LAS unsigned char*)lds_raw;
    cg::grid_group grid = cg::this_grid();
    const int lo = a.ph_lo, hi = a.ph_hi;
    volatile LAS unsigned* bst = (volatile LAS unsigned*)(lds + LDS_BYTES - 64);
    if (threadIdx.x < 2) bst[threadIdx.x] = 0u;
    __syncthreads();
    const XcdBarrier xbar = xcd_barrier_post((unsigned*)(a.ws + WS_CTL) + 16384 + a.li * 4096, bst);
#define IN(k) (lo <= (k) && (k) < hi)
#define SEAM(k) do { if (IN(k) && IN((k) + 1)) { if ((k) == 0) grid.sync(); else xcd_barrier(xbar); } } while (0)
#ifndef DUP_MASK
#define DUP_MASK 0u
#endif
#define REPS(k) for (int rep = 0, nrep = ((DUP_MASK >> (k)) & 1u) ? 2 : 1; rep < nrep; ++rep, (rep < nrep ? grid.sync() : (void)0))
    unsigned char* ws = a.ws;
#define BFP(off) ((bf16_t*)(ws + (off)))
#define FPP(off) ((float*)(ws + (off)))
    const int G = gridDim.x, cu = blockIdx.x;
    if (IN(0)) REPS(0) { p0_prologue(a, lds); }
    SEAM(0);
    if (IN(1)) REPS(1) {
        { pg8::Gemm g{(const bf16_t*)a.out, BFP(WS_WIN_T), 1024, 1024, 1024};     pg8::StaticOrder S; S.init(T_TOK, IN_COLS, G, cu);
          pg8::EpiInProj E{BFP(WS_Q), BFP(WS_K), BFP(WS_V), BFP(WS_U), BFP(WS_GV), BFP(WS_GA), BFP(WS_GB), FPP(WS_KMP), (const float2*)(ws + WS_ROPE)};
          pg8::gemm_phase(lds, g, S, E); }
    }
    SEAM(1);
    if (IN(2)) REPS(2) { att::sel_phase(BFP(WS_Q), FPP(WS_KMP), (signed char*)(ws + WS_SEL));
                 att::gmlp_phase(lds, BFP(WS_U), BFP(WS_GV), BFP(WS_WM), a.in[5], a.in[7], BFP(WS_ATTGM)); }
    SEAM(2);
    if (IN(3)) REPS(3) {
        { pg8::Gemm g{BFP(WS_MN), BFP(WS_XAKV_T), 1024, 1024, 1024}; pg8::StaticOrder S; S.init(NB * NMEM, 1024, G, cu);
          pg8::EpiPlain E{BFP(WS_XKV), 1024};
          pg8::gemm_phase(lds, g, S, E); }
      att::moba_sel_phase(lds, BFP(WS_Q), BFP(WS_K), BFP(WS_V), (const signed char*)(ws + WS_SEL), BFP(WS_PART), FPP(WS_ML), (unsigned*)(ws + WS_CTL) + a.li * 8192 + 64 + rep); }
    SEAM(3);
    if (IN(4)) REPS(4) att::moba_own_phase(lds, BFP(WS_Q), BFP(WS_K), BFP(WS_V), (const signed char*)(ws + WS_SEL), BFP(WS_PART), FPP(WS_ML), BFP(WS_ATTGM));
    SEAM(4);
    if (IN(5)) REPS(5) {
        pg8::Gemm g{BFP(WS_ATTGM), BFP(WS_WAB_T), 1024, 1024, 1024}; pg8::StaticOrder S; S.init(T_TOK, 1024, G, cu);
        pg8::EpiMergedFused E{BFP(WS_GA), BFP(WS_GB), BFP(WS_MERGED)};
        pg8::gemm_phase<pg8::EpiMergedFused, pg8::StaticOrder, true>(lds, g, S, E);
    }
    SEAM(5);
    if (IN(6)) REPS(6) {
        pg8::Gemm g{BFP(WS_MERGED), BFP(WS_WOUT_T), 1024, 1024, 1024}; pg8::StaticOrder S; S.init(T_TOK, 1024, G, cu);
        pg8::EpiResid<2> E{FPP(WS_RS0), (const bf16_t*)a.out, BFP(WS_XB), FPP(WS_SS1)};
        pg8::gemm_phase(lds, g, S, E);
    }
    SEAM(6);
    if (IN(7)) REPS(7) {
        pg8::Gemm g{BFP(WS_XB), BFP(WS_XAQ_T), 1024, 1024, 1024}; pg8::StaticOrder S; S.init(T_TOK, 512, G, cu);
        pg8::EpiRowScale E{BFP(WS_XQ), 512, FPP(WS_SS1), C2X};
        pg8::gemm_phase(lds, g, S, E);
    }
    SEAM(7);
    if (IN(8)) REPS(8) att::xattn_phase(lds, BFP(WS_XQ), BFP(WS_XKV), BFP(WS_XO));
    SEAM(8);
    if (IN(9)) REPS(9) {
        pg8::Gemm g{BFP(WS_XO), BFP(WS_XAO_T), 512, 512, 512}; pg8::StaticOrder S; S.init(T_TOK, 1024, G, cu);
        pg8::EpiResid<1> E{nullptr, nullptr, BFP(WS_XB), FPP(WS_SS2)};
        pg8::gemm_phase(lds, g, S, E);
    }
    SEAM(9);
    if (IN(10)) REPS(10) {
        pg8::Gemm g{BFP(WS_XB), BFP(WS_PQ_T), 1024, 1024, 1024}; pg8::StaticOrder S; S.init(T_TOK, 2048, G, cu);
        pg8::EpiRowScale E{BFP(WS_QP), 2048, FPP(WS_SS2), 1.f};
        pg8::gemm_phase(lds, g, S, E);
    }
    SEAM(10);
    if (IN(11)) REPS(11) peer::topk_phase(lds, BFP(WS_QP), BFP(WS_SK), (unsigned short*)(ws + WS_PID), FPP(WS_PW));
    SEAM(11);
    if (IN(12)) REPS(12) peer::down_phase(BFP(WS_XB), ws + WS_WD, (const unsigned short*)(ws + WS_PID), BFP(WS_PARTD), (unsigned*)(ws + WS_CTL) + a.li * 8192 + 1024 + rep * 512);
    SEAM(12);
    if (IN(13)) REPS(13) peer::coef_phase(lds, BFP(WS_PARTD), FPP(WS_SS2), FPP(WS_SD), FPP(WS_SU), (const unsigned short*)(ws + WS_PID), FPP(WS_PW), BFP(WS_COEF));
    SEAM(13);
    if (IN(14)) REPS(14) peer::up_phase(ws + WS_WU, (const unsigned short*)(ws + WS_PID), BFP(WS_COEF), BFP(WS_XB), (rep + 1 < nrep) ? BFP(WS_RD) : BFP(WS_XB), FPP(WS_SS3), (unsigned*)(ws + WS_CTL) + a.li * 8192 + 2048 + rep * 512);
    SEAM(14);
    if (IN(15)) REPS(15) peer::final_phase(BFP(WS_XB), FPP(WS_SS3), a.in[20], a.out);
#undef BFP
#undef FPP
#undef IN
#undef SEAM
}

__global__ void __launch_bounds__(256) nv_inproj_rope(const bf16_t* XN, const float* W, const float2* rope, bf16_t* Q, bf16_t* K) {
    const int r0 = blockIdx.x * 8, which = blockIdx.y, p = threadIdx.x, head = p >> 5, i = p & 31;
    const int c1 = which * 512 + head * 64 + i, c2 = c1 + 32;
    float a1[8], a2[8];
#pragma unroll
    for (int j = 0; j < 8; ++j) { a1[j] = 0.f; a2[j] = 0.f; }
    for (int k = 0; k < 1024; ++k) { const float w1 = W[(size_t)k * IN_COLS + c1], w2 = W[(size_t)k * IN_COLS + c2];
#pragma unroll
        for (int j = 0; j < 8; ++j) { const float x = bf2f(XN[(size_t)(r0 + j) * 1024 + k]); a1[j] += x * w1; a2[j] += x * w2; } }
    bf16_t* O = which ? K : Q; const float sc = which ? 1.f : C2M;
#pragma unroll
    for (int j = 0; j < 8; ++j) { const int r = r0 + j, pos = r & (SEQ - 1); const float2 cs = rope[pos * 32 + i];
        const float o1 = a1[j] * cs.x - a2[j] * cs.y, o2 = a2[j] * cs.x + a1[j] * cs.y;
        *(unsigned*)(O + (size_t)r * 512 + head * 64 + 2 * i) = pk2(o1 * sc, o2 * sc); }
}
__global__ void __launch_bounds__(256) nv_inproj_rest(const bf16_t* XN, const float* W, bf16_t* V, bf16_t* U, bf16_t* GV, bf16_t* GA, bf16_t* GB) {
    const int r0 = blockIdx.x * 8, n = 1024 + blockIdx.y * 256 + threadIdx.x;
    float acc[8];
#pragma unroll
    for (int j = 0; j < 8; ++j) acc[j] = 0.f;
    for (int k = 0; k < 1024; ++k) { const float w = W[(size_t)k * IN_COLS + n];
#pragma unroll
        for (int j = 0; j < 8; ++j) acc[j] += bf2f(XN[(size_t)(r0 + j) * 1024 + k]) * w; }
#pragma unroll
    for (int j = 0; j < 8; ++j) { const size_t r = r0 + j; const float v = acc[j];
        if (n < 1536) V[r * 512 + (n - 1024)] = f2bf(v);
        else if (n < 2048) U[r * 512 + (n - 1536)] = f2bf(gelu_tanh(v));
        else if (n < 2560) GV[r * 512 + (n - 2048)] = f2bf(gelu_tanh(v));
        else if (n < 3584) GA[r * 1024 + (n - 2560)] = f2bf(sigmoidf(v));
        else GB[r * 1024 + (n - 3584)] = f2bf(sigmoidf(v)); }
}
__global__ void __launch_bounds__(512) nv_kmean(const bf16_t* K, float* KMP) {
    const int blk = blockIdx.x, c = threadIdx.x; float s = 0.f;
    for (int r = 0; r < 256; ++r) s += bf2f(K[(size_t)(blk * 256 + r) * 512 + c]);
    KMP[(size_t)blk * 1024 + c] = s; KMP[(size_t)blk * 1024 + 512 + c] = 0.f;
}
template <int MODE>
__global__ void __launch_bounds__(256) nv_gemm(const bf16_t* A, int lda, const float* W, int ldw, int K, const float* kscale, bf16_t* O, int ldo, const float* SS, float cscale, float* res) {
    const int r0 = blockIdx.x * 8, n = blockIdx.y * 256 + threadIdx.x;
    float acc[8];
#pragma unroll
    for (int j = 0; j < 8; ++j) acc[j] = 0.f;
    for (int k = 0; k < K; ++k) { const float w = W[(size_t)k * ldw + n] * (kscale ? kscale[k] : 1.f);
#pragma unroll
        for (int j = 0; j < 8; ++j) acc[j] += bf2f(A[(size_t)(r0 + j) * lda + k]) * w; }
#pragma unroll
    for (int j = 0; j < 8; ++j) { const size_t r = r0 + j; float v = acc[j];
        if (MODE == 0) { float rs = 1.f; if (SS) { float s = 0.f; for (int q = 0; q < 16; ++q) s += SS[r * 16 + q]; rs = rsqrtf(s * (1.f / DM) + EPS); } O[r * ldo + n] = f2bf(v * rs * cscale); }
        else { const float x = res[r * ldo + n] + v; res[r * ldo + n] = x; O[r * ldo + n] = f2bf(x); } }
}
__global__ void __launch_bounds__(256) nv_wout(const bf16_t* A, const float* W, const float* x, float* out, bf16_t* XB) {
    const int r0 = blockIdx.x * 8, n = blockIdx.y * 256 + threadIdx.x;
    float acc[8];
#pragma unroll
    for (int j = 0; j < 8; ++j) acc[j] = 0.f;
    for (int k = 0; k < 1024; ++k) { const float w = W[(size_t)k * 1024 + n];
#pragma unroll
        for (int j = 0; j < 8; ++j) acc[j] += bf2f(A[(size_t)(r0 + j) * 1024 + k]) * w; }
#pragma unroll
    for (int j = 0; j < 8; ++j) { const size_t r = r0 + j; const float v = x[r * 1024 + n] + acc[j]; out[r * 1024 + n] = v; XB[r * 1024 + n] = f2bf(v); }
}
__global__ void __launch_bounds__(256) nv_merged(const bf16_t* AG, const float* Wa, const float* Wb, const bf16_t* GA, const bf16_t* GB, bf16_t* MG) {
    const int r0 = blockIdx.x * 8, n = blockIdx.y * 256 + threadIdx.x;
    float ya[8], yb[8];
#pragma unroll
    for (int j = 0; j < 8; ++j) { ya[j] = 0.f; yb[j] = 0.f; }
    for (int k = 0; k < 512; ++k) { const float wa = Wa[(size_t)k * 1024 + n], wb = Wb[(size_t)k * 1024 + n];
#pragma unroll
        for (int j = 0; j < 8; ++j) { ya[j] += bf2f(AG[(size_t)(r0 + j) * 1024 + k]) * wa; yb[j] += bf2f(AG[(size_t)(r0 + j) * 1024 + 512 + k]) * wb; } }
#pragma unroll
    for (int j = 0; j < 8; ++j) { const size_t r = r0 + j; MG[r * 1024 + n] = f2bf(bf2f(GA[r * 1024 + n]) * ya[j] + bf2f(GB[r * 1024 + n]) * yb[j]); }
}
__global__ void __launch_bounds__(256) nv_rowss(const float* X, float* SS) {
    const int lane = threadIdx.x & 63, row = blockIdx.x * 4 + (threadIdx.x >> 6); float s = 0.f;
    for (int j = 0; j < 16; ++j) { const float v = X[(size_t)row * 1024 + j * 64 + lane]; s += v * v; }
    s = wave_sum(s);
    if (lane < 16) SS[(size_t)row * 16 + lane] = lane == 0 ? s : 0.f;
}
__global__ void __launch_bounds__(256) nv_sel(const bf16_t* Q, const float* KMP, signed char* SEL) {
    const int idx = blockIdx.x * 256 + threadIdx.x, t = idx >> 3, h = idx & 7, b = t / SEQ, qb = (t % SEQ) / 256;
    float bv[3] = {-3e38f, -3e38f, -3e38f}; int bi[3] = {-1, -1, -1};
    for (int n = 0; n < qb; ++n) { float g = 0.f; const float* km = KMP + (size_t)(b * 32 + n) * 1024 + h * 64;
        for (int j = 0; j < 64; ++j) g += bf2f(Q[(size_t)t * 512 + h * 64 + j]) * (km[j] + km[512 + j]);
        if (g > bv[0]) { bv[2] = bv[1]; bi[2] = bi[1]; bv[1] = bv[0]; bi[1] = bi[0]; bv[0] = g; bi[0] = n; }
        else if (g > bv[1]) { bv[2] = bv[1]; bi[2] = bi[1]; bv[1] = g; bi[1] = n; }
        else if (g > bv[2]) { bv[2] = g; bi[2] = n; } }
    char4 o; o.x = (signed char)bi[0]; o.y = (signed char)bi[1]; o.z = (signed char)bi[2]; o.w = -1;
    ((char4*)SEL)[(size_t)(b * 8 + h) * SEQ + (t % SEQ)] = o;
}
__global__ void __launch_bounds__(256) nv_moba(const bf16_t* Q, const bf16_t* K, const bf16_t* V, const signed char* SEL, bf16_t* ATTGM) {
    const int lane = threadIdx.x & 63, idx = blockIdx.x * 4 + (threadIdx.x >> 6), t = idx >> 3, h = idx & 7, b = t / SEQ, pos = t % SEQ, qb = pos / 256;
    const float q = bf2f(Q[(size_t)t * 512 + h * 64 + lane]);
    float m = -3e38f, l = 0.f, o = 0.f;
    for (int s = 0; s < 4; ++s) {
        int n, cnt;
        if (s < 3) { n = SEL[((size_t)(b * 8 + h) * SEQ + pos) * 4 + s]; if (n < 0) continue; cnt = 256; } else { n = qb; cnt = pos - qb * 256 + 1; }
        const size_t base = (size_t)b * SEQ + (size_t)n * 256;
        for (int j = 0; j < cnt; ++j) {
            const float sc = wave_sum(q * bf2f(K[(base + j) * 512 + h * 64 + lane]));
            const float mn = fmaxf(m, sc), al = exp2f(m - mn), p = exp2f(sc - mn);
            l = l * al + p; o = o * al + p * bf2f(V[(base + j) * 512 + h * 64 + lane]); m = mn; } }
    ATTGM[(size_t)t * 1024 + h * 64 + lane] = f2bf(o / l);
}
__global__ void __launch_bounds__(256) nv_gvstat(const bf16_t* GV, float* RS) {
    const int lane = threadIdx.x & 63, row = blockIdx.x * 4 + (threadIdx.x >> 6); float s = 0.f;
    for (int j = 0; j < 8; ++j) { const float v = bf2f(GV[(size_t)row * 512 + j * 64 + lane]); s += v * v; }
    s = wave_sum(s);
    if (lane == 0) RS[row] = rsqrtf(s * (1.f / 512.f) + EPS);
}
__global__ void __launch_bounds__(256) nv_gmlp(const bf16_t* U, const bf16_t* GV, const float* RS, const float* ng, const float* w_s, const float* b_s, bf16_t* ATTGM) {
    const size_t idx = (size_t)blockIdx.x * 256 + threadIdx.x; const int t = (int)(idx >> 9), c = (int)(idx & 511), g = c >> 6, tt = t & 127, t0 = t - tt;
    float z = 0.f;
    for (int s = 0; s <= tt; ++s) z += w_s[((size_t)g * 128 + tt) * 128 + s] * (bf2f(GV[(size_t)(t0 + s) * 512 + c]) * RS[t0 + s] * ng[c]);
    z += b_s[g * 128 + tt];
    ATTGM[(size_t)t * 1024 + 512 + c] = f2bf(bf2f(U[(size_t)t * 512 + c]) * z);
}
__global__ void __launch_bounds__(256) nv_xattn(const bf16_t* XQ, const bf16_t* XKV, bf16_t* XO) {
    const int lane = threadIdx.x & 63, idx = blockIdx.x * 4 + (threadIdx.x >> 6), t = idx >> 2, h = idx & 3, b = t / SEQ;
    const float q0 = bf2f(XQ[(size_t)t * 512 + h * 128 + lane]), q1 = bf2f(XQ[(size_t)t * 512 + h * 128 + 64 + lane]);
    float m = -3e38f, l = 0.f, o0 = 0.f, o1 = 0.f;
    for (int j = 0; j < NMEM; ++j) { const bf16_t* kr = XKV + (size_t)(b * NMEM + j) * 1024 + h * 128;
        const float sc = wave_sum(q0 * bf2f(kr[lane]) + q1 * bf2f(kr[64 + lane]));
        const float mn = fmaxf(m, sc), al = exp2f(m - mn), p = exp2f(sc - mn);
        l = l * al + p; o0 = o0 * al + p * bf2f(kr[512 + lane]); o1 = o1 * al + p * bf2f(kr[512 + 64 + lane]); m = mn; }
    XO[(size_t)t * 512 + h * 128 + lane] = f2bf(o0 / l); XO[(size_t)t * 512 + h * 128 + 64 + lane] = f2bf(o1 / l);
}
__device__ __forceinline__ void wave_argmax(float v, int i, float& bv, int& bi) {
#pragma unroll
    for (int o = 1; o < 64; o <<= 1) { const float ov = __shfl_xor(v, o); const int oi = __shfl_xor(i, o); if (ov > v || (ov == v && oi < i)) { v = ov; i = oi; } }
    bv = v; bi = i;
}
__global__ void __launch_bounds__(256) nv_peer_topk(const bf16_t* QP, const float* SK, int* PID, float* PW) {
    __shared__ float sv[4][2][16]; __shared__ int si[4][2][16];
    const int lane = threadIdx.x & 63, w = threadIdx.x >> 6, idx = blockIdx.x * 4 + w, t = idx >> 3, h = idx & 7;
    for (int p = 0; p < 2; ++p) {
        const bf16_t* q = QP + (size_t)t * 2048 + h * 256 + p * 128; const float* k0 = SK + ((size_t)(h * 2 + p) * 128 + lane) * 128; const float* k1 = k0 + 64 * 128;
        float s0 = 0.f, s1 = 0.f;
        for (int d = 0; d < 128; ++d) { const float qq = bf2f(q[d]); s0 += qq * k0[d]; s1 += qq * k1[d]; }
        for (int r = 0; r < 16; ++r) { float v; int i; if (s0 >= s1) { v = s0; i = lane; } else { v = s1; i = lane + 64; }
            float bv; int bi; wave_argmax(v, i, bv, bi);
            if (bi == lane) s0 = -3e38f; if (bi == lane + 64) s1 = -3e38f;
            if (lane == 0) { sv[w][p][r] = bv; si[w][p][r] = bi; } }
    }
    __syncthreads();
    float c[4]; int ci[4];
#pragma unroll
    for (int j = 0; j < 4; ++j) { const int pos = lane * 4 + j, i1 = pos >> 4, i2 = pos & 15; c[j] = sv[w][0][i1] + sv[w][1][i2]; ci[j] = pos; }
    float mykeep = 0.f; int myid = 0;
    float top0 = 0.f, denom = 0.f;
    for (int r = 0; r < 16; ++r) { float v = c[0]; int i = ci[0];
#pragma unroll
        for (int j = 1; j < 4; ++j) if (c[j] > v) { v = c[j]; i = ci[j]; }
        float bv; int bi; wave_argmax(v, i, bv, bi);
#pragma unroll
        for (int j = 0; j < 4; ++j) if (ci[j] == bi) c[j] = -3e38f;
        if (r == 0) top0 = bv;
        const float e = __expf(bv - top0); denom += e;
        if (lane == r) { mykeep = e; myid = si[w][0][bi >> 4] * 128 + si[w][1][bi & 15]; } }
    if (lane < 16) { PID[(size_t)idx * 16 + lane] = myid; PW[(size_t)idx * 16 + lane] = mykeep / denom; }
}
__global__ void __launch_bounds__(256) nv_peer_ffn(const bf16_t* XB, const float* SS, const float* gffn, const float* WDn, const float* WUp, const int* PID, const float* PW, const float* fg, float* out) {
    __shared__ float coef[128]; __shared__ int eid[128]; __shared__ float red[4];
    const int t = blockIdx.x, tid = threadIdx.x, lane = tid & 63, w = tid >> 6;
    float s = 0.f; for (int q = 0; q < 16; ++q) s += SS[(size_t)t * 16 + q]; const float rstd = rsqrtf(s * (1.f / DM) + EPS);
    float xh[16];
#pragma unroll
    for (int j = 0; j < 16; ++j) xh[j] = bf2f(XB[(size_t)t * 1024 + j * 64 + lane]) * gffn[j * 64 + lane];
    for (int jj = 0; jj < 32; ++jj) { const int j = w * 32 + jj; const int e = PID[(size_t)t * 128 + j]; const float* wd = WDn + (size_t)e * 1024; float d = 0.f;
#pragma unroll
        for (int q = 0; q < 16; ++q) d += xh[q] * wd[q * 64 + lane];
        d = wave_sum(d) * rstd;
        if (lane == 0) { coef[j] = PW[(size_t)t * 128 + j] * gelu_tanh(d); eid[j] = e; } }
    __syncthreads();
    float y[4] = {0.f, 0.f, 0.f, 0.f};
    for (int j = 0; j < 128; ++j) { const float cf = coef[j]; const float4 u = *(const float4*)(WUp + (size_t)eid[j] * 1024 + tid * 4); y[0] += cf * u.x; y[1] += cf * u.y; y[2] += cf * u.z; y[3] += cf * u.w; }
    const float4 x2 = *(const float4*)(out + (size_t)t * 1024 + tid * 4);
    y[0] += x2.x; y[1] += x2.y; y[2] += x2.z; y[3] += x2.w;
    float ss = wave_sum(y[0] * y[0] + y[1] * y[1] + y[2] * y[2] + y[3] * y[3]);
    if (lane == 0) red[w] = ss;
    __syncthreads();
    const float r2 = rsqrtf((red[0] + red[1] + red[2] + red[3]) * (1.f / DM) + EPS);
    const float4 g = *(const float4*)(fg + tid * 4);
    *(float4*)(out + (size_t)t * 1024 + tid * 4) = make_float4(y[0] * r2 * g.x, y[1] * r2 * g.y, y[2] * r2 * g.z, y[3] * r2 * g.w);
}

#ifndef OPT_MASK
#define OPT_MASK 0xFFFFu
#endif

static void launch_mega(const Args& a0, int lo, int hi, int grid, hipStream_t stream, int li = 0) {
    Args a = a0; a.ph_lo = lo; a.ph_hi = hi; a.li = li;
    void* args[] = {&a};
    hipError_t e = hipLaunchCooperativeKernel((void*)mega_fwd, dim3(grid), dim3(NTHREADS), args, LDS_BYTES, stream);
    if (e != hipSuccess) fprintf(stderr, "cooperative launch failed: %s (grid %d)\n", hipGetErrorString(e), grid);
}

extern "C" void kernel_launch(void* const* d_in, const int* in_sizes, int n_in, void* d_out, int out_size, void* d_ws, size_t ws_size, hipStream_t stream) {
    static int grid = 0;
    if (grid == 0) {
        int dev = 0, cus = 0, per_cu = 0;
        (void)hipGetDevice(&dev);
        (void)hipDeviceGetAttribute(&cus, hipDeviceAttributeMultiprocessorCount, dev);
        (void)hipFuncSetAttribute((const void*)mega_fwd, hipFuncAttributeMaxDynamicSharedMemorySize, LDS_BYTES);
        (void)hipOccupancyMaxActiveBlocksPerMultiprocessor(&per_cu, (const void*)mega_fwd, NTHREADS, LDS_BYTES);
        if (n_in != 21 || ws_size < WS_END || out_size != T_TOK * DM || per_cu < 1) { fprintf(stderr, "kernel_launch: bad config n_in %d ws %zu out %d per_cu %d\n", n_in, ws_size, out_size, per_cu); grid = -1; return; }
        grid = cus;
    }
    if (grid < 0) return;
    (void)hipMemsetAsync((char*)d_ws + WS_CTL, 0, CTL_BYTES, stream);
    Args a{};
    for (int i = 0; i < 21; ++i) a.in[i] = (const float*)d_in[i];
    a.out = (float*)d_out; a.ws = (unsigned char*)d_ws;
    unsigned char* ws = (unsigned char*)d_ws;
    const unsigned mask = OPT_MASK;
#ifndef PROBE_LO
#define PROBE_LO 0
#define PROBE_HI 0
#endif
    if (PROBE_HI >= PROBE_LO && PROBE_HI > 0) { launch_mega(a, 0, PROBE_HI, grid, stream, 0); launch_mega(a, PROBE_LO, NPHASE, grid, stream, 1); return; }
    if (mask == (1u << NPHASE) - 1u) { launch_mega(a, 0, NPHASE, grid, stream); return; }
#define BF(off) ((bf16_t*)(ws + (off)))
#define FP(off) ((float*)(ws + (off)))
    for (int ph = 0; ph < NPHASE; ++ph) {
        if (mask & (1u << ph)) { int hi = ph + 1; while (hi < NPHASE && (mask & (1u << hi))) ++hi; launch_mega(a, ph, hi, grid, stream); ph = hi - 1; continue; }
        switch (ph) {
        case 1:
            nv_inproj_rope<<<dim3(T_TOK / 8, 2), 256, 0, stream>>>(BF(WS_XN), a.in[3], (const float2*)(ws + WS_ROPE), BF(WS_Q), BF(WS_K));
            nv_inproj_rest<<<dim3(T_TOK / 8, 14), 256, 0, stream>>>(BF(WS_XN), a.in[3], BF(WS_V), BF(WS_U), BF(WS_GV), BF(WS_GA), BF(WS_GB));
            nv_kmean<<<256, 512, 0, stream>>>(BF(WS_K), FP(WS_KMP));
            nv_gemm<0><<<dim3(NB * NMEM / 8, 4), 256, 0, stream>>>(BF(WS_MN), 1024, a.in[13], 1024, 1024, nullptr, BF(WS_XKV), 1024, nullptr, 1.f, nullptr);
            break;
        case 2:
            nv_sel<<<T_TOK * 8 / 256, 256, 0, stream>>>(BF(WS_Q), FP(WS_KMP), (signed char*)(ws + WS_SEL));
            nv_gvstat<<<T_TOK / 4, 256, 0, stream>>>(BF(WS_GV), FP(WS_RS));
            nv_gmlp<<<T_TOK * 512 / 256, 256, 0, stream>>>(BF(WS_U), BF(WS_GV), FP(WS_RS), a.in[5], a.in[6], a.in[7], BF(WS_ATTGM));
            break;
        case 3:
            break;
        case 4:
            nv_moba<<<T_TOK * 8 / 4, 256, 0, stream>>>(BF(WS_Q), BF(WS_K), BF(WS_V), (const signed char*)(ws + WS_SEL), BF(WS_ATTGM));
            break;
        case 5:
            nv_merged<<<dim3(T_TOK / 8, 4), 256, 0, stream>>>(BF(WS_ATTGM), a.in[4], a.in[8], BF(WS_GA), BF(WS_GB), BF(WS_MERGED));
            break;
        case 6:
            nv_wout<<<dim3(T_TOK / 8, 4), 256, 0, stream>>>(BF(WS_MERGED), a.in[9], a.in[0], a.out, BF(WS_XB));
            nv_rowss<<<T_TOK / 4, 256, 0, stream>>>(a.out, FP(WS_SS1));
            break;
        case 7:
            nv_gemm<0><<<dim3(T_TOK / 8, 2), 256, 0, stream>>>(BF(WS_XB), 1024, a.in[12], 512, 1024, a.in[10], BF(WS_XQ), 512, FP(WS_SS1), C2X, nullptr);
            break;
        case 8:
            nv_xattn<<<T_TOK * 4 / 4, 256, 0, stream>>>(BF(WS_XQ), BF(WS_XKV), BF(WS_XO));
            break;
        case 9:
            nv_gemm<1><<<dim3(T_TOK / 8, 4), 256, 0, stream>>>(BF(WS_XO), 512, a.in[14], 1024, 512, nullptr, BF(WS_XB), 1024, nullptr, 1.f, a.out);
            nv_rowss<<<T_TOK / 4, 256, 0, stream>>>(a.out, FP(WS_SS2));
            break;
        case 10:
            nv_gemm<0><<<dim3(T_TOK / 8, 8), 256, 0, stream>>>(BF(WS_XB), 1024, a.in[16], 2048, 1024, a.in[15], BF(WS_QP), 2048, FP(WS_SS2), 1.f, nullptr);
            break;
        case 11:
            nv_peer_topk<<<T_TOK * 8 / 4, 256, 0, stream>>>(BF(WS_QP), a.in[17], (int*)(ws + WS_PID), FP(WS_PW));
            break;
        case 12:
            nv_peer_ffn<<<T_TOK, 256, 0, stream>>>(BF(WS_XB), FP(WS_SS2), a.in[15], a.in[18], a.in[19], (const int*)(ws + WS_PID), FP(WS_PW), a.in[20], a.out);
            break;
        default: break;
        }
    }
#undef BF
#undef FP
}
```

```cpp
#include <hip/hip_runtime.h>
#include <hip/hip_cooperative_groups.h>
#include <cstdio>
#include <cstdint>
namespace cg = cooperative_groups;

constexpr int T_TOK = 65536, DM = 1024, NB = 8, SEQ = 8192, NMEM = 256;
constexpr int IN_COLS = 4608;
constexpr float EPS = 1e-6f;
constexpr float LOG2E = 1.4426950408889634f;
constexpr float C2M = 0.125f * LOG2E;
constexpr float C2X = 0.08838834764831845f * LOG2E;

typedef unsigned short bf16_t;
#define LAS __attribute__((address_space(3)))

constexpr size_t MiB = 1u << 20;
constexpr size_t WS_CTL = 0, CTL_BYTES = 1 * MiB;
constexpr size_t WS_ROPE = 1 * MiB;
constexpr size_t WS_WIN_T = 3 * MiB;
constexpr size_t WS_WAB_T = 12 * MiB;
constexpr size_t WS_WOUT_T = 14 * MiB;
constexpr size_t WS_XAQ_T = 16 * MiB;
constexpr size_t WS_XAKV_T = 17 * MiB;
constexpr size_t WS_XAO_T = 19 * MiB;
constexpr size_t WS_PQ_T = 20 * MiB;
constexpr size_t WS_SK = 24 * MiB;
constexpr size_t WS_WM = 24 * MiB + 512 * 1024;
constexpr size_t WS_MN = 25 * MiB;
constexpr size_t WS_XKV = 29 * MiB;
constexpr size_t WS_KMP = 33 * MiB;
constexpr size_t WS_SS1 = 34 * MiB;
constexpr size_t WS_SS2 = 38 * MiB;
constexpr size_t WS_SEL = 42 * MiB;
constexpr size_t WS_WD = 44 * MiB;
constexpr size_t WS_SD = 60 * MiB;
constexpr size_t WS_SU = 61 * MiB;
constexpr size_t WS_WU = 76 * MiB;
constexpr size_t WS_SS3 = 92 * MiB;
constexpr size_t WS_RA = 108 * MiB;
constexpr size_t WS_XN = WS_RA, WS_PART = WS_RA, WS_ML = WS_RA + 192 * MiB, WS_MERGED = WS_RA;
constexpr size_t WS_RB = 316 * MiB;
constexpr size_t WS_Q = WS_RB, WS_K = WS_RB + 64 * MiB, WS_V = WS_RB + 128 * MiB, WS_XB = WS_RB, WS_XQ = WS_V;
constexpr size_t WS_RC = 508 * MiB;
constexpr size_t WS_U = WS_RC, WS_GV = WS_RC + 64 * MiB, WS_XO = WS_U, WS_PID = WS_GV, WS_PW = WS_GV + 32 * MiB;
constexpr size_t WS_RD = 636 * MiB;
constexpr size_t WS_GA = WS_RD, WS_GB = WS_RD + 128 * MiB, WS_QP = WS_RD;
constexpr size_t WS_RE = 892 * MiB;
constexpr size_t WS_ATTGM = WS_RE, WS_COEF = WS_RE;
constexpr size_t WS_PARTD = WS_RD;
constexpr size_t WS_END = 1020 * MiB;
constexpr size_t WS_RS = WS_SS2;

__device__ __forceinline__ float bf2f(bf16_t v) { return __uint_as_float((unsigned)v << 16); }
__device__ __forceinline__ bf16_t f2bf(float f) { unsigned u = __float_as_uint(f); return (bf16_t)((u + 0x7fffu + ((u >> 16) & 1u)) >> 16); }
__device__ __forceinline__ unsigned pk2(float lo, float hi) { return (unsigned)f2bf(lo) | ((unsigned)f2bf(hi) << 16); }
__device__ __forceinline__ float gelu_tanh(float x) { const float t = x * (-2.3022082f + -0.10294325f * (x * x)); return x * __builtin_amdgcn_rcpf(1.f + __builtin_amdgcn_exp2f(t)); }
__device__ __forceinline__ float sigmoidf(float x) { return __builtin_amdgcn_rcpf(1.f + __builtin_amdgcn_exp2f(-1.4426950409f * x)); }
template <int CTRL> __device__ __forceinline__ float dppf_(float v) { return __builtin_bit_cast(float, __builtin_amdgcn_update_dpp(0, __builtin_bit_cast(int, v), CTRL, 0xf, 0xf, true)); }
__device__ __forceinline__ float wave_sum(float v) {
    v += dppf_<0xB1>(v); v += dppf_<0x4E>(v); v += dppf_<0x141>(v); v += dppf_<0x140>(v);
    { auto rr = __builtin_amdgcn_permlane16_swap(__float_as_uint(v), __float_as_uint(v), false, false); v = __uint_as_float(rr[0]) + __uint_as_float(rr[1]); }
    { auto rr = __builtin_amdgcn_permlane32_swap(__float_as_uint(v), __float_as_uint(v), false, false); v = __uint_as_float(rr[0]) + __uint_as_float(rr[1]); }
    return v;
}
__device__ __forceinline__ float wave_max(float v) {
#pragma unroll
    for (int o = 1; o < 64; o <<= 1) v = fmaxf(v, __shfl_xor(v, o));
    return v;
}
__device__ __forceinline__ int qk_store_col(int d) { return 2 * (d & 31) + (d >> 5); }

struct Args { const float* in[21]; float* out; unsigned char* ws; int ph_lo, ph_hi, li, pad; };

template <bool QKPERM>
__device__ __forceinline__ void p0_transpose_item(const float* W, int ldw, int K, int Ncols, bf16_t* WT, int ldt, int col_off, const float* kscale, LAS float* scr, int item, int lane) {
    const int nblk = Ncols / 32, kb = item / nblk, nb = item % nblk, k0 = 64 * kb, n0 = 32 * nb;
#pragma unroll 8
    for (int i = 0; i < 32; ++i) { const int kk = 2 * i + (lane >> 5); float v = W[(size_t)(k0 + kk) * ldw + n0 + (lane & 31)]; if (kscale) v *= kscale[k0 + kk]; scr[kk * 33 + (lane & 31)] = v; }
    asm volatile("s_waitcnt lgkmcnt(0)" ::: "memory");
    const int c = lane & 7;
#pragma unroll
    for (int j = 0; j < 4; ++j) { const int n = (lane >> 3) + 8 * j; const LAS float* s = scr + (8 * c) * 33 + n;
        uint4 o; o.x = pk2(s[0 * 33], s[1 * 33]); o.y = pk2(s[2 * 33], s[3 * 33]); o.z = pk2(s[4 * 33], s[5 * 33]); o.w = pk2(s[6 * 33], s[7 * 33]);
        int nn = n0 + n;
        if (QKPERM) { if (nn < 1024) nn = (nn & ~63) + qk_store_col(nn & 63); }
        *(uint4*)(WT + (size_t)nn * ldt + col_off + k0 + 8 * c) = o; }
    asm volatile("s_waitcnt lgkmcnt(0)" ::: "memory");
}
template <int B>
__device__ __forceinline__ void rms_rows_to_bf16(const float* __restrict__ X, const float* __restrict__ g, bf16_t* __restrict__ O, size_t m0, size_t mstride, int lane) {
    float4 v[B][4];
#pragma unroll
    for (int u = 0; u < B; ++u) { const float4* xr = (const float4*)(X + (m0 + u * mstride) * DM) + lane;
#pragma unroll
        for (int j = 0; j < 4; ++j) v[u][j] = xr[64 * j]; }
    const float4* gr = (const float4*)g + lane; float4 gg[4];
#pragma unroll
    for (int j = 0; j < 4; ++j) gg[j] = gr[64 * j];
#pragma unroll
    for (int u = 0; u < B; ++u) { float s = 0.f;
#pragma unroll
        for (int j = 0; j < 4; ++j) s += (v[u][j].x * v[u][j].x + v[u][j].y * v[u][j].y) + (v[u][j].z * v[u][j].z + v[u][j].w * v[u][j].w);
        const float rstd = rsqrtf(wave_sum(s) * (1.f / DM) + EPS);
        uint2* o8 = (uint2*)(O + (m0 + u * mstride) * DM) + lane;
#pragma unroll
        for (int j = 0; j < 4; ++j) { uint2 o; o.x = pk2(v[u][j].x * rstd * gg[j].x, v[u][j].y * rstd * gg[j].y); o.y = pk2(v[u][j].z * rstd * gg[j].z, v[u][j].w * rstd * gg[j].w); o8[64 * j] = o; } }
}
__device__ __forceinline__ void p0_prologue(const Args& a, LAS unsigned char* lds) {
    const int tid = threadIdx.x, lane = tid & 63, wave = tid >> 6;
    const int gw = blockIdx.x * 8 + wave, NGW = gridDim.x * 8;
    unsigned char* ws = a.ws;
    LAS float* scr = (LAS float*)(lds + wave * 16384);
    constexpr int I_IN = (1024 / 64) * (IN_COLS / 32), I_A = (512 / 64) * (1024 / 32), I_O = (1024 / 64) * (1024 / 32), I_XQ = (1024 / 64) * (512 / 32), I_KV = I_O, I_XO = (512 / 64) * (1024 / 32), I_PQ = (1024 / 64) * (2048 / 32);
    constexpr int NITEMS = I_IN + 2 * I_A + I_O + I_XQ + I_KV + I_XO + I_PQ;
    for (int it = gw; it < NITEMS; it += NGW) {
        int r = it;
        if (r < I_IN) { p0_transpose_item<true>(a.in[3], IN_COLS, 1024, IN_COLS, (bf16_t*)(ws + WS_WIN_T), 1024, 0, nullptr, scr, r, lane); continue; } r -= I_IN;
        if (r < I_A) { p0_transpose_item<false>(a.in[4], 1024, 512, 1024, (bf16_t*)(ws + WS_WAB_T), 1024, 0, nullptr, scr, r, lane); continue; } r -= I_A;
        if (r < I_A) { p0_transpose_item<false>(a.in[8], 1024, 512, 1024, (bf16_t*)(ws + WS_WAB_T), 1024, 512, nullptr, scr, r, lane); continue; } r -= I_A;
        if (r < I_O) { p0_transpose_item<false>(a.in[9], 1024, 1024, 1024, (bf16_t*)(ws + WS_WOUT_T), 1024, 0, nullptr, scr, r, lane); continue; } r -= I_O;
        if (r < I_XQ) { p0_transpose_item<false>(a.in[12], 512, 1024, 512, (bf16_t*)(ws + WS_XAQ_T), 1024, 0, a.in[10], scr, r, lane); continue; } r -= I_XQ;
        if (r < I_KV) { p0_transpose_item<false>(a.in[13], 1024, 1024, 1024, (bf16_t*)(ws + WS_XAKV_T), 1024, 0, nullptr, scr, r, lane); continue; } r -= I_KV;
        if (r < I_XO) { p0_transpose_item<false>(a.in[14], 1024, 512, 1024, (bf16_t*)(ws + WS_XAO_T), 512, 0, nullptr, scr, r, lane); continue; } r -= I_XO;
        p0_transpose_item<false>(a.in[16], 2048, 1024, 2048, (bf16_t*)(ws + WS_PQ_T), 1024, 0, a.in[15], scr, r, lane);
    }
    const size_t gt = (size_t)blockIdx.x * blockDim.x + tid, GT = (size_t)gridDim.x * blockDim.x;
    {
        const float* s = a.in[17]; bf16_t* d = (bf16_t*)(ws + WS_SK);
        for (size_t i = gt; i < 8 * 2 * 128 * 128 / 4; i += GT) { const float4 v = ((const float4*)s)[i]; uint2 o; o.x = pk2(v.x, v.y); o.y = pk2(v.z, v.w); ((uint2*)d)[i] = o; }
    }
    {
        const float* s = a.in[6]; bf16_t* d = (bf16_t*)(ws + WS_WM);
        for (size_t i = gt; i < 8 * 128 * 128; i += GT) { const int ss = i & 127, tt = (i >> 7) & 127; d[i] = f2bf(ss <= tt ? s[i] : 0.f); }
    }
    {
        float2* d = (float2*)(ws + WS_ROPE);
        for (size_t i = gt; i < 8192 * 32; i += GT) { const int p = (int)(i >> 5), k = (int)(i & 31);
            const float freq = powf(10000.0f, -(float)k / 32.0f); const float ang = (float)p * freq; float sn, cs; sincosf(ang, &sn, &cs); d[i] = make_float2(cs, sn); }
    }
    for (int r0 = gw; r0 < 2 * 16384; r0 += 4 * NGW) {
        float v[4][16];
#pragma unroll
        for (int u = 0; u < 4; ++u) { const int r = r0 + u * NGW; if (r < 2 * 16384) { const int which = r >> 14, e = r & 16383; const float* src = (which ? a.in[19] : a.in[18]) + (size_t)e * 1024 + lane * 16;
#pragma unroll
            for (int q = 0; q < 4; ++q) { const float4 t4 = *(const float4*)(src + 4 * q); v[u][4 * q] = t4.x; v[u][4 * q + 1] = t4.y; v[u][4 * q + 2] = t4.z; v[u][4 * q + 3] = t4.w; } } }
#pragma unroll
        for (int u = 0; u < 4; ++u) { const int r = r0 + u * NGW; if (r < 2 * 16384) { const int which = r >> 14, e = r & 16383;
            if (!which) {
#pragma unroll
                for (int q = 0; q < 4; ++q) { const float4 g4 = *(const float4*)(a.in[15] + lane * 16 + 4 * q); v[u][4 * q] *= g4.x; v[u][4 * q + 1] *= g4.y; v[u][4 * q + 2] *= g4.z; v[u][4 * q + 3] *= g4.w; } }
            float am = 0.f;
#pragma unroll
            for (int q = 0; q < 16; ++q) am = fmaxf(am, fabsf(v[u][q]));
            am = wave_max(am);
            const float qmax = which ? 440.f : 127.f;
            const float inv = am > 0.f ? qmax / am : 0.f;
            if (lane == 0) ((float*)(ws + (which ? WS_SU : WS_SD)))[e] = am > 0.f ? am / qmax : 1.f;
            unsigned w[4];
            if (which) {
#pragma unroll
                for (int q = 0; q < 4; ++q) { int pk = __builtin_amdgcn_cvt_pk_fp8_f32(v[u][4 * q] * inv, v[u][4 * q + 1] * inv, 0, false); pk = __builtin_amdgcn_cvt_pk_fp8_f32(v[u][4 * q + 2] * inv, v[u][4 * q + 3] * inv, pk, true); w[q] = (unsigned)pk; }
            } else {
#pragma unroll
                for (int q = 0; q < 4; ++q) w[q] = ((unsigned)__float2int_rn(v[u][4 * q] * inv) & 0xffu) | (((unsigned)__float2int_rn(v[u][4 * q + 1] * inv) & 0xffu) << 8) | (((unsigned)__float2int_rn(v[u][4 * q + 2] * inv) & 0xffu) << 16) | ((unsigned)__float2int_rn(v[u][4 * q + 3] * inv) << 24);
            }
            *(uint4*)(ws + (which ? WS_WU : WS_WD) + (size_t)(lane >> 3) * (16384 * 128) + (size_t)e * 128 + (lane & 7) * 16) = make_uint4(w[0], w[1], w[2], w[3]); } }
    }
    { size_t m = gw;
      for (; m + 3 * (size_t)NGW < T_TOK; m += 4 * (size_t)NGW) rms_rows_to_bf16<4>(a.in[0], a.in[2], (bf16_t*)(ws + WS_XN), m, NGW, lane);
      for (; m < T_TOK; m += NGW) rms_rows_to_bf16<1>(a.in[0], a.in[2], (bf16_t*)(ws + WS_XN), m, NGW, lane); }
    for (size_t m = gw; m < NB * NMEM; m += NGW) rms_rows_to_bf16<1>(a.in[1], a.in[11], (bf16_t*)(ws + WS_MN), m, NGW, lane);
}


namespace pg8 {
typedef short bf16x8 __attribute__((ext_vector_type(8)));
typedef float f32x4 __attribute__((ext_vector_type(4)));
typedef unsigned u32x4 __attribute__((ext_vector_type(4)));
constexpr int BM = 256, BK = 64, HALF = 128, HTB = HALF * BK * 2, STAGE_BYTES = 8 * HTB, NXCD = 8, WGM = 8;
__host__ __device__ __forceinline__ int lds_byte(int r, int c) { const int st = (r >> 4) * 2 + (c >> 5), rr = r & 15, cc = c & 31, ob = rr * 64 + cc * 2; return st * 1024 + (ob ^ (((ob >> 9) & 1) << 5)); }
__host__ __device__ __forceinline__ void stage_rc(int b, int& R, int& C) { const int st = b / 1024, sb = b % 1024, swz = sb ^ (((sb >> 9) & 1) << 5); R = (st >> 1) * 16 + swz / 64; C = (st & 1) * 32 + (swz % 64) / 2; }
__host__ __device__ __forceinline__ int perm32(int rho) { const int n = rho >> 4, i = rho & 15; return 8 * (i >> 2) + 4 * n + (i & 3); }
struct Unit { int pm, pn, kofs, var; };
struct Gemm { const bf16_t* A; const bf16_t* Bt; int lda, ldb, K; };
struct StaticOrder {
    int nM, nN, nwg, G, c, NV, kvar;
    __device__ void init(int M, int N, int G_, int c_, int NV_ = 1, int kvar_ = 0) { nM = M / BM; nN = N / BM; nwg = nM * nN; G = G_; c = c_; NV = NV_; kvar = kvar_; }
    __device__ bool next(int i, Unit& u) const {
        const int it = i / NV, v = i - it * NV;
        const long L = (long)it * G + c; if (L >= nwg) return false;
        int wgid = (int)L; { const int q = nwg / NXCD, r = nwg % NXCD, xcd = wgid % NXCD, off = wgid / NXCD; wgid = (xcd < r ? xcd * (q + 1) : r * (q + 1) + (xcd - r) * q) + off; }
        const int nig = WGM * nN, gid = wgid / nig, fm = gid * WGM, gsz = (nM - fm) < WGM ? (nM - fm) : WGM;
        u.pm = fm + ((wgid % nig) % gsz); u.pn = (wgid % nig) / gsz; u.kofs = v * kvar; u.var = v; return true;
    }
};
typedef __bf16 cvt_bf16x2 __attribute__((ext_vector_type(2)));
typedef float cvt_f32x2 __attribute__((ext_vector_type(2)));
__device__ __forceinline__ unsigned cvt_pk_bf16(float lo, float hi) { const cvt_f32x2 v = {lo, hi}; return __builtin_bit_cast(unsigned, __builtin_convertvector(v, cvt_bf16x2)); }
__device__ __forceinline__ u32x4 pack8(const f32x4 a, const f32x4 b) { u32x4 w; w.x = cvt_pk_bf16(a[0], a[1]); w.y = cvt_pk_bf16(a[2], a[3]); w.z = cvt_pk_bf16(b[0], b[1]); w.w = cvt_pk_bf16(b[2], b[3]); return w; }
__device__ __forceinline__ void unpack8(const u32x4 w, f32x4& a, f32x4& b) {
    a[0] = __uint_as_float(w.x << 16); a[1] = __uint_as_float(w.x & 0xffff0000u); a[2] = __uint_as_float(w.y << 16); a[3] = __uint_as_float(w.y & 0xffff0000u);
    b[0] = __uint_as_float(w.z << 16); b[1] = __uint_as_float(w.z & 0xffff0000u); b[2] = __uint_as_float(w.w << 16); b[3] = __uint_as_float(w.w & 0xffff0000u); }

template <class Epi, class Sched, bool MIDHOOK = false>
__device__ __forceinline__ void gemm_phase(LAS unsigned char* lds, const Gemm g, const Sched& S, const Epi& E) {
    const int tid = threadIdx.x, wid = __builtin_amdgcn_readfirstlane(tid >> 6), lane = tid & 63, wr = wid >> 2, wc = wid & 3, fr = lane & 15, fq = lane >> 4;
    const int nt = g.K / BK;
    unsigned voffA[2], voffB[2];
#pragma unroll
    for (int i = 0; i < 2; ++i) { int R, C; stage_rc(tid * 16 + i * 8192, R, C); const int Rb = (R & ~31) + perm32(R & 31);
        voffA[i] = (unsigned)(R * g.lda + C) * 2u; voffB[i] = (unsigned)(Rb * g.ldb + C) * 2u; }
    const size_t kstep = (size_t)(BK * 2);
    const size_t hstepA = (size_t)HALF * g.lda * 2, hstepB = (size_t)HALF * g.ldb * 2;
    const size_t tstepA = 2 * hstepA, tstepB = 2 * hstepB;
    const unsigned ldsw = (unsigned)wid * 1024u;
    const int aoff = lds_byte(wr * 64 + fr, fq * 8), boff = lds_byte(wc * 32 + fr, fq * 8);
#define PG8_SA(b, h) (((b) * 2 + (h)) * HTB)
#define PG8_SB(b, h) ((4 + (b) * 2 + (h)) * HTB)
#define PG8_STAGE(bufoff, gbase, voff) do { _Pragma("unroll") for (int _i = 0; _i < 2; ++_i) \
        __builtin_amdgcn_global_load_lds((const unsigned*)((const char*)(gbase) + (voff)[_i]), (LAS unsigned*)(lds + (bufoff) + ldsw + _i * 8192), 16, 0, 0); } while (0)
#define PG8_LDA(dst, b, h) do { _Pragma("unroll") for (int m = 0; m < 4; ++m) _Pragma("unroll") for (int k = 0; k < 2; ++k) dst[m][k] = *(const LAS bf16x8*)(lds + PG8_SA(b, h) + aoff + m * 2048 + k * 1024); } while (0)
#define PG8_LDB(dst, b, h) do { _Pragma("unroll") for (int n = 0; n < 2; ++n) _Pragma("unroll") for (int k = 0; k < 2; ++k) dst[n][k] = *(const LAS bf16x8*)(lds + PG8_SB(b, h) + boff + n * 2048 + k * 1024); } while (0)
#define PG8_MMA(ai, bj, At, Bt) do { __builtin_amdgcn_s_setprio(1); _Pragma("unroll") for (int m = 0; m < 4; ++m) _Pragma("unroll") for (int n = 0; n < 2; ++n) _Pragma("unroll") for (int k = 0; k < 2; ++k) \
        acc[ai][bj][m][n] = __builtin_amdgcn_mfma_f32_16x16x32_bf16(Bt[n][k], At[m][k], acc[ai][bj][m][n], 0, 0, 0); __builtin_amdgcn_s_setprio(0); } while (0)
#define PG8_WAIT_V(n) asm volatile("s_waitcnt vmcnt(" #n ")" ::: "memory")
#define PG8_WAIT_L(n) asm volatile("s_waitcnt lgkmcnt(" #n ")" ::: "memory")
#define PG8_BAR __builtin_amdgcn_s_barrier()
#define PG8_SCHED __builtin_amdgcn_sched_barrier(0)
    Unit cur, nxt; int ui = 0;
    if (!S.next(0, cur)) return;
    f32x4 acc[2][2][4][2];
#pragma unroll
    for (int a = 0; a < 2; ++a)
#pragma unroll
        for (int b = 0; b < 2; ++b)
#pragma unroll
            for (int m = 0; m < 4; ++m)
#pragma unroll
                for (int n = 0; n < 2; ++n) acc[a][b][m][n] = (f32x4){0.f, 0.f, 0.f, 0.f};
    bf16x8 At[4][2], B0[2][2], B1[2][2];
    const char* cA = (const char*)g.A + (size_t)cur.pm * tstepA + (size_t)cur.kofs * 2; const char* cB = (const char*)g.Bt + (size_t)cur.pn * tstepB + (size_t)cur.kofs * 2;
    PG8_STAGE(PG8_SB(0, 0), cB, voffB); PG8_STAGE(PG8_SB(0, 1), cB + hstepB, voffB); PG8_STAGE(PG8_SA(0, 0), cA, voffA); PG8_STAGE(PG8_SA(0, 1), cA + hstepA, voffA);
    if (wr == 1) PG8_BAR;
    PG8_WAIT_V(2); PG8_BAR;
    PG8_STAGE(PG8_SB(1, 0), cB + kstep, voffB); PG8_STAGE(PG8_SA(1, 0), cA + kstep, voffA); PG8_STAGE(PG8_SB(1, 1), cB + hstepB + kstep, voffB);
    PG8_WAIT_V(6); PG8_BAR;
    for (;;) {
        const bool has_next = S.next(ui + 1, nxt);
        const char* nA = has_next ? (const char*)g.A + (size_t)nxt.pm * tstepA + (size_t)nxt.kofs * 2 : cA; const char* nB = has_next ? (const char*)g.Bt + (size_t)nxt.pn * tstepB + (size_t)nxt.kofs * 2 : cB;
#define PG8_KPAIR(t) do { \
            const bool last = (t == nt - 2); \
            const char* a1 = cA + (size_t)(t + 1) * kstep; \
            const char* a2 = last ? nA : cA + (size_t)(t + 2) * kstep; const char* b2 = last ? nB : cB + (size_t)(t + 2) * kstep; \
            const char* a3 = a2 + kstep; const char* b3 = b2 + kstep; \
            PG8_LDB(B0, 0, 0); PG8_LDB(B1, 0, 1); PG8_SCHED; PG8_LDA(At, 0, 0); PG8_STAGE(PG8_SA(1, 1), a1 + hstepA, voffA); \
            PG8_WAIT_V(8); PG8_WAIT_L(0); PG8_BAR; PG8_MMA(0, 0, At, B0); PG8_MMA(0, 1, At, B1); PG8_BAR; PG8_SCHED; \
            PG8_LDA(At, 0, 1); PG8_STAGE(PG8_SB(0, 0), b2, voffB); PG8_STAGE(PG8_SB(0, 1), b2 + hstepB, voffB); PG8_STAGE(PG8_SA(0, 0), a2, voffA); \
            PG8_WAIT_V(8); PG8_WAIT_L(0); PG8_BAR; PG8_MMA(1, 0, At, B0); PG8_MMA(1, 1, At, B1); PG8_BAR; PG8_SCHED; \
            PG8_LDB(B0, 1, 0); PG8_LDB(B1, 1, 1); PG8_SCHED; PG8_LDA(At, 1, 0); PG8_STAGE(PG8_SA(0, 1), a2 + hstepA, voffA); \
            PG8_WAIT_V(8); PG8_WAIT_L(0); PG8_BAR; PG8_MMA(0, 0, At, B0); PG8_MMA(0, 1, At, B1); PG8_BAR; PG8_SCHED; \
            PG8_LDA(At, 1, 1); PG8_STAGE(PG8_SB(1, 0), b3, voffB); PG8_STAGE(PG8_SB(1, 1), b3 + hstepB, voffB); PG8_STAGE(PG8_SA(1, 0), a3, voffA); \
            PG8_WAIT_V(8); PG8_WAIT_L(0); PG8_BAR; PG8_MMA(1, 0, At, B0); PG8_MMA(1, 1, At, B1); PG8_BAR; PG8_SCHED; \
        } while (0)
        if constexpr (MIDHOOK) {
            for (int t = 0; t < nt / 2; t += 2) PG8_KPAIR(t);
            E.mid(acc, cur, wr, wc, fr, fq);
            for (int t = nt / 2; t < nt; t += 2) PG8_KPAIR(t);
        } else {
            for (int t = 0; t < nt; t += 2) PG8_KPAIR(t);
        }
#undef PG8_KPAIR
        if (wr == 0) PG8_BAR;
        E(acc, cur, wr, wc, fr, fq);
        if (!has_next) break;
#pragma unroll
        for (int a = 0; a < 2; ++a)
#pragma unroll
            for (int b = 0; b < 2; ++b)
#pragma unroll
                for (int m = 0; m < 4; ++m)
#pragma unroll
                    for (int n = 0; n < 2; ++n) acc[a][b][m][n] = (f32x4){0.f, 0.f, 0.f, 0.f};
        cur = nxt; cA = nA; cB = nB; ++ui;
        if (wr == 1) PG8_BAR;
    }
    PG8_WAIT_V(0);
    PG8_BAR;
#undef PG8_SA
#undef PG8_SB
#undef PG8_STAGE
#undef PG8_LDA
#undef PG8_LDB
#undef PG8_MMA
#undef PG8_WAIT_V
#undef PG8_WAIT_L
#undef PG8_BAR
#undef PG8_SCHED
}

#define EPI_ROWS() const int row0 = u.pm * BM + wr * 64 + fr; const int cw = wc * 32 + 8 * fq
template <int ACT>
__device__ __forceinline__ void store_act(const f32x4 (&acc)[2][2][4][2], bf16_t* O, int ldc, int colt, int row0, int cw) {
#pragma unroll
    for (int ai = 0; ai < 2; ++ai)
#pragma unroll
        for (int m = 0; m < 4; ++m) { bf16_t* rowp = O + (size_t)(row0 + ai * HALF + m * 16) * ldc + colt + cw;
#pragma unroll
            for (int bj = 0; bj < 2; ++bj) { f32x4 v0 = acc[ai][bj][m][0], v1 = acc[ai][bj][m][1];
                if (ACT != 0) asm volatile("" : "+v"(v0[0]), "+v"(v0[1]), "+v"(v0[2]), "+v"(v0[3]), "+v"(v1[0]), "+v"(v1[1]), "+v"(v1[2]), "+v"(v1[3]) :: "memory");
                if (ACT == 1) {
#pragma unroll
                    for (int e = 0; e < 4; ++e) { v0[e] = gelu_tanh(v0[e]); v1[e] = gelu_tanh(v1[e]); } }
                if (ACT == 2) {
#pragma unroll
                    for (int e = 0; e < 4; ++e) { v0[e] = sigmoidf(v0[e]); v1[e] = sigmoidf(v1[e]); } }
                *(u32x4*)(rowp + bj * HALF) = pack8(v0, v1);
 } }
}
struct EpiPlain { bf16_t* O; int ldc;
    __device__ __forceinline__ void operator()(const f32x4 (&acc)[2][2][4][2], const Unit& u, int wr, int wc, int fr, int fq) const { EPI_ROWS(); store_act<0>(acc, O, ldc, u.pn * BM, row0, cw); } };
struct EpiInProj { bf16_t *Q, *K, *V, *U, *GV, *GA, *GB; float* KMP; const float2* rope;
    __device__ __forceinline__ void operator()(const f32x4 (&acc)[2][2][4][2], const Unit& u, int wr, int wc, int fr, int fq) const {
        EPI_ROWS(); const int pn = u.pn;
        if (pn < 4) {
            const bool isk = pn >= 2; bf16_t* O = isk ? K : Q; const float sc = isk ? 1.f : C2M; const int ct = (pn & 1) * 256;
            const int i0 = ((wc & 1) * 32 + 8 * fq) >> 1;
            f32x4 ks[2][2];
#pragma unroll
            for (int bj = 0; bj < 2; ++bj) { ks[bj][0] = (f32x4){0.f, 0.f, 0.f, 0.f}; ks[bj][1] = (f32x4){0.f, 0.f, 0.f, 0.f}; }
            f32x4 tt[2][4][2];
#pragma unroll
            for (int ai = 0; ai < 2; ++ai)
#pragma unroll
                for (int m = 0; m < 4; ++m) { const int pos = (row0 + ai * HALF + m * 16) & (SEQ - 1); tt[ai][m][0] = *(const f32x4*)(rope + pos * 32 + i0); tt[ai][m][1] = *(const f32x4*)(rope + pos * 32 + i0 + 2); }
#pragma unroll
            for (int ai = 0; ai < 2; ++ai)
#pragma unroll
                for (int m = 0; m < 4; ++m) { const int r = row0 + ai * HALF + m * 16;
                    const f32x4 t0 = tt[ai][m][0], t1 = tt[ai][m][1];
#pragma unroll
                    for (int bj = 0; bj < 2; ++bj) { const f32x4 v0 = acc[ai][bj][m][0], v1 = acc[ai][bj][m][1]; f32x4 o0, o1;
                        o0[0] = v0[0] * t0[0] - v0[1] * t0[1]; o0[1] = v0[1] * t0[0] + v0[0] * t0[1];
                        o0[2] = v0[2] * t0[2] - v0[3] * t0[3]; o0[3] = v0[3] * t0[2] + v0[2] * t0[3];
                        o1[0] = v1[0] * t1[0] - v1[1] * t1[1]; o1[1] = v1[1] * t1[0] + v1[0] * t1[1];
                        o1[2] = v1[2] * t1[2] - v1[3] * t1[3]; o1[3] = v1[3] * t1[2] + v1[2] * t1[3];
                        if (isk) { ks[bj][0] += o0; ks[bj][1] += o1; }
                        *(u32x4*)(O + (size_t)r * 512 + ct + bj * HALF + cw) = pack8(o0 * sc, o1 * sc); } }
            if (isk) {
#pragma unroll
                for (int bj = 0; bj < 2; ++bj)
#pragma unroll
                    for (int n = 0; n < 2; ++n)
#pragma unroll
                        for (int e = 0; e < 4; ++e) { float v = ks[bj][n][e]; v += __shfl_xor(v, 1); v += __shfl_xor(v, 2); v += __shfl_xor(v, 4); v += __shfl_xor(v, 8); ks[bj][n][e] = v; }
                if (fr == 0) {
#pragma unroll
                    for (int bj = 0; bj < 2; ++bj)
#pragma unroll
                        for (int n = 0; n < 2; ++n) *(f32x4*)(KMP + ((size_t)u.pm * 2 + wr) * 512 + ct + bj * HALF + cw + 4 * n) = ks[bj][n]; }
            }
        } else if (pn < 6) store_act<0>(acc, V, 512, (pn - 4) * BM, row0, cw);
        else if (pn < 8) store_act<1>(acc, U, 512, (pn - 6) * BM, row0, cw);
        else if (pn < 10) store_act<1>(acc, GV, 512, (pn - 8) * BM, row0, cw);
        else if (pn < 14) store_act<2>(acc, GA, 1024, (pn - 10) * BM, row0, cw);
        else store_act<2>(acc, GB, 1024, (pn - 14) * BM, row0, cw);
    } };
struct EpiMerged { const bf16_t *GA, *GB; bf16_t* MG;
    __device__ __forceinline__ void operator()(const f32x4 (&acc)[2][2][4][2], const Unit& u, int wr, int wc, int fr, int fq) const {
        EPI_ROWS(); const bf16_t* G = u.var ? GB : GA;
#pragma unroll
        for (int ai = 0; ai < 2; ++ai) {
            u32x4 gq[4][2], pq[4][2];
#pragma unroll
            for (int m = 0; m < 4; ++m)
#pragma unroll
                for (int bj = 0; bj < 2; ++bj) { const size_t off = (size_t)(row0 + ai * HALF + m * 16) * 1024 + u.pn * BM + cw + bj * HALF; gq[m][bj] = *(const u32x4*)(G + off); if (u.var) pq[m][bj] = *(const u32x4*)(MG + off); }
#pragma unroll
            for (int m = 0; m < 4; ++m)
#pragma unroll
                for (int bj = 0; bj < 2; ++bj) { const size_t off = (size_t)(row0 + ai * HALF + m * 16) * 1024 + u.pn * BM + cw + bj * HALF; f32x4 g0, g1; unpack8(gq[m][bj], g0, g1);
                    f32x4 v0 = acc[ai][bj][m][0] * g0, v1 = acc[ai][bj][m][1] * g1;
                    if (u.var) { f32x4 p0, p1; unpack8(pq[m][bj], p0, p1); v0 += p0; v1 += p1; }
                    *(u32x4*)(MG + off) = pack8(v0, v1); }
        }
    } };
struct EpiMergedFused { const bf16_t *GA, *GB; bf16_t* MG;
    __device__ __forceinline__ void mid(f32x4 (&acc)[2][2][4][2], const Unit& u, int wr, int wc, int fr, int fq) const {
        EPI_ROWS();
#pragma unroll
        for (int ai = 0; ai < 2; ++ai)
#pragma unroll
            for (int mh = 0; mh < 2; ++mh) {
                u32x4 ga[2][2], gb[2][2];
#pragma unroll
                for (int mm = 0; mm < 2; ++mm)
#pragma unroll
                    for (int bj = 0; bj < 2; ++bj) { const size_t off = (size_t)(row0 + ai * HALF + (mh * 2 + mm) * 16) * 1024 + u.pn * BM + cw + bj * HALF; ga[mm][bj] = *(const u32x4*)(GA + off); gb[mm][bj] = *(const u32x4*)(GB + off); }
#pragma unroll
                for (int mm = 0; mm < 2; ++mm)
#pragma unroll
                    for (int bj = 0; bj < 2; ++bj) { const int m = mh * 2 + mm; f32x4 a0, a1, b0, b1; unpack8(ga[mm][bj], a0, a1); unpack8(gb[mm][bj], b0, b1);
#pragma unroll
                        for (int e = 0; e < 4; ++e) { acc[ai][bj][m][0][e] *= a0[e] * __builtin_amdgcn_rcpf(fmaxf(b0[e], 1e-30f)); acc[ai][bj][m][1][e] *= a1[e] * __builtin_amdgcn_rcpf(fmaxf(b1[e], 1e-30f)); } }
                asm volatile("" ::: "memory");
            }
    }
    __device__ __forceinline__ void operator()(const f32x4 (&acc)[2][2][4][2], const Unit& u, int wr, int wc, int fr, int fq) const {
        EPI_ROWS();
#pragma unroll
        for (int ai = 0; ai < 2; ++ai) {
            u32x4 gb[4][2];
#pragma unroll
            for (int m = 0; m < 4; ++m)
#pragma unroll
                for (int bj = 0; bj < 2; ++bj) gb[m][bj] = *(const u32x4*)(GB + (size_t)(row0 + ai * HALF + m * 16) * 1024 + u.pn * BM + cw + bj * HALF);
#pragma unroll
            for (int m = 0; m < 4; ++m)
#pragma unroll
                for (int bj = 0; bj < 2; ++bj) { f32x4 b0, b1; unpack8(gb[m][bj], b0, b1);
                    *(u32x4*)(MG + (size_t)(row0 + ai * HALF + m * 16) * 1024 + u.pn * BM + cw + bj * HALF) = pack8(acc[ai][bj][m][0] * b0, acc[ai][bj][m][1] * b1); }
        }
    } };
template <bool RESBF> struct EpiResid { const float* res; bf16_t* XB; float* SS;
    __device__ __forceinline__ void operator()(const f32x4 (&acc)[2][2][4][2], const Unit& u, int wr, int wc, int fr, int fq) const {
        EPI_ROWS();
#pragma unroll
        for (int ai = 0; ai < 2; ++ai) {
            f32x4 xr[4][2][2];
#pragma unroll
            for (int m = 0; m < 4; ++m)
#pragma unroll
                for (int bj = 0; bj < 2; ++bj) { const size_t off = (size_t)(row0 + ai * HALF + m * 16) * 1024 + u.pn * BM + cw + bj * HALF;
                    if (RESBF) { const u32x4 w = *(const u32x4*)(XB + off); xr[m][bj][0] = __builtin_bit_cast(f32x4, w); }
                    else { xr[m][bj][0] = *(const f32x4*)(res + off); xr[m][bj][1] = *(const f32x4*)(res + off + 4); } }
#pragma unroll
            for (int m = 0; m < 4; ++m) { const int r = row0 + ai * HALF + m * 16; float ss = 0.f;
#pragma unroll
                for (int bj = 0; bj < 2; ++bj) { const size_t off = (size_t)r * 1024 + u.pn * BM + cw + bj * HALF; f32x4 x0, x1;
                    if (RESBF) unpack8(__builtin_bit_cast(u32x4, xr[m][bj][0]), x0, x1); else { x0 = xr[m][bj][0]; x1 = xr[m][bj][1]; }
                    const f32x4 v0 = acc[ai][bj][m][0] + x0, v1 = acc[ai][bj][m][1] + x1;
                    *(u32x4*)(XB + off) = pack8(v0, v1);
                    ss += (v0[0] * v0[0] + v0[1] * v0[1]) + (v0[2] * v0[2] + v0[3] * v0[3]) + (v1[0] * v1[0] + v1[1] * v1[1]) + (v1[2] * v1[2] + v1[3] * v1[3]); }
                ss += __shfl_xor(ss, 16); ss += __shfl_xor(ss, 32);
                if (fq == 0) SS[(size_t)r * 16 + u.pn * 4 + wc] = ss; }
        }
    } };
struct EpiRowScale { bf16_t* O; int ldc; const float* SS; float cscale;
    __device__ __forceinline__ void operator()(const f32x4 (&acc)[2][2][4][2], const Unit& u, int wr, int wc, int fr, int fq) const {
        EPI_ROWS();
        f32x4 sq[2][4];
#pragma unroll
        for (int ai = 0; ai < 2; ++ai)
#pragma unroll
            for (int m = 0; m < 4; ++m) sq[ai][m] = *(const f32x4*)(SS + (size_t)(row0 + ai * HALF + m * 16) * 16 + 4 * fq);
#pragma unroll
        for (int ai = 0; ai < 2; ++ai)
#pragma unroll
            for (int m = 0; m < 4; ++m) { const int r = row0 + ai * HALF + m * 16; const f32x4 s4 = sq[ai][m];
                float st = (s4[0] + s4[1]) + (s4[2] + s4[3]); st += __shfl_xor(st, 16); st += __shfl_xor(st, 32);
                const float rs = rsqrtf(st * (1.f / DM) + EPS) * cscale;
                bf16_t* rowp = O + (size_t)r * ldc + u.pn * BM + cw;
#pragma unroll
                for (int bj = 0; bj < 2; ++bj) *(u32x4*)(rowp + bj * HALF) = pack8(acc[ai][bj][m][0] * rs, acc[ai][bj][m][1] * rs); }
    } };
#undef EPI_ROWS
}


namespace att {
typedef unsigned u32x4 __attribute__((ext_vector_type(4)));
typedef float f32x4 __attribute__((ext_vector_type(4)));
typedef short bf16x8 __attribute__((ext_vector_type(8)));
typedef short s16x4 __attribute__((ext_vector_type(4)));
typedef float f32x16 __attribute__((ext_vector_type(16)));
typedef float f32x8 __attribute__((ext_vector_type(8)));
typedef float f32x2 __attribute__((ext_vector_type(2)));
#define KSWZ(row, colB) ((row) * 256 + ((colB) ^ (((row) & 7) << 4)))
#define SBAR() __builtin_amdgcn_sched_barrier(0)
constexpr float THR2 = 8.f;
__device__ __forceinline__ int crow(int r, int hi) { return (r & 3) + 8 * (r >> 2) + 4 * hi; }
__device__ __forceinline__ unsigned cvtpk(float lo, float hi) { return pg8::cvt_pk_bf16(lo, hi); }
template <bool SWAPK>
__device__ __forceinline__ void softmax_tile(f32x16& p0, f32x16& p1, float& m_reg, float& l_reg, float& alpha, f32x16& negm, bool first, bf16x8& pa0, bf16x8& pa1, bf16x8& pa2, bf16x8& pa3) {
    float pmax = p0[0];
#pragma unroll
    for (int r = 1; r < 16; ++r) pmax = fmaxf(pmax, p0[r]);
#pragma unroll
    for (int r = 0; r < 16; ++r) pmax = fmaxf(pmax, p1[r]);
    { auto rr = __builtin_amdgcn_permlane32_swap(__float_as_uint(pmax), __float_as_uint(pmax), false, false); pmax = fmaxf(__uint_as_float(rr[0]), __uint_as_float(rr[1])); }
    alpha = 1.f;
    if (first || !__all(pmax <= THR2)) {
        const float d = first ? pmax : fmaxf(pmax, 0.f);
        m_reg += d; alpha = first ? 1.f : __builtin_amdgcn_exp2f(-d);
#pragma unroll
        for (int r = 0; r < 16; ++r) { p0[r] -= d; p1[r] -= d; negm[r] = -m_reg; }
    }
#pragma unroll
    for (int r = 0; r < 16; ++r) { p0[r] = __builtin_amdgcn_exp2f(p0[r]); p1[r] = __builtin_amdgcn_exp2f(p1[r]); }
    float ps;
    { const f32x16 s16 = p0 + p1;
      const f32x8 s8 = s16.lo + s16.hi; const f32x4 s4 = s8.lo + s8.hi; const f32x2 s2 = s4.lo + s4.hi; ps = s2[0] + s2[1]; }
    { auto rr = __builtin_amdgcn_permlane32_swap(__float_as_uint(ps), __float_as_uint(ps), false, false); ps = __uint_as_float(rr[0]) + __uint_as_float(rr[1]); }
    l_reg = l_reg * alpha + ps;
#define PK4(P, BASE, OUT) do { unsigned a0 = cvtpk(P[BASE + 0], P[BASE + 1]), a1 = cvtpk(P[BASE + 2], P[BASE + 3]); \
    unsigned b0 = cvtpk(P[BASE + 4], P[BASE + 5]), b1 = cvtpk(P[BASE + 6], P[BASE + 7]); \
    auto r0 = __builtin_amdgcn_permlane32_swap(a0, b0, false, false); auto r1 = __builtin_amdgcn_permlane32_swap(a1, b1, false, false); \
    u32x4 w = {r0[0], r1[0], r0[1], r1[1]}; OUT = __builtin_bit_cast(bf16x8, w); } while (0)
#define PKD(P, BASE, OUT) do { u32x4 w = {cvtpk(P[BASE + 0], P[BASE + 1]), cvtpk(P[BASE + 2], P[BASE + 3]), cvtpk(P[BASE + 4], P[BASE + 5]), cvtpk(P[BASE + 6], P[BASE + 7])}; OUT = __builtin_bit_cast(bf16x8, w); } while (0)
    if (SWAPK) { PK4(p0, 0, pa0); PK4(p0, 8, pa1); PK4(p1, 0, pa2); PK4(p1, 8, pa3); }
    else { PKD(p0, 0, pa0); PKD(p0, 8, pa1); PKD(p1, 0, pa2); PKD(p1, 8, pa3); }
#undef PKD
#undef PK4
}
__device__ __forceinline__ void qkt128(f32x16& p0, f32x16& p1, const LAS unsigned char* Ks, const bf16x8* qr, const f32x16& negm, int r32, int hi) {
    p0 = negm; p1 = negm;
#pragma unroll
    for (int d0 = 0; d0 < 8; ++d0) { const int cb = (d0 * 16 + hi * 8) * 2;
        const bf16x8 b0 = *(const LAS bf16x8*)(Ks + KSWZ(r32, cb)); const bf16x8 b1 = *(const LAS bf16x8*)(Ks + KSWZ(32 + r32, cb));
        p0 = __builtin_amdgcn_mfma_f32_32x32x16_bf16(b0, qr[d0], p0, 0, 0, 0); p1 = __builtin_amdgcn_mfma_f32_32x32x16_bf16(b1, qr[d0], p1, 0, 0, 0); }
}
__device__ __forceinline__ int v_st(int k, int c) { const int kk = (k & ~0xC) | ((k & 4) << 1) | ((k & 8) >> 1); return ((kk >> 3) * 4 + (c >> 5)) * 512 + ((kk & 7) * 32 + (c & 31)) * 2; }
__device__ __forceinline__ int v_rd_base(int lane) { return ((lane & 3) << 3) | (((lane >> 2) & 3) << 6) | (((lane >> 4) & 1) << 5) | (((lane >> 5) & 1) << 8); }
constexpr int v_rd_off(int d0, int ks, int half) { return d0 * 512 + ks * 4096 + half * 2048; }
template <int OFF> __device__ __forceinline__ s16x4 tr_read(int vb) { s16x4 r; asm volatile("ds_read_b64_tr_b16 %0, %1 offset:%2" : "=&v"(r) : "v"(vb), "i"(OFF) : "memory"); return r; }
template <int D0> __device__ __forceinline__ void pv_one(f32x16& od, int vb, bf16x8 pa0, bf16x8 pa1, bf16x8 pa2, bf16x8 pa3) {
    const s16x4 l0 = tr_read<v_rd_off(D0, 0, 0)>(vb), h0 = tr_read<v_rd_off(D0, 0, 1)>(vb), l1 = tr_read<v_rd_off(D0, 1, 0)>(vb), h1 = tr_read<v_rd_off(D0, 1, 1)>(vb);
    const s16x4 l2 = tr_read<v_rd_off(D0, 2, 0)>(vb), h2 = tr_read<v_rd_off(D0, 2, 1)>(vb), l3 = tr_read<v_rd_off(D0, 3, 0)>(vb), h3 = tr_read<v_rd_off(D0, 3, 1)>(vb);
    asm volatile("s_waitcnt lgkmcnt(0)" ::: "memory"); SBAR();
#define PK(L, H) (bf16x8){L[0], L[1], L[2], L[3], H[0], H[1], H[2], H[3]}
    od = __builtin_amdgcn_mfma_f32_32x32x16_bf16(pa0, PK(l0, h0), od, 0, 0, 0);
    od = __builtin_amdgcn_mfma_f32_32x32x16_bf16(pa1, PK(l1, h1), od, 0, 0, 0);
    od = __builtin_amdgcn_mfma_f32_32x32x16_bf16(pa2, PK(l2, h2), od, 0, 0, 0);
    od = __builtin_amdgcn_mfma_f32_32x32x16_bf16(pa3, PK(l3, h3), od, 0, 0, 0);
#undef PK
}

__device__ __forceinline__ void qkt64(f32x16& p0, f32x16& p1, const LAS unsigned char* Kt, const bf16x8* qr, const f32x16& negm, int r32, int hi) {
    const LAS unsigned char* kb = Kt + hi * 1024 + r32 * 16;
    p0 = negm; p1 = negm;
#pragma unroll
    for (int d0 = 0; d0 < 4; ++d0) { const bf16x8 b0 = *(const LAS bf16x8*)(kb + d0 * 2048), b1 = *(const LAS bf16x8*)(kb + d0 * 2048 + 512);
        p0 = __builtin_amdgcn_mfma_f32_32x32x16_bf16(b0, qr[d0], p0, 0, 0, 0); p1 = __builtin_amdgcn_mfma_f32_32x32x16_bf16(b1, qr[d0], p1, 0, 0, 0); }
}
template <int D0> __device__ __forceinline__ void pv64_one(f32x16& od, int vb, bf16x8 pa0, bf16x8 pa1, bf16x8 pa2, bf16x8 pa3) {
    const s16x4 l0 = tr_read<D0 * 4096 + 0>(vb), h0 = tr_read<D0 * 4096 + 512>(vb), l1 = tr_read<D0 * 4096 + 1024>(vb), h1 = tr_read<D0 * 4096 + 1536>(vb);
    const s16x4 l2 = tr_read<D0 * 4096 + 2048>(vb), h2 = tr_read<D0 * 4096 + 2560>(vb), l3 = tr_read<D0 * 4096 + 3072>(vb), h3 = tr_read<D0 * 4096 + 3584>(vb);
    asm volatile("s_waitcnt lgkmcnt(0)" ::: "memory"); SBAR();
#define PK(L, H) (bf16x8){L[0], L[1], L[2], L[3], H[0], H[1], H[2], H[3]}
    od = __builtin_amdgcn_mfma_f32_32x32x16_bf16(pa0, PK(l0, h0), od, 0, 0, 0);
    od = __builtin_amdgcn_mfma_f32_32x32x16_bf16(pa1, PK(l1, h1), od, 0, 0, 0);
    od = __builtin_amdgcn_mfma_f32_32x32x16_bf16(pa2, PK(l2, h2), od, 0, 0, 0);
    od = __builtin_amdgcn_mfma_f32_32x32x16_bf16(pa3, PK(l3, h3), od, 0, 0, 0);
#undef PK
}
constexpr int MB_K = 0, MB_V = 32768, MB_LIST = 65536, MB_WS = 81920, MB_MISC = 90112, MB_STG = 91136;
struct KVRegs { uint4 k[4], v[4]; };
__device__ __forceinline__ void moba_kv_load(KVRegs& R, const bf16_t* K, const bf16_t* V, size_t row0, int h, int tid) {
#pragma unroll
    for (int i = 0; i < 4; ++i) { const int key = tid & 255, ch = (tid >> 8) + 2 * i; R.k[i] = *(const uint4*)(K + (row0 + key) * 512 + h * 64 + ch * 8); }
#pragma unroll
    for (int i = 0; i < 4; ++i) { const int pc = tid + 512 * i, key = pc >> 3, c8 = pc & 7; R.v[i] = *(const uint4*)(V + (row0 + key) * 512 + h * 64 + c8 * 8); }
}
__device__ __forceinline__ void moba_kv_store(LAS unsigned char* lds, const KVRegs& R, int tid) {
#pragma unroll
    for (int i = 0; i < 4; ++i) { const int key = tid & 255, ch = (tid >> 8) + 2 * i;
        *(LAS u32x4*)(lds + MB_K + (key >> 6) * 8192 + ch * 1024 + (key & 63) * 16) = (u32x4){R.k[i].x, R.k[i].y, R.k[i].z, R.k[i].w}; }
#pragma unroll
    for (int i = 0; i < 4; ++i) { const int pc = tid + 512 * i, key = pc >> 3, c8 = pc & 7;
        *(LAS u32x4*)(lds + MB_V + (key >> 6) * 8192 + (c8 >> 2) * 4096 + ((key >> 4) & 3) * 1024 + (key & 15) * 64 + (c8 & 3) * 16) = (u32x4){R.v[i].x, R.v[i].y, R.v[i].z, R.v[i].w}; }
}
__device__ __forceinline__ void rescale_o2(f32x16 (&o)[2], float alpha, LAS float* wsf, int r32, int hi) {
    if (__any(alpha < 1.f)) { if (hi == 0) wsf[r32] = alpha; asm volatile("s_waitcnt lgkmcnt(0)" ::: "memory");
#pragma unroll
        for (int r = 0; r < 16; ++r) { const float al = wsf[crow(r, hi)]; o[0][r] *= al; o[1][r] *= al; }
        asm volatile("s_waitcnt lgkmcnt(0)" ::: "memory"); }
}
__device__ __forceinline__ void top3_insert(float v, int i, float& v0, int& i0, float& v1, int& i1, float& v2, int& i2) {
    const bool g0 = v > v0, g1 = v > v1, g2 = v > v2;
    v2 = g1 ? v1 : (g2 ? v : v2); i2 = g1 ? i1 : (g2 ? i : i2);
    v1 = g0 ? v0 : (g1 ? v : v1); i1 = g0 ? i0 : (g1 ? i : i1);
    v0 = g0 ? v : v0; i0 = g0 ? i : i0;
}
__device__ __forceinline__ void sel_phase(const bf16_t* __restrict__ Q, const float* __restrict__ KMP, signed char* __restrict__ SEL) {
    const int tid = threadIdx.x, lane = tid & 63, wid = tid >> 6, r32 = lane & 31, hi = lane >> 5;
    const int gw = blockIdx.x * 8 + wid, NGW = gridDim.x * 8;
    for (int wu = gw; wu < 64 * 32; wu += NGW) {
        const int bh = wu & 63, qb = wu >> 6, b = bh >> 3, h = bh & 7;
        if (qb == 0) {
#pragma unroll
            for (int g = 0; g < 4; ++g) ((unsigned*)SEL)[(size_t)(b * 8 + h) * SEQ + g * 64 + lane] = 0xffffffffu;
            continue;
        }
        bf16x8 ka[4];
        { const float* kp = KMP + (size_t)(b * 32 + r32) * 1024 + h * 64 + hi * 8;
#pragma unroll
          for (int ks = 0; ks < 4; ++ks) { const f32x4 a0 = *(const f32x4*)(kp + ks * 16), a1 = *(const f32x4*)(kp + ks * 16 + 4), c0 = *(const f32x4*)(kp + 512 + ks * 16), c1 = *(const f32x4*)(kp + 512 + ks * 16 + 4);
              const f32x4 s0 = (a0 + c0) * (1.f / 256.f), s1 = (a1 + c1) * (1.f / 256.f);
              const u32x4 w = {cvtpk(s0[0], s0[1]), cvtpk(s0[2], s0[3]), cvtpk(s1[0], s1[1]), cvtpk(s1[2], s1[3])}; ka[ks] = __builtin_bit_cast(bf16x8, w); } }
#pragma unroll 1
        for (int gp = 0; gp < 2; ++gp) {
            bf16x8 qf[4][4];
#pragma unroll
            for (int g = 0; g < 4; ++g)
#pragma unroll
                for (int ks = 0; ks < 4; ++ks) qf[g][ks] = *(const bf16x8*)(Q + ((size_t)b * SEQ + qb * 256 + (gp * 4 + g) * 32 + r32) * 512 + h * 64 + ks * 16 + hi * 8);
#pragma unroll
            for (int g = 0; g < 4; ++g) {
                f32x16 acc = {};
#pragma unroll
                for (int ks = 0; ks < 4; ++ks) acc = __builtin_amdgcn_mfma_f32_32x32x16_bf16(ka[ks], qf[g][ks], acc, 0, 0, 0);
                float v0 = -3e38f, v1 = -3e38f, v2 = -3e38f; int i0 = -1, i1 = -1, i2 = -1;
#pragma unroll
                for (int r = 0; r < 16; ++r) { const int n = crow(r, hi); if (n < qb) top3_insert(acc[r], n, v0, i0, v1, i1, v2, i2); }
                float pv[3] = {v0, v1, v2}; int pi[3] = {i0, i1, i2};
#pragma unroll
                for (int k = 0; k < 3; ++k) { auto rv = __builtin_amdgcn_permlane32_swap(__float_as_uint(pv[k]), __float_as_uint(pv[k]), false, false); auto ri = __builtin_amdgcn_permlane32_swap((unsigned)pi[k], (unsigned)pi[k], false, false);
                    const float ov = __uint_as_float(hi ? rv[0] : rv[1]); const int oi = (int)(hi ? ri[0] : ri[1]);
                    if (oi >= 0) top3_insert(ov, oi, v0, i0, v1, i1, v2, i2); }
                if (hi == 0) ((unsigned*)SEL)[(size_t)(b * 8 + h) * SEQ + qb * 256 + (gp * 4 + g) * 32 + r32] = (unsigned)(i0 & 0xff) | ((unsigned)(i1 & 0xff) << 8) | ((unsigned)(i2 & 0xff) << 16) | 0xff000000u;
            }
        }
    }
}
__device__ __forceinline__ void moba_sel_phase(LAS unsigned char* lds, const bf16_t* Q, const bf16_t* K, const bf16_t* V, const signed char* SEL, bf16_t* PART, float* ML, unsigned* qctr) {
    const int tid = threadIdx.x, wid = tid >> 6, lane = tid & 63, r32 = lane & 31, hi = lane >> 5;
    LAS float* wsf = (LAS float*)(lds + MB_WS + wid * 1024); LAS int* wsd = (LAS int*)(wsf + 64);
    LAS unsigned* misc = (LAS unsigned*)(lds + MB_MISC); LAS unsigned short* list = (LAS unsigned short*)(lds + MB_LIST);
    const int vb0 = (int)(uintptr_t)(lds + MB_V) + ((lane >> 4) & 1) * 32 + (lane & 3) * 8 + (4 * hi + ((lane & 15) >> 2)) * 64;
    constexpr int NU = 31 * 64;
    if (tid == 0) misc[2] = __hip_atomic_fetch_add(qctr, 1u, __ATOMIC_RELAXED, __HIP_MEMORY_SCOPE_AGENT);
    __syncthreads();
    int u = (int)misc[2];
    KVRegs R;
    if (u < NU) moba_kv_load(R, K, V, (size_t)((u & 63) >> 3) * SEQ + (size_t)(u >> 6) * 256, u & 7, tid);
    while (u < NU) {
        const int n = u >> 6, bh = u & 63, b = bh >> 3, h = bh & 7;
        __syncthreads();
        moba_kv_store(lds, R, tid);
        if (tid == 0) { misc[1] = 0u; misc[2] = __hip_atomic_fetch_add(qctr, 1u, __ATOMIC_RELAXED, __HIP_MEMORY_SCOPE_AGENT); }
        unsigned sv[16];
#pragma unroll
        for (int i = 0; i < 16; ++i) { const int pos = 256 * (n + 1) + i * 512 + tid; sv[i] = ((const unsigned*)SEL)[(size_t)(b * 8 + h) * SEQ + (pos < SEQ ? pos : SEQ - 1)]; }
        __syncthreads();
#pragma unroll
        for (int i = 0; i < 16; ++i) { const int base = 256 * (n + 1) + i * 512;
            if (base < SEQ) { const int pos = base + tid; int slot = -1;
                if (pos < SEQ) slot = ((sv[i] & 0xff) == (unsigned)n) ? 0 : (((sv[i] >> 8) & 0xff) == (unsigned)n) ? 1 : (((sv[i] >> 16) & 0xff) == (unsigned)n) ? 2 : -1;
                const unsigned long long bal = __ballot(slot >= 0);
                const int tot = __popcll(bal), pre = __popcll(bal & ((1ull << lane) - 1ull));
                unsigned off = 0; if (lane == 0 && tot) off = __hip_atomic_fetch_add(misc + 1, (unsigned)tot, __ATOMIC_RELAXED, __HIP_MEMORY_SCOPE_WORKGROUP);
                off = __builtin_amdgcn_readfirstlane(off);
                if (slot >= 0) list[off + pre] = (unsigned short)((pos << 2) | slot); } }
        __syncthreads();
        const int unext = (int)misc[2];
        if (unext < NU) moba_kv_load(R, K, V, (size_t)((unext & 63) >> 3) * SEQ + (size_t)(unext >> 6) * 256, unext & 7, tid);
        const int cnt = (int)misc[1], nbatch = (cnt + 31) >> 5;
        unsigned en = 0; bf16x8 qn[4];
        if (wid < nbatch) { const int li0 = wid * 32 + r32; en = list[li0 < cnt ? li0 : cnt - 1];
#pragma unroll
            for (int d0 = 0; d0 < 4; ++d0) qn[d0] = *(const bf16x8*)(Q + ((size_t)b * SEQ + (en >> 2)) * 512 + h * 64 + d0 * 16 + hi * 8); }
        for (int bt = wid; bt < nbatch; bt += 8) {
            const int li = bt * 32 + r32; const bool valid = li < cnt; const unsigned e = en;
            const int pos = e >> 2, slot = e & 3; const size_t t = (size_t)b * SEQ + pos;
            bf16x8 qr[4];
#pragma unroll
            for (int d0 = 0; d0 < 4; ++d0) qr[d0] = qn[d0];
            { const int btn = (bt + 8 < nbatch) ? bt + 8 : bt; const int lin = btn * 32 + r32; en = list[lin < cnt ? lin : cnt - 1];
#pragma unroll
              for (int d0 = 0; d0 < 4; ++d0) qn[d0] = *(const bf16x8*)(Q + ((size_t)b * SEQ + (en >> 2)) * 512 + h * 64 + d0 * 16 + hi * 8); }
            float m_reg = 0.f, l_reg = 0.f; f32x16 o[2] = {}; f32x16 negm = {};
#pragma unroll
            for (int kt = 0; kt < 4; ++kt) {
                f32x16 p0, p1; float alpha; bf16x8 pa0, pa1, pa2, pa3;
                qkt64(p0, p1, lds + MB_K + kt * 8192, qr, negm, r32, hi);
                softmax_tile<false>(p0, p1, m_reg, l_reg, alpha, negm, kt == 0, pa0, pa1, pa2, pa3);
                rescale_o2(o, alpha, wsf, r32, hi);
                pv64_one<0>(o[0], vb0 + kt * 8192, pa0, pa1, pa2, pa3); pv64_one<1>(o[1], vb0 + kt * 8192, pa0, pa1, pa2, pa3);
            }
            const int dst = valid ? (int)((t * 8 + h) * 3 + slot) : -1;
            if (hi == 0) { wsf[32 + r32] = l_reg; wsd[r32] = dst; if (valid) *(float2*)(ML + (size_t)dst * 2) = make_float2(m_reg, l_reg); }
            asm volatile("s_waitcnt lgkmcnt(0)" ::: "memory");
            LAS bf16_t* stg = (LAS bf16_t*)(lds + MB_STG + wid * 4096);
#pragma unroll
            for (int r = 0; r < 16; ++r) { const int orow = crow(r, hi); const float rl = __builtin_amdgcn_rcpf(wsf[32 + orow]);
                stg[orow * 64 + r32] = f2bf(o[0][r] * rl); stg[orow * 64 + 32 + r32] = f2bf(o[1][r] * rl); }
            asm volatile("s_waitcnt lgkmcnt(0)" ::: "memory");
#pragma unroll
            for (int i = 0; i < 4; ++i) { const int row = i * 8 + (lane >> 3), pcs = lane & 7; const u32x4 v = *(const LAS u32x4*)(stg + row * 64 + pcs * 8); const int dd = wsd[row];
                if (dd >= 0) *(u32x4*)(PART + (size_t)dd * 64 + pcs * 8) = v; }
            asm volatile("s_waitcnt lgkmcnt(0)" ::: "memory");
        }
        u = unext;
    }
}
__device__ __forceinline__ void moba_own_phase(LAS unsigned char* lds, const bf16_t* Q, const bf16_t* K, const bf16_t* V, const signed char* SEL, const bf16_t* PART, const float* ML, bf16_t* ATT) {
    const int tid = threadIdx.x, wid = tid >> 6, lane = tid & 63, r32 = lane & 31, hi = lane >> 5;
    LAS float* wsf = (LAS float*)(lds + MB_WS + wid * 1024);
    const int vb0 = (int)(uintptr_t)(lds + MB_V) + ((lane >> 4) & 1) * 32 + (lane & 3) * 8 + (4 * hi + ((lane & 15) >> 2)) * 64;
    KVRegs R;
    if ((int)blockIdx.x < 64 * 32) moba_kv_load(R, K, V, (size_t)((blockIdx.x & 63) >> 3) * SEQ + (size_t)(blockIdx.x >> 6) * 256, blockIdx.x & 7, tid);
    for (int u = blockIdx.x; u < 64 * 32; u += gridDim.x) {
        const int bh = u & 63, n = u >> 6, b = bh >> 3, h = bh & 7;
        __syncthreads();
        moba_kv_store(lds, R, tid);
        __syncthreads();
        { const int un = u + gridDim.x; if (un < 64 * 32) moba_kv_load(R, K, V, (size_t)((un & 63) >> 3) * SEQ + (size_t)(un >> 6) * 256, un & 7, tid); }
        const size_t t0 = (size_t)b * SEQ + (size_t)n * 256 + wid * 32, t = t0 + r32;
        bf16x8 qr[4];
#pragma unroll
        for (int d0 = 0; d0 < 4; ++d0) qr[d0] = *(const bf16x8*)(Q + t * 512 + h * 64 + d0 * 16 + hi * 8);
        float m_reg = 0.f, l_reg = 0.f; f32x16 o[2] = {}; f32x16 negm = {};
        const int ntile = (wid >> 1) + 1, rowa = wid * 32 + r32;
#pragma unroll
        for (int kt = 0; kt < 4; ++kt) { if (kt >= ntile) break;
            f32x16 p0, p1; float alpha; bf16x8 pa0, pa1, pa2, pa3;
            qkt64(p0, p1, lds + MB_K + kt * 8192, qr, negm, r32, hi);
            if (kt == ntile - 1) {
#pragma unroll
                for (int r = 0; r < 16; ++r) { const int ka = 64 * kt + crow(r, hi); if (ka > rowa) p0[r] = -1e30f; if (ka + 32 > rowa) p1[r] = -1e30f; } }
            softmax_tile<false>(p0, p1, m_reg, l_reg, alpha, negm, kt == 0, pa0, pa1, pa2, pa3);
            rescale_o2(o, alpha, wsf, r32, hi);
            pv64_one<0>(o[0], vb0 + kt * 8192, pa0, pa1, pa2, pa3); pv64_one<1>(o[1], vb0 + kt * 8192, pa0, pa1, pa2, pa3);
        }
        u32x4 pr[4][3];
#pragma unroll
        for (int i = 0; i < 4; ++i) { const int row = i * 8 + (lane >> 3), pcs = lane & 7;
#pragma unroll
            for (int q = 0; q < 3; ++q) pr[i][q] = *(const u32x4*)(PART + (((t0 + row) * 8 + h) * 3 + q) * 64 + pcs * 8); }
        const unsigned sv = ((const unsigned*)SEL)[(size_t)(b * 8 + h) * SEQ + n * 256 + wid * 32 + r32];
        float2 mlv[3];
#pragma unroll
        for (int i = 0; i < 3; ++i) mlv[i] = *(const float2*)(ML + ((t * 8 + h) * 3 + i) * 2);
        float mi[3], li[3]; float M = m_reg;
#pragma unroll
        for (int i = 0; i < 3; ++i) { const bool v = ((sv >> (8 * i)) & 0x80u) == 0u; mi[i] = v ? mlv[i].x : -1e30f; li[i] = v ? mlv[i].y : 0.f; M = fmaxf(M, mi[i]); }
        const float wo = __builtin_amdgcn_exp2f(m_reg - M); float L = l_reg * wo; float wi[3];
#pragma unroll
        for (int i = 0; i < 3; ++i) { wi[i] = li[i] * __builtin_amdgcn_exp2f(mi[i] - M); L += wi[i]; }
        const float rL = 1.f / L;
        if (hi == 0) { wsf[32 + r32] = wo * rL; wsf[64 + r32] = wi[0] * rL; wsf[96 + r32] = wi[1] * rL; wsf[128 + r32] = wi[2] * rL; }
        asm volatile("s_waitcnt lgkmcnt(0)" ::: "memory");
        LAS bf16_t* stg = (LAS bf16_t*)(lds + MB_STG + wid * 4096);
#pragma unroll
        for (int r = 0; r < 16; ++r) { const int orow = crow(r, hi); const float a0 = wsf[32 + orow];
            stg[orow * 64 + r32] = f2bf(o[0][r] * a0); stg[orow * 64 + 32 + r32] = f2bf(o[1][r] * a0); }
        asm volatile("s_waitcnt lgkmcnt(0)" ::: "memory");
#pragma unroll
        for (int i = 0; i < 4; ++i) { const int row = i * 8 + (lane >> 3), pcs = lane & 7;
            const u32x4 own = *(const LAS u32x4*)(stg + row * 64 + pcs * 8); const float a1 = wsf[64 + row], a2 = wsf[96 + row], a3 = wsf[128 + row];
            float v[8];
#pragma unroll
            for (int q = 0; q < 4; ++q) { v[2 * q] = __uint_as_float(own[q] << 16); v[2 * q + 1] = __uint_as_float(own[q] & 0xffff0000u); }
#pragma unroll
            for (int q = 0; q < 4; ++q) {
                v[2 * q]     += (a1 != 0.f ? a1 * __uint_as_float(pr[i][0][q] << 16) : 0.f) + (a2 != 0.f ? a2 * __uint_as_float(pr[i][1][q] << 16) : 0.f) + (a3 != 0.f ? a3 * __uint_as_float(pr[i][2][q] << 16) : 0.f);
                v[2 * q + 1] += (a1 != 0.f ? a1 * __uint_as_float(pr[i][0][q] & 0xffff0000u) : 0.f) + (a2 != 0.f ? a2 * __uint_as_float(pr[i][1][q] & 0xffff0000u) : 0.f) + (a3 != 0.f ? a3 * __uint_as_float(pr[i][2][q] & 0xffff0000u) : 0.f); }
            *(u32x4*)(ATT + (t0 + row) * 1024 + h * 64 + pcs * 8) = (u32x4){pk2(v[0], v[1]), pk2(v[2], v[3]), pk2(v[4], v[5]), pk2(v[6], v[7])}; }
        asm volatile("s_waitcnt lgkmcnt(0)" ::: "memory");
    }
    __syncthreads();
}
__device__ __forceinline__ void gmlp_phase(LAS unsigned char* lds, const bf16_t* U, const bf16_t* GV, const bf16_t* WM, const float* ng, const float* bs, bf16_t* ATTGM) {
    const int tid = threadIdx.x, wid = tid >> 6, lane = tid & 63, r32 = lane & 31, hi = lane >> 5;
    const int tb = wid & 3, hf = wid >> 2;
    for (int c = blockIdx.x; c < T_TOK / 128; c += gridDim.x) {
        const size_t t0 = (size_t)c * 128;
        __syncthreads();
        {
            uint4 v[16];
#pragma unroll
            for (int i = 0; i < 16; ++i) v[i] = *(const uint4*)(GV + (t0 + wid * 16 + i) * 512 + lane * 8);
#pragma unroll
            for (int i = 0; i < 16; ++i) { const int sidx = wid * 16 + i;
                float f[8]; f[0] = __uint_as_float(v[i].x << 16); f[1] = __uint_as_float(v[i].x & 0xffff0000u); f[2] = __uint_as_float(v[i].y << 16); f[3] = __uint_as_float(v[i].y & 0xffff0000u);
                f[4] = __uint_as_float(v[i].z << 16); f[5] = __uint_as_float(v[i].z & 0xffff0000u); f[6] = __uint_as_float(v[i].w << 16); f[7] = __uint_as_float(v[i].w & 0xffff0000u);
                float ss = 0.f;
#pragma unroll
                for (int e = 0; e < 8; ++e) ss += f[e] * f[e];
                const float rs = rsqrtf(wave_sum(ss) * (1.f / 512.f) + EPS);
                const u32x4 w = {cvtpk(f[0] * rs, f[1] * rs), cvtpk(f[2] * rs, f[3] * rs), cvtpk(f[4] * rs, f[5] * rs), cvtpk(f[6] * rs, f[7] * rs)};
                *(LAS u32x4*)(lds + (lane >> 4) * 32768 + (sidx >> 6) * 16384 + v_st(sidx & 63, (lane & 15) * 8)) = w; }
        }
        __syncthreads();
#pragma unroll 1
        for (int slab = 0; slab < 4; ++slab) {
            const int g = slab * 2 + hf;
            bf16x8 pa[8];
#pragma unroll
            for (int ks = 0; ks < 8; ++ks) pa[ks] = *(const bf16x8*)(WM + ((size_t)(g * 128 + tb * 32 + r32)) * 128 + ks * 16 + hi * 8);
            f32x16 o[2] = {};
            const int vb = (int)(uintptr_t)lds + slab * 32768 + hf * 1024 + v_rd_base(lane);
            const int c0 = slab * 128 + hf * 64 + r32;
            const float ng0 = ng[c0], ng1 = ng[c0 + 32];
            float bbv[16]; bf16_t u0[16], u1[16];
#pragma unroll
            for (int r = 0; r < 16; ++r) { const int tt = tb * 32 + crow(r, hi); bbv[r] = bs[g * 128 + tt]; const bf16_t* up = U + (t0 + tt) * 512 + c0; u0[r] = up[0]; u1[r] = up[32]; }
#define GSTEP(KS) if ((KS) <= 2 * tb + 1) { \
                const s16x4 l0 = tr_read<((KS) >> 2) * 16384 + v_rd_off(0, (KS) & 3, 0)>(vb), h0 = tr_read<((KS) >> 2) * 16384 + v_rd_off(0, (KS) & 3, 1)>(vb); \
                const s16x4 l1 = tr_read<((KS) >> 2) * 16384 + v_rd_off(1, (KS) & 3, 0)>(vb), h1 = tr_read<((KS) >> 2) * 16384 + v_rd_off(1, (KS) & 3, 1)>(vb); \
                asm volatile("s_waitcnt lgkmcnt(0)" ::: "memory"); SBAR(); \
                o[0] = __builtin_amdgcn_mfma_f32_32x32x16_bf16(pa[KS], ((bf16x8){l0[0], l0[1], l0[2], l0[3], h0[0], h0[1], h0[2], h0[3]}), o[0], 0, 0, 0); \
                o[1] = __builtin_amdgcn_mfma_f32_32x32x16_bf16(pa[KS], ((bf16x8){l1[0], l1[1], l1[2], l1[3], h1[0], h1[1], h1[2], h1[3]}), o[1], 0, 0, 0); }
            GSTEP(0) GSTEP(1) GSTEP(2) GSTEP(3) GSTEP(4) GSTEP(5) GSTEP(6) GSTEP(7)
#undef GSTEP
#pragma unroll
            for (int r = 0; r < 16; ++r) { const int tt = tb * 32 + crow(r, hi); const float bb = bbv[r];
                bf16_t* op = ATTGM + (t0 + tt) * 1024 + 512 + c0;
                op[0] = f2bf(bf2f(u0[r]) * (o[0][r] * ng0 + bb)); op[32] = f2bf(bf2f(u1[r]) * (o[1][r] * ng1 + bb)); }
        }
    }
    __syncthreads();
}
constexpr int XA_K = 0, XA_V = 65536, XA_WS = 131072;
__device__ __forceinline__ void xattn_phase(LAS unsigned char* lds, const bf16_t* XQ, const bf16_t* XKV, bf16_t* XO) {
    const int tid = threadIdx.x, wid = tid >> 6, lane = tid & 63, r32 = lane & 31, hi = lane >> 5;
    LAS float* wsf = (LAS float*)(lds + XA_WS) + wid * 64;
    const int vb0 = (int)(uintptr_t)(lds + XA_V) + v_rd_base(lane);
    int staged = -1;
    for (int u = blockIdx.x; u < 32 * 32; u += gridDim.x) {
        const int bh = u & 31, tile = u >> 5, b = bh >> 2, h = bh & 3;
        if (bh != staged) {
            __syncthreads();
            const int sr = tid >> 4, sc = (tid & 15) * 8;
#pragma unroll
            for (int i = 0; i < 8; ++i) { const int key = i * 32 + sr; const bf16_t* src = XKV + (size_t)(b * NMEM + key) * 1024 + h * 128 + sc;
                const uint4 kv = *(const uint4*)src, vv = *(const uint4*)(src + 512);
                *(LAS u32x4*)(lds + XA_K + (key >> 6) * 16384 + KSWZ(key & 63, sc * 2)) = (u32x4){kv.x, kv.y, kv.z, kv.w};
                *(LAS u32x4*)(lds + XA_V + (key >> 6) * 16384 + v_st(key & 63, sc)) = (u32x4){vv.x, vv.y, vv.z, vv.w}; }
            __syncthreads(); staged = bh;
        }
        const size_t t0 = (size_t)b * SEQ + tile * 256 + wid * 32;
        bf16x8 qr[8];
#pragma unroll
        for (int d0 = 0; d0 < 8; ++d0) qr[d0] = *(const bf16x8*)(XQ + (t0 + r32) * 512 + h * 128 + d0 * 16 + hi * 8);
        float m_reg = 0.f, l_reg = 0.f; f32x16 o[4] = {}; f32x16 negm = {};
#pragma unroll
        for (int kt = 0; kt < 4; ++kt) {
            f32x16 p0, p1; float alpha; bf16x8 pa0, pa1, pa2, pa3;
            qkt128(p0, p1, lds + XA_K + kt * 16384, qr, negm, r32, hi);
            softmax_tile<true>(p0, p1, m_reg, l_reg, alpha, negm, kt == 0, pa0, pa1, pa2, pa3);
            if (__any(alpha < 1.f)) { if (hi == 0) wsf[r32] = alpha; asm volatile("s_waitcnt lgkmcnt(0)" ::: "memory");
#pragma unroll
                for (int r = 0; r < 16; ++r) { const float al = wsf[crow(r, hi)];
#pragma unroll
                    for (int d = 0; d < 4; ++d) o[d][r] *= al; }
                asm volatile("s_waitcnt lgkmcnt(0)" ::: "memory"); }
            const int vb = vb0 + kt * 16384;
            pv_one<0>(o[0], vb, pa0, pa1, pa2, pa3); pv_one<1>(o[1], vb, pa0, pa1, pa2, pa3); pv_one<2>(o[2], vb, pa0, pa1, pa2, pa3); pv_one<3>(o[3], vb, pa0, pa1, pa2, pa3);
        }
        if (hi == 0) wsf[32 + r32] = l_reg; asm volatile("s_waitcnt lgkmcnt(0)" ::: "memory");
#pragma unroll
        for (int r = 0; r < 16; ++r) { const int orow = crow(r, hi); const float rl = __builtin_amdgcn_rcpf(wsf[32 + orow]);
            bf16_t* op = XO + (t0 + orow) * 512 + h * 128 + r32;
#pragma unroll
            for (int d0 = 0; d0 < 4; ++d0) op[d0 * 32] = f2bf(o[d0][r] * rl); }
        asm volatile("s_waitcnt lgkmcnt(0)" ::: "memory");
    }
    __syncthreads();
}
}

namespace peer {
typedef unsigned u32x4 __attribute__((ext_vector_type(4)));
typedef short bf16x8 __attribute__((ext_vector_type(8)));
typedef float f32x16 __attribute__((ext_vector_type(16)));
typedef float f32x4 __attribute__((ext_vector_type(4)));
typedef __bf16 bf16x2 __attribute__((ext_vector_type(2)));
#define KSWZ(row, colB) ((row) * 256 + ((colB) ^ (((row) & 7) << 4)))
__device__ __forceinline__ int crow(int r, int hi) { return (r & 3) + 8 * (r >> 2) + 4 * hi; }
__device__ __forceinline__ unsigned ord_key(float f) { const unsigned b = __float_as_uint(f); return b ^ ((unsigned)((int)b >> 31) | 0x80000000u); }
__device__ __forceinline__ float ord_inv(unsigned o) { return __uint_as_float(o ^ ((unsigned)((int)(~o) >> 31) | 0x80000000u)); }
__device__ __forceinline__ unsigned selu(unsigned m, unsigned a, unsigned b) { return (a & m) | (b & ~m); }
__device__ __forceinline__ unsigned umax_(unsigned a, unsigned b) { return (int)a > (int)b ? a : b; }
__device__ __forceinline__ unsigned umin_(unsigned a, unsigned b) { return (int)a < (int)b ? a : b; }
template <int OFF, int A, int B> __device__ __forceinline__ void ce_desc(unsigned (&k)[64]) { const unsigned a = k[OFF + A], b = k[OFF + B]; k[OFF + A] = umax_(a, b); k[OFF + B] = umin_(a, b); }
template <int OFF> __device__ __forceinline__ void sort16_desc(unsigned (&k)[64]) {
#define CE(a, b) ce_desc<OFF, a, b>(k);
    CE(0,13) CE(1,12) CE(2,15) CE(3,14) CE(4,8) CE(5,6) CE(7,11) CE(9,10)
    CE(0,5) CE(1,7) CE(2,9) CE(3,4) CE(6,13) CE(8,14) CE(10,15) CE(11,12)
    CE(0,1) CE(2,3) CE(4,5) CE(6,8) CE(7,9) CE(10,11) CE(12,13) CE(14,15)
    CE(0,2) CE(1,3) CE(4,10) CE(5,11) CE(6,7) CE(8,9) CE(12,14) CE(13,15)
    CE(1,2) CE(3,12) CE(4,6) CE(5,7) CE(8,10) CE(9,11) CE(13,14)
    CE(1,4) CE(2,6) CE(5,8) CE(7,10) CE(9,13) CE(11,14)
    CE(2,4) CE(3,6) CE(9,12) CE(11,13)
    CE(3,5) CE(6,8) CE(7,9) CE(10,12)
    CE(3,4) CE(5,6) CE(7,8) CE(9,10) CE(11,12)
    CE(6,7) CE(8,9)
#undef CE
}
template <int OFF> __device__ __forceinline__ void merge16_desc(unsigned (&k)[64]) {
#pragma unroll
    for (int stride = 8; stride > 0; stride >>= 1)
#pragma unroll
        for (int i = 0; i < 16; ++i) { const int j = i ^ stride; if (j > i) { const unsigned a = k[OFF + i], b = k[OFF + j]; k[OFF + i] = umax_(a, b); k[OFF + j] = umin_(a, b); } }
}
template <int A, int B> __device__ __forceinline__ void top16_merge(unsigned (&k)[64]) {
#pragma unroll
    for (int i = 0; i < 16; ++i) k[A + i] = umax_(k[A + i], k[B + 15 - i]);
    merge16_desc<A>(k);
}
__device__ __forceinline__ void top16_of_64(unsigned (&k)[64]) {
    sort16_desc<0>(k); sort16_desc<16>(k); sort16_desc<32>(k); sort16_desc<48>(k);
    top16_merge<0, 16>(k); top16_merge<32, 48>(k); top16_merge<0, 32>(k);
}
__device__ __forceinline__ void top16_of_cand(unsigned (&k)[64]) {
    sort16_desc<0>(k); sort16_desc<16>(k); sort16_desc<32>(k); ce_desc<48, 0, 1>(k);
    top16_merge<0, 16>(k);
    k[46] = umax_(k[46], k[49]); k[47] = umax_(k[47], k[48]); merge16_desc<32>(k);
#pragma unroll
    for (int i = 0; i < 16; ++i) k[i] = umax_(k[i], k[32 + 15 - i]);
}
__device__ __forceinline__ void partner_merge(unsigned (&k)[64], int hi) {
    unsigned pr[16];
#pragma unroll
    for (int i = 0; i < 16; ++i) { const unsigned t = k[15 - i]; auto rr = __builtin_amdgcn_permlane32_swap(t, t, false, false); pr[i] = selu(0u - (unsigned)hi, rr[0], rr[1]); }
#pragma unroll
    for (int i = 0; i < 16; ++i) k[i] = umax_(k[i], pr[i]);
    merge16_desc<0>(k);
}
constexpr int cand_slot(int i, int j) { int n = 0; for (int a = 0; a < 16; ++a) for (int b = 0; b < 16; ++b) { if (a == i && b == j) return n; if ((a + 1) * (b + 1) <= 16) ++n; } return n; }
static_assert(cand_slot(15, 0) == 49, "50 candidates");
constexpr float TK_BIAS = 48.f;
__device__ __forceinline__ unsigned pos_key(float biased) { return __float_as_uint(biased); }
constexpr int TK_LDS_SK = 0, TK_LDS_IDX = 65536, TK_LDS_BYTES = 65536 + 8 * 32 * 32;
__device__ __forceinline__ void sk_tile(f32x16& p0, f32x16& p1, const LAS unsigned char* Ks, const bf16x8* qr, int r32, int hi) {
    p0 = f32x16{}; p1 = f32x16{};
#pragma unroll
    for (int d0 = 0; d0 < 8; ++d0) { const int cb = (d0 * 16 + hi * 8) * 2;
        const bf16x8 b0 = *(const LAS bf16x8*)(Ks + KSWZ(r32, cb)); const bf16x8 b1 = *(const LAS bf16x8*)(Ks + KSWZ(32 + r32, cb));
        p0 = __builtin_amdgcn_mfma_f32_32x32x16_bf16(b0, qr[d0], p0, 0, 0, 0); p1 = __builtin_amdgcn_mfma_f32_32x32x16_bf16(b1, qr[d0], p1, 0, 0, 0); }
}
__device__ __forceinline__ void topk_loadq(bf16x8 (&qa)[8], bf16x8 (&qb)[8], const bf16_t* QP, int t, int h, int hi) {
#pragma unroll
    for (int d0 = 0; d0 < 8; ++d0) { qa[d0] = *(const bf16x8*)(QP + (size_t)t * 2048 + h * 256 + d0 * 16 + hi * 8); qb[d0] = *(const bf16x8*)(QP + (size_t)t * 2048 + h * 256 + 128 + d0 * 16 + hi * 8); }
}
__device__ __forceinline__ void topk_half(unsigned (&top)[16], const LAS unsigned char* lds, const bf16x8 (&qr)[8], int p, int r32, int hi) {
    unsigned k[64];
#pragma unroll
    for (int tl = 0; tl < 2; ++tl) { f32x16 p0, p1; sk_tile(p0, p1, lds + TK_LDS_SK + (p * 2 + tl) * 16384, qr, r32, hi); p0 = p0 + TK_BIAS; p1 = p1 + TK_BIAS;
#pragma unroll
        for (int r = 0; r < 16; ++r) { k[tl * 32 + r] = (pos_key(p0[r]) & ~0x7Fu) | (unsigned)(tl * 64 + crow(r, hi)); k[tl * 32 + 16 + r] = (pos_key(p1[r]) & ~0x7Fu) | (unsigned)(tl * 64 + 32 + crow(r, hi)); } }
    top16_of_64(k); partner_merge(k, hi);
#pragma unroll
    for (int i = 0; i < 16; ++i) top[i] = k[i];
}
__device__ __forceinline__ void topk_phase(LAS unsigned char* lds, const bf16_t* QP, const bf16_t* SK, unsigned short* PID, float* PW) {
    const int tid = threadIdx.x, lane = tid & 63, wid = tid >> 6, r32 = lane & 31, hi = lane >> 5;
    LAS unsigned char* idxl = lds + TK_LDS_IDX + wid * 1024 + r32 * 32;
    int staged_h = -1;
    bf16x8 qa[8], qb[8];
    if ((int)blockIdx.x < 8 * 256) topk_loadq(qa, qb, QP, (int)(blockIdx.x >> 3) * 256 + wid * 32 + r32, blockIdx.x & 7, hi);
    for (int u = blockIdx.x; u < 8 * 256; u += gridDim.x) {
        const int h = u & 7, tile = u >> 3;
        if (h != staged_h) {
            __syncthreads();
            for (int pc = tid; pc < 4096; pc += 512) { const int row = pc >> 4, ch = pc & 15;
                const uint4 v = *(const uint4*)(SK + ((size_t)h * 256 + row) * 128 + ch * 8);
                *(LAS u32x4*)(lds + TK_LDS_SK + (row >> 6) * 16384 + KSWZ(row & 63, ch * 16)) = (u32x4){v.x, v.y, v.z, v.w}; }
            __syncthreads(); staged_h = h;
        }
        const int t = tile * 256 + wid * 32 + r32;
        const unsigned hm = 0u - (unsigned)hi;
        unsigned top0[16], top1[16];
        topk_half(top0, lds, qa, 0, r32, hi);
        topk_half(top1, lds, qb, 1, r32, hi);
        { const int un = (u + (int)gridDim.x < 8 * 256) ? u + (int)gridDim.x : u; topk_loadq(qa, qb, QP, (un >> 3) * 256 + wid * 32 + r32, un & 7, hi); }
        { unsigned w[4];
#pragma unroll
          for (int q = 0; q < 4; ++q) { const unsigned a0 = selu(hm, top1[4 * q], top0[4 * q]), a1 = selu(hm, top1[4 * q + 1], top0[4 * q + 1]), a2 = selu(hm, top1[4 * q + 2], top0[4 * q + 2]), a3 = selu(hm, top1[4 * q + 3], top0[4 * q + 3]);
              w[q] = (a0 & 0x7Fu) | ((a1 & 0x7Fu) << 8) | ((a2 & 0x7Fu) << 16) | ((a3 & 0x7Fu) << 24); }
          *(LAS u32x4*)(idxl + hi * 16) = (u32x4){w[0], w[1], w[2], w[3]}; }
        float f1[16], f2[16];
#pragma unroll
        for (int i = 0; i < 16; ++i) { f1[i] = __uint_as_float(top0[i] & ~0x7Fu); f2[i] = __uint_as_float(top1[i] & ~0x7Fu) - TK_BIAS; }
        unsigned k[64];
#pragma unroll
        for (int i = 0; i < 16; ++i)
#pragma unroll
            for (int j = 0; j < 16; ++j) if ((i + 1) * (j + 1) <= 16) k[cand_slot(i, j)] = (pos_key(f1[i] + f2[j]) & ~0xFFu) | (unsigned)(i * 16 + j);
        top16_of_cand(k);
        float sv[16], den = 0.f; const float s0 = __uint_as_float(k[0] & ~0xFFu);
#pragma unroll
        for (int i = 0; i < 16; ++i) { sv[i] = __expf(__uint_as_float(k[i] & ~0xFFu) - s0); den += sv[i]; }
        const float rden = 1.f / den;
        asm volatile("s_waitcnt lgkmcnt(0)" ::: "memory");
        int ids[8]; float ws_[8];
#pragma unroll
        for (int i = 0; i < 8; ++i) { const unsigned kk = selu(hm, k[8 + i], k[i]); const int ci = (kk >> 4) & 15, cj = kk & 15;
            const int i1 = *(const LAS unsigned char*)(idxl + ci), i2 = *(const LAS unsigned char*)(idxl + 16 + cj);
            ids[i] = i1 * 128 + i2; ws_[i] = __uint_as_float(selu(hm, __float_as_uint(sv[8 + i]), __float_as_uint(sv[i]))) * rden; }
        unsigned short* po = PID + ((size_t)t * 8 + h) * 16 + hi * 8; float* pw = PW + ((size_t)t * 8 + h) * 16 + hi * 8;
        *(uint4*)po = make_uint4((unsigned)ids[0] | ((unsigned)ids[1] << 16), (unsigned)ids[2] | ((unsigned)ids[3] << 16), (unsigned)ids[4] | ((unsigned)ids[5] << 16), (unsigned)ids[6] | ((unsigned)ids[7] << 16));
        *(float4*)pw = make_float4(ws_[0], ws_[1], ws_[2], ws_[3]); *(float4*)(pw + 4) = make_float4(ws_[4], ws_[5], ws_[6], ws_[7]);
        asm volatile("s_waitcnt lgkmcnt(0)" ::: "memory");
    }
    __syncthreads();
}

typedef float f32x2 __attribute__((ext_vector_type(2)));
template <int CTRL> __device__ __forceinline__ float dpp_f(float v) { return __builtin_bit_cast(float, __builtin_amdgcn_update_dpp(0, __builtin_bit_cast(int, v), CTRL, 0xf, 0xf, true)); }
__device__ __forceinline__ unsigned xcc_id() { return (unsigned)__builtin_amdgcn_s_getreg((3 << 11) | 20) & 7u; }
__device__ __forceinline__ float swapadd32(float a, float b) { auto rr = __builtin_amdgcn_permlane32_swap(__float_as_uint(a), __float_as_uint(b), false, false); return __uint_as_float(rr[0]) + __uint_as_float(rr[1]); }
__device__ __forceinline__ float swapadd16(float a, float b) { auto rr = __builtin_amdgcn_permlane16_swap(__float_as_uint(a), __float_as_uint(b), false, false); return __uint_as_float(rr[0]) + __uint_as_float(rr[1]); }
__device__ __forceinline__ void fp8x16_to_f32(const uint4 r, float (&f)[16]) {
    const unsigned w[4] = {r.x, r.y, r.z, r.w};
#pragma unroll
    for (int q = 0; q < 4; ++q) { const f32x2 lo = __builtin_amdgcn_cvt_pk_f32_fp8((int)w[q], false), hi = __builtin_amdgcn_cvt_pk_f32_fp8((int)w[q], true); f[4 * q] = lo.x; f[4 * q + 1] = lo.y; f[4 * q + 2] = hi.x; f[4 * q + 3] = hi.y; }
}
constexpr int PEER_ITEM_TOK = 64, PEER_NITEM = T_TOK / PEER_ITEM_TOK;
struct DnIn { unsigned idp; uint4 xa, xb; };
__device__ __forceinline__ void dn_s1(DnIn& I, const unsigned short* PID, const bf16_t* XB, size_t t, int slice, int lane, int l8) {
    I.idp = ((const unsigned*)PID)[t * 64 + lane];
    I.xa = *(const uint4*)(XB + t * 1024 + slice * 128 + l8 * 16); I.xb = *(const uint4*)(XB + t * 1024 + slice * 128 + l8 * 16 + 8);
}
template <int CTRL> __device__ __forceinline__ int dpp_i(int v) { return __builtin_amdgcn_update_dpp(0, v, CTRL, 0xf, 0xf, true); }
__device__ __forceinline__ void dn_quantx(unsigned (&xq)[4], float& sx, const DnIn& I) {
    const unsigned xw[8] = {I.xa.x, I.xa.y, I.xa.z, I.xa.w, I.xb.x, I.xb.y, I.xb.z, I.xb.w};
    float xf[16]; float am = 0.f;
#pragma unroll
    for (int q = 0; q < 8; ++q) { xf[2 * q] = __uint_as_float(xw[q] << 16); xf[2 * q + 1] = __uint_as_float(xw[q] & 0xffff0000u); am = fmaxf(am, fmaxf(fabsf(xf[2 * q]), fabsf(xf[2 * q + 1]))); }
    am = fmaxf(am, dpp_f<0xB1>(am)); am = fmaxf(am, dpp_f<0x4E>(am)); am = fmaxf(am, dpp_f<0x141>(am));
    const float inv = am > 0.f ? 127.f / am : 0.f; sx = am * (1.f / 127.f);
#pragma unroll
    for (int q = 0; q < 4; ++q) xq[q] = ((unsigned)__float2int_rn(xf[4 * q] * inv) & 0xffu) | (((unsigned)__float2int_rn(xf[4 * q + 1] * inv) & 0xffu) << 8) | (((unsigned)__float2int_rn(xf[4 * q + 2] * inv) & 0xffu) << 16) | ((unsigned)__float2int_rn(xf[4 * q + 3] * inv) << 24);
}
__device__ __forceinline__ void pe_s2(uint4 (&W)[16], unsigned idp, const unsigned char* wslice, unsigned loff, int g8) {
#pragma unroll
    for (int i = 0; i < 8; ++i) { const unsigned p0 = (unsigned)__shfl((int)idp, 4 * g8 + (i >> 1)), p1 = (unsigned)__shfl((int)idp, 32 + 4 * g8 + (i >> 1));
        const unsigned e0 = (i & 1) ? (p0 >> 16) : (p0 & 0xffffu), e1 = (i & 1) ? (p1 >> 16) : (p1 & 0xffffu);
        W[i] = *(const uint4*)(wslice + ((e0 << 7) + loff)); W[8 + i] = *(const uint4*)(wslice + ((e1 << 7) + loff)); }
}
__device__ __forceinline__ int reduce8x8(const int (&v)[8], bool b2, bool b1, bool b0) {
    int n[4], m[2];
#pragma unroll
    for (int j = 0; j < 4; ++j) n[j] = (b2 ? v[4 + j] : v[j]) + dpp_i<0x141>(b2 ? v[j] : v[4 + j]);
#pragma unroll
    for (int j = 0; j < 2; ++j) m[j] = (b1 ? n[2 + j] : n[j]) + dpp_i<0x4E>(b1 ? n[j] : n[2 + j]);
    return (b0 ? m[1] : m[0]) + dpp_i<0xB1>(b0 ? m[0] : m[1]);
}
__device__ __forceinline__ void dn_s3(const uint4 (&W)[16], const unsigned (&xq)[4], float sx, bf16_t* po, int lane, int l8) {
    const bool b2 = (l8 >> 2) & 1, b1 = (l8 >> 1) & 1, b0 = l8 & 1;
    int d[16];
#pragma unroll
    for (int i = 0; i < 16; ++i) { int a = __builtin_amdgcn_sdot4((int)W[i].x, (int)xq[0], 0, false); a = __builtin_amdgcn_sdot4((int)W[i].y, (int)xq[1], a, false);
        a = __builtin_amdgcn_sdot4((int)W[i].z, (int)xq[2], a, false); d[i] = __builtin_amdgcn_sdot4((int)W[i].w, (int)xq[3], a, false); }
    const int lo[8] = {d[0], d[1], d[2], d[3], d[4], d[5], d[6], d[7]}, hi[8] = {d[8], d[9], d[10], d[11], d[12], d[13], d[14], d[15]};
    const float r0 = (float)reduce8x8(lo, b2, b1, b0) * sx, r1 = (float)reduce8x8(hi, b2, b1, b0) * sx;
    const float n0 = dpp_f<0xB1>(r0), n1 = dpp_f<0xB1>(r1);
    if (!(lane & 1)) { ((unsigned*)po)[lane >> 1] = pk2(r0, n0); ((unsigned*)po)[32 + (lane >> 1)] = pk2(r1, n1); }
}
__device__ __forceinline__ void down_phase(const bf16_t* XB, const unsigned char* WDq, const unsigned short* PID, bf16_t* PARTD, unsigned* qctr) {
    const int lane = threadIdx.x & 63, g8 = lane >> 3, l8 = lane & 7;
    const unsigned xcc = xcc_id();
    for (int st = 0; st < 8; ++st) { const int slice = (int)((xcc + st) & 7u);
        const unsigned char* wslice = WDq + (size_t)slice * (16384 * 128); const unsigned loff = (unsigned)l8 * 16u;
        for (;;) { unsigned it_ = 0; if (lane == 0) it_ = __hip_atomic_fetch_add(qctr + slice * 64, 1u, __ATOMIC_RELAXED, __HIP_MEMORY_SCOPE_AGENT);
            const int item = (int)__builtin_amdgcn_readfirstlane(it_); if (item >= PEER_NITEM) break;
            const size_t t0 = (size_t)item * PEER_ITEM_TOK; bf16_t* pbase = PARTD + ((size_t)slice * T_TOK + t0) * 128;
            DnIn IA, IB; uint4 WA[16], WB[16]; unsigned xq[4]; float sx;
            dn_s1(IA, PID, XB, t0, slice, lane, l8); dn_s1(IB, PID, XB, t0 + 1, slice, lane, l8);
            pe_s2(WA, IA.idp, wslice, loff, g8);
#pragma unroll 1
            for (int k = 0; k < PEER_ITEM_TOK; k += 2) {
                const int k2 = (k + 2 < PEER_ITEM_TOK) ? k + 2 : PEER_ITEM_TOK - 1, k3 = (k + 3 < PEER_ITEM_TOK) ? k + 3 : PEER_ITEM_TOK - 1;
                dn_quantx(xq, sx, IA); dn_s1(IA, PID, XB, t0 + k2, slice, lane, l8); pe_s2(WB, IB.idp, wslice, loff, g8);
                dn_s3(WA, xq, sx, pbase + (size_t)k * 128, lane, l8);
                dn_quantx(xq, sx, IB); dn_s1(IB, PID, XB, t0 + k3, slice, lane, l8); pe_s2(WA, IA.idp, wslice, loff, g8);
                dn_s3(WB, xq, sx, pbase + (size_t)(k + 1) * 128, lane, l8);
            }
        }
    }
}
template <int B>
__device__ __forceinline__ void coef_batch(const bf16_t* __restrict__ PARTD, const float* __restrict__ SS, const LAS float* SD, const LAS float* SU, const unsigned short* __restrict__ PID, const float* __restrict__ PW, bf16_t* __restrict__ COEF,
                                           size_t tq0, size_t tstride, int sub, int j8) {
    u32x4 pv[B][8], e[B]; f32x4 sq[B], pw[B][2];
#pragma unroll
    for (int u = 0; u < B; ++u) { const size_t t = (tq0 + u * tstride) * 4 + sub;
        e[u] = *(const u32x4*)(PID + t * 128 + j8); pw[u][0] = *(const f32x4*)(PW + t * 128 + j8); pw[u][1] = *(const f32x4*)(PW + t * 128 + j8 + 4);
        sq[u] = *(const f32x4*)(SS + t * 16 + (j8 & 24) / 2);
#pragma unroll
        for (int x = 0; x < 8; ++x) pv[u][x] = *(const u32x4*)(PARTD + ((size_t)x * T_TOK + t) * 128 + j8); }
    float sd[B][8], su[B][8];
#pragma unroll
    for (int u = 0; u < B; ++u)
#pragma unroll
        for (int q = 0; q < 4; ++q) { const unsigned ea = e[u][q] & 0xffffu, eb = e[u][q] >> 16; sd[u][2 * q] = SD[ea]; sd[u][2 * q + 1] = SD[eb]; su[u][2 * q] = SU[ea]; su[u][2 * q + 1] = SU[eb]; }
#pragma unroll
    for (int u = 0; u < B; ++u) { const size_t t = (tq0 + u * tstride) * 4 + sub;
        float d[8];
#pragma unroll
        for (int q = 0; q < 8; ++q) d[q] = 0.f;
#pragma unroll
        for (int x = 0; x < 8; ++x)
#pragma unroll
            for (int q = 0; q < 4; ++q) { d[2 * q] += __uint_as_float(pv[u][x][q] << 16); d[2 * q + 1] += __uint_as_float(pv[u][x][q] & 0xffff0000u); }
        float ssum = (sq[u][0] + sq[u][1]) + (sq[u][2] + sq[u][3]); ssum += dpp_f<0xB1>(ssum); ssum += dpp_f<0x4E>(ssum);
        const float rstd = rsqrtf(ssum * (1.f / DM) + EPS);
        float o[8];
#pragma unroll
        for (int q = 0; q < 8; ++q) o[q] = pw[u][q >> 2][q & 3] * su[u][q] * gelu_tanh(d[q] * rstd * sd[u][q]);
        *(u32x4*)(COEF + t * 128 + j8) = (u32x4){pk2(o[0], o[1]), pk2(o[2], o[3]), pk2(o[4], o[5]), pk2(o[6], o[7])}; }
}
__device__ __forceinline__ void coef_phase(LAS unsigned char* lds, const bf16_t* __restrict__ PARTD, const float* __restrict__ SS, const float* __restrict__ SDg, const float* __restrict__ SUg, const unsigned short* __restrict__ PID, const float* __restrict__ PW, bf16_t* __restrict__ COEF) {
    const int lane = threadIdx.x & 63, wid = threadIdx.x >> 6, sub = lane >> 4, j8 = (lane & 15) * 8;
    LAS float* SD = (LAS float*)lds; LAS float* SU = SD + 16384;
    __syncthreads();
    for (int i = threadIdx.x; i < 16384 / 4; i += 512) { ((LAS f32x4*)SD)[i] = ((const f32x4*)SDg)[i]; ((LAS f32x4*)SU)[i] = ((const f32x4*)SUg)[i]; }
    __syncthreads();
    const size_t gw = blockIdx.x * 8 + wid, NGW = gridDim.x * 8;
    size_t tq = gw;
    for (; tq + 1 * NGW < T_TOK / 4; tq += 2 * NGW) coef_batch<2>(PARTD, SS, SD, SU, PID, PW, COEF, tq, NGW, sub, j8);
    for (; tq < T_TOK / 4; tq += NGW) coef_batch<1>(PARTD, SS, SD, SU, PID, PW, COEF, tq, NGW, sub, j8);
}
struct UpIn { unsigned idp, cfp, x2; };
__device__ __forceinline__ void up_s1(UpIn& I, const unsigned short* PID, const bf16_t* COEF, const bf16_t* xin, size_t t, int slice, int lane, int c0) {
    I.idp = ((const unsigned*)PID)[t * 64 + lane]; I.cfp = ((const unsigned*)COEF)[t * 64 + lane];
    I.x2 = *(const unsigned*)(xin + t * 1024 + slice * 128 + c0);
}
__device__ __forceinline__ void up_s3(const uint4 (&W)[16], unsigned cfp, unsigned x2, bf16_t* orow, float* ss3, int lane, int g8) {
    f32x2 ac2[8];
#pragma unroll
    for (int q = 0; q < 8; ++q) ac2[q] = (f32x2){0.f, 0.f};
#pragma unroll
    for (int i = 0; i < 16; ++i) { const unsigned cp = (unsigned)__shfl((int)cfp, (i < 8 ? 0 : 32) + 4 * g8 + ((i & 7) >> 1)); const float c = (i & 1) ? __uint_as_float(cp & 0xffff0000u) : __uint_as_float(cp << 16); const f32x2 c2 = {c, c}; const unsigned w[4] = {W[i].x, W[i].y, W[i].z, W[i].w};
#pragma unroll
        for (int q = 0; q < 4; ++q) { ac2[2 * q] = __builtin_elementwise_fma(__builtin_amdgcn_cvt_pk_f32_fp8((int)w[q], false), c2, ac2[2 * q]); ac2[2 * q + 1] = __builtin_elementwise_fma(__builtin_amdgcn_cvt_pk_f32_fp8((int)w[q], true), c2, ac2[2 * q + 1]); } }
    float acc[16];
#pragma unroll
    for (int q = 0; q < 8; ++q) { acc[2 * q] = ac2[q].x; acc[2 * q + 1] = ac2[q].y; }
    float a8[8], a4[4];
#pragma unroll
    for (int q = 0; q < 8; ++q) a8[q] = swapadd32(acc[q], acc[q + 8]);
#pragma unroll
    for (int q = 0; q < 4; ++q) a4[q] = swapadd16(a8[q], a8[q + 4]);
    const bool b3 = (lane >> 3) & 1;
    const float y0 = (b3 ? a4[2] : a4[0]) + dpp_f<0x128>(b3 ? a4[0] : a4[2]);
    const float y1 = (b3 ? a4[3] : a4[1]) + dpp_f<0x128>(b3 ? a4[1] : a4[3]);
    const float o0 = __uint_as_float(x2 << 16) + y0, o1 = __uint_as_float(x2 & 0xffff0000u) + y1;
    *(unsigned*)orow = pk2(o0, o1);
    const float ss = wave_sum(o0 * o0 + o1 * o1);
    if (lane == 0) *ss3 = ss;
}
__device__ __forceinline__ void up_phase(const unsigned char* WUq, const unsigned short* PID, const bf16_t* COEF, const bf16_t* xin, bf16_t* xout, float* SS3, unsigned* qctr) {
    const int lane = threadIdx.x & 63, g8 = lane >> 3, l8 = lane & 7;
    const int c0 = 16 * l8 + 8 * ((lane >> 5) & 1) + 4 * ((lane >> 4) & 1) + 2 * ((lane >> 3) & 1);
    const unsigned xcc = xcc_id();
    for (int st = 0; st < 8; ++st) { const int slice = (int)((xcc + st) & 7u);
        const unsigned char* wslice = WUq + (size_t)slice * (16384 * 128); const unsigned loff = (unsigned)l8 * 16u;
        for (;;) { unsigned it_ = 0; if (lane == 0) it_ = __hip_atomic_fetch_add(qctr + slice * 64, 1u, __ATOMIC_RELAXED, __HIP_MEMORY_SCOPE_AGENT);
            const int item = (int)__builtin_amdgcn_readfirstlane(it_); if (item >= PEER_NITEM) break;
            const size_t t0 = (size_t)item * PEER_ITEM_TOK;
            UpIn IA, IB; uint4 WA[16], WB[16];
            up_s1(IA, PID, COEF, xin, t0, slice, lane, c0); up_s1(IB, PID, COEF, xin, t0 + 1, slice, lane, c0);
            pe_s2(WA, IA.idp, wslice, loff, g8);
#pragma unroll 1
            for (int k = 0; k < PEER_ITEM_TOK; k += 2) {
                const int k2 = (k + 2 < PEER_ITEM_TOK) ? k + 2 : PEER_ITEM_TOK - 1, k3 = (k + 3 < PEER_ITEM_TOK) ? k + 3 : PEER_ITEM_TOK - 1;
                { const unsigned cp_ = IA.cfp; const unsigned xx = IA.x2;
                  up_s1(IA, PID, COEF, xin, t0 + k2, slice, lane, c0); pe_s2(WB, IB.idp, wslice, loff, g8);
                  up_s3(WA, cp_, xx, xout + (t0 + k) * 1024 + slice * 128 + c0, SS3 + (t0 + k) * 8 + slice, lane, g8); }
                { const unsigned cp_ = IB.cfp; const unsigned xx = IB.x2;
                  up_s1(IB, PID, COEF, xin, t0 + k3, slice, lane, c0); pe_s2(WA, IA.idp, wslice, loff, g8);
                  up_s3(WB, cp_, xx, xout + (t0 + k + 1) * 1024 + slice * 128 + c0, SS3 + (t0 + k + 1) * 8 + slice, lane, g8); }
            }
        }
    }
}
template <int B>
__device__ __forceinline__ void final_batch(const bf16_t* __restrict__ xin, const float* __restrict__ SS3, const float* __restrict__ fg, float* __restrict__ out, size_t t0, size_t tstride, int lane) {
    u32x4 v[B][2]; f32x4 sq[B][2];
#pragma unroll
    for (int u = 0; u < B; ++u) { const size_t t = t0 + u * tstride; sq[u][0] = *(const f32x4*)(SS3 + t * 8); sq[u][1] = *(const f32x4*)(SS3 + t * 8 + 4);
        v[u][0] = *(const u32x4*)(xin + t * 1024 + lane * 8); v[u][1] = *(const u32x4*)(xin + t * 1024 + 512 + lane * 8); }
    const f32x4 g00 = *(const f32x4*)(fg + lane * 8), g01 = *(const f32x4*)(fg + lane * 8 + 4), g10 = *(const f32x4*)(fg + 512 + lane * 8), g11 = *(const f32x4*)(fg + 516 + lane * 8);
#pragma unroll
    for (int u = 0; u < B; ++u) { const size_t t = t0 + u * tstride; const f32x4 s4 = sq[u][0] + sq[u][1];
        const float r2 = rsqrtf(((s4[0] + s4[1]) + (s4[2] + s4[3])) * (1.f / DM) + EPS);
#pragma unroll
        for (int q = 0; q < 2; ++q) { const u32x4 w = v[u][q]; const f32x4 ga = q ? g10 : g00, gb = q ? g11 : g01; float* op = out + t * 1024 + q * 512 + lane * 8;
            const f32x4 o0 = {__uint_as_float(w.x << 16) * r2 * ga[0], __uint_as_float(w.x & 0xffff0000u) * r2 * ga[1], __uint_as_float(w.y << 16) * r2 * ga[2], __uint_as_float(w.y & 0xffff0000u) * r2 * ga[3]};
            const f32x4 o1 = {__uint_as_float(w.z << 16) * r2 * gb[0], __uint_as_float(w.z & 0xffff0000u) * r2 * gb[1], __uint_as_float(w.w << 16) * r2 * gb[2], __uint_as_float(w.w & 0xffff0000u) * r2 * gb[3]};
            *(f32x4*)op = o0; *(f32x4*)(op + 4) = o1; } }
}
__device__ __forceinline__ void final_phase(const bf16_t* __restrict__ xin, const float* __restrict__ SS3, const float* __restrict__ fg, float* __restrict__ out) {
    const int lane = threadIdx.x & 63, wid = threadIdx.x >> 6;
    const size_t gw = blockIdx.x * 8 + wid, NGW = gridDim.x * 8;
    size_t t = gw;
    for (; t + 7 * NGW < T_TOK; t += 8 * NGW) final_batch<8>(xin, SS3, fg, out, t, NGW, lane);
    for (; t < T_TOK; t += NGW) final_batch<1>(xin, SS3, fg, out, t, NGW, lane);
}
#undef KSWZ
}


#define XB_TMO      128
#define XB_XCNT(j)  (256  + 64 * (j))
#define XB_XSUB(j)  (1280 + 64 * (j))
#define XB_XGEN(j)  (2304 + 64 * (j))
#define XB_TOP      3328
#define XB_TOPGEN   3392
#define XCD_BAR_WORDS 3456
#define XB_SPIN_CAP (1u << 22)
__device__ __forceinline__ unsigned xb_ld(unsigned* p)              { return __hip_atomic_load(p, __ATOMIC_RELAXED, __HIP_MEMORY_SCOPE_AGENT); }
__device__ __forceinline__ unsigned xb_add(unsigned* p, unsigned v) { return __hip_atomic_fetch_add(p, v, __ATOMIC_RELAXED, __HIP_MEMORY_SCOPE_AGENT); }
__device__ __forceinline__ unsigned xb_xcc_id() { return (unsigned)__builtin_amdgcn_s_getreg((3 << 11) | 20) & 0xFu; }
#define XB_SPIN(cond, bar) do { unsigned _sp = 0; while (cond) { __builtin_amdgcn_s_sleep(1); \
    if ((++_sp & 255u) == 0u) { if (xb_ld(&(bar)[XB_TMO])) break; if (_sp > XB_SPIN_CAP) { atomicAdd(&(bar)[XB_TMO], 1u); break; } } } } while (0)
struct XcdBarrier { unsigned* bar; unsigned x; volatile LAS unsigned* st; };
__device__ __forceinline__ XcdBarrier xcd_barrier_post(unsigned* bar, volatile LAS unsigned* st) {
    XcdBarrier b; b.bar = bar; b.x = xb_xcc_id(); b.st = st;
    if (threadIdx.x == 0) (void)xb_add(&bar[XB_XCNT(b.x)], 1u);
    return b;
}
__device__ __forceinline__ void xcd_barrier_complete(unsigned* bar, unsigned x, unsigned& nloc, unsigned& nx) {
    const unsigned G = gridDim.x * gridDim.y * gridDim.z;
    unsigned sum, cnt, mine, sp = 0u;
    for (;;) {
        sum = 0u; cnt = 0u; mine = 0u;
#pragma unroll
        for (unsigned j = 0; j < 16; ++j) { const unsigned c = xb_ld(&bar[XB_XCNT(j)]); sum += c; cnt += (c > 0u) ? 1u : 0u; mine = (j == x) ? c : mine; }
        if (sum == G) break;
        __builtin_amdgcn_s_sleep(1);
        if ((++sp & 255u) == 0u) { if (xb_ld(&bar[XB_TMO])) break; if (sp > XB_SPIN_CAP) { atomicAdd(&bar[XB_TMO], 1u); break; } }
    }
    nloc = mine > 0u ? mine : 1u; nx = cnt > 0u ? cnt : 1u;
}
__device__ __forceinline__ void xcd_barrier(const XcdBarrier& b) {
    asm volatile("s_waitcnt vmcnt(0)" ::: "memory");
    __syncthreads();
    if (threadIdx.x == 0) {
        unsigned* bar = b.bar;
        __builtin_amdgcn_s_waitcnt(0);
        unsigned nloc = b.st[0], nx = b.st[1];
        if (nloc == 0u) { xcd_barrier_complete(bar, b.x, nloc, nx); b.st[0] = nloc; b.st[1] = nx; }
        const unsigned old = xb_add(&bar[XB_XSUB(b.x)], 1u);
        const unsigned gen = old / nloc;
        if (old + 1u == (gen + 1u) * nloc) {
            __builtin_amdgcn_fence(__ATOMIC_RELEASE, "agent");
            asm volatile("s_waitcnt vmcnt(0)" ::: "memory");
            const unsigned og = xb_add(&bar[XB_TOP], 1u);
            const unsigned tg = og / nx;
            if (og + 1u == (tg + 1u) * nx) xb_add(&bar[XB_TOPGEN], 1u);
            else XB_SPIN(xb_ld(&bar[XB_TOPGEN]) == tg, bar);
            __builtin_amdgcn_fence(__ATOMIC_ACQUIRE, "agent");
            xb_add(&bar[XB_XGEN(b.x)], 1u);
            asm volatile("s_waitcnt vmcnt(0)" ::: "memory");
        } else {
            XB_SPIN(xb_ld(&bar[XB_XGEN(b.x)]) == gen, bar);
            __builtin_amdgcn_fence(__ATOMIC_ACQUIRE, "agent");
            asm volatile("s_waitcnt vmcnt(0)" ::: "memory");
        }
    }
    __syncthreads();
}

constexpr int NTHREADS = 512;
constexpr int LDS_BYTES = 147456;
constexpr int NPHASE = 16;

__global__ void __launch_bounds__(NTHREADS, 2) mega_fwd(Args a) {
    extern __shared__ __attribute__((aligned(16))) unsigned char lds_raw[];
    LAS unsigned char* lds = (LAS unsigned char*)lds_raw;
    cg::grid_group grid = cg::this_grid();
    const int lo = a.ph_lo, hi = a.ph_hi;
    volatile LAS unsigned* bst = (volatile LAS unsigned*)(lds + LDS_BYTES - 64);
    if (threadIdx.x < 2) bst[threadIdx.x] = 0u;
    __syncthreads();
    const XcdBarrier xbar = xcd_barrier_post((unsigned*)(a.ws + WS_CTL) + 16384 + a.li * 4096, bst);
#define IN(k) (lo <= (k) && (k) < hi)
#define SEAM(k) do { if (IN(k) && IN((k) + 1)) { if ((k) == 0) grid.sync(); else xcd_barrier(xbar); } } while (0)
#ifndef DUP_MASK
#define DUP_MASK 0u
#endif
#define REPS(k) for (int rep = 0, nrep = ((DUP_MASK >> (k)) & 1u) ? 2 : 1; rep < nrep; ++rep, (rep < nrep ? grid.sync() : (void)0))
    unsigned char* ws = a.ws;
#define BFP(off) ((bf16_t*)(ws + (off)))
#define FPP(off) ((float*)(ws + (off)))
    const int G = gridDim.x, cu = blockIdx.x;
    if (IN(0)) REPS(0) { p0_prologue(a, lds); }
    SEAM(0);
    if (IN(1)) REPS(1) {
        { pg8::Gemm g{BFP(WS_XN), BFP(WS_WIN_T), 1024, 1024, 1024}; pg8::StaticOrder S; S.init(T_TOK, IN_COLS, G, cu);
          pg8::EpiInProj E{BFP(WS_Q), BFP(WS_K), BFP(WS_V), BFP(WS_U), BFP(WS_GV), BFP(WS_GA), BFP(WS_GB), FPP(WS_KMP), (const float2*)(ws + WS_ROPE)};
          pg8::gemm_phase(lds, g, S, E); }
    }
    SEAM(1);
    if (IN(2)) REPS(2) { att::sel_phase(BFP(WS_Q), FPP(WS_KMP), (signed char*)(ws + WS_SEL));
                 att::gmlp_phase(lds, BFP(WS_U), BFP(WS_GV), BFP(WS_WM), a.in[5], a.in[7], BFP(WS_ATTGM)); }
    SEAM(2);
    if (IN(3)) REPS(3) {
        { pg8::Gemm g{BFP(WS_MN), BFP(WS_XAKV_T), 1024, 1024, 1024}; pg8::StaticOrder S; S.init(NB * NMEM, 1024, G, cu);
          pg8::EpiPlain E{BFP(WS_XKV), 1024};
          pg8::gemm_phase(lds, g, S, E); }
      att::moba_sel_phase(lds, BFP(WS_Q), BFP(WS_K), BFP(WS_V), (const signed char*)(ws + WS_SEL), BFP(WS_PART), FPP(WS_ML), (unsigned*)(ws + WS_CTL) + a.li * 8192 + 64 + rep); }
    SEAM(3);
    if (IN(4)) REPS(4) att::moba_own_phase(lds, BFP(WS_Q), BFP(WS_K), BFP(WS_V), (const signed char*)(ws + WS_SEL), BFP(WS_PART), FPP(WS_ML), BFP(WS_ATTGM));
    SEAM(4);
    if (IN(5)) REPS(5) {
        pg8::Gemm g{BFP(WS_ATTGM), BFP(WS_WAB_T), 1024, 1024, 1024}; pg8::StaticOrder S; S.init(T_TOK, 1024, G, cu);
        pg8::EpiMergedFused E{BFP(WS_GA), BFP(WS_GB), BFP(WS_MERGED)};
        pg8::gemm_phase<pg8::EpiMergedFused, pg8::StaticOrder, true>(lds, g, S, E);
    }
    SEAM(5);
    if (IN(6)) REPS(6) {
        pg8::Gemm g{BFP(WS_MERGED), BFP(WS_WOUT_T), 1024, 1024, 1024}; pg8::StaticOrder S; S.init(T_TOK, 1024, G, cu);
        pg8::EpiResid<false> E{a.in[0], BFP(WS_XB), FPP(WS_SS1)};
        pg8::gemm_phase(lds, g, S, E);
    }
    SEAM(6);
    if (IN(7)) REPS(7) {
        pg8::Gemm g{BFP(WS_XB), BFP(WS_XAQ_T), 1024, 1024, 1024}; pg8::StaticOrder S; S.init(T_TOK, 512, G, cu);
        pg8::EpiRowScale E{BFP(WS_XQ), 512, FPP(WS_SS1), C2X};
        pg8::gemm_phase(lds, g, S, E);
    }
    SEAM(7);
    if (IN(8)) REPS(8) att::xattn_phase(lds, BFP(WS_XQ), BFP(WS_XKV), BFP(WS_XO));
    SEAM(8);
    if (IN(9)) REPS(9) {
        pg8::Gemm g{BFP(WS_XO), BFP(WS_XAO_T), 512, 512, 512}; pg8::StaticOrder S; S.init(T_TOK, 1024, G, cu);
        pg8::EpiResid<true> E{nullptr, BFP(WS_XB), FPP(WS_SS2)};
        pg8::gemm_phase(lds, g, S, E);
    }
    SEAM(9);
    if (IN(10)) REPS(10) {
        pg8::Gemm g{BFP(WS_XB), BFP(WS_PQ_T), 1024, 1024, 1024}; pg8::StaticOrder S; S.init(T_TOK, 2048, G, cu);
        pg8::EpiRowScale E{BFP(WS_QP), 2048, FPP(WS_SS2), 1.f};
        pg8::gemm_phase(lds, g, S, E);
    }
    SEAM(10);
    if (IN(11)) REPS(11) peer::topk_phase(lds, BFP(WS_QP), BFP(WS_SK), (unsigned short*)(ws + WS_PID), FPP(WS_PW));
    SEAM(11);
    if (IN(12)) REPS(12) peer::down_phase(BFP(WS_XB), ws + WS_WD, (const unsigned short*)(ws + WS_PID), BFP(WS_PARTD), (unsigned*)(ws + WS_CTL) + a.li * 8192 + 1024 + rep * 512);
    SEAM(12);
    if (IN(13)) REPS(13) peer::coef_phase(lds, BFP(WS_PARTD), FPP(WS_SS2), FPP(WS_SD), FPP(WS_SU), (const unsigned short*)(ws + WS_PID), FPP(WS_PW), BFP(WS_COEF));
    SEAM(13);
    if (IN(14)) REPS(14) peer::up_phase(ws + WS_WU, (const unsigned short*)(ws + WS_PID), BFP(WS_COEF), BFP(WS_XB), (rep + 1 < nrep) ? BFP(WS_RD) : BFP(WS_XB), FPP(WS_SS3), (unsigned*)(ws + WS_CTL) + a.li * 8192 + 2048 + rep * 512);
    SEAM(14);
    if (IN(15)) REPS(15) peer::final_phase(BFP(WS_XB), FPP(WS_SS3), a.in[20], a.out);
#undef BFP
#undef FPP
#undef IN
#undef SEAM
}

__global__ void __launch_bounds__(256) nv_inproj_rope(const bf16_t* XN, const float* W, const float2* rope, bf16_t* Q, bf16_t* K) {
    const int r0 = blockIdx.x * 8, which = blockIdx.y, p = threadIdx.x, head = p >> 5, i = p & 31;
    const int c1 = which * 512 + head * 64 + i, c2 = c1 + 32;
    float a1[8], a2[8];
#pragma unroll
    for (int j = 0; j < 8; ++j) { a1[j] = 0.f; a2[j] = 0.f; }
    for (int k = 0; k < 1024; ++k) { const float w1 = W[(size_t)k * IN_COLS + c1], w2 = W[(size_t)k * IN_COLS + c2];
#pragma unroll
        for (int j = 0; j < 8; ++j) { const float x = bf2f(XN[(size_t)(r0 + j) * 1024 + k]); a1[j] += x * w1; a2[j] += x * w2; } }
    bf16_t* O = which ? K : Q; const float sc = which ? 1.f : C2M;
#pragma unroll
    for (int j = 0; j < 8; ++j) { const int r = r0 + j, pos = r & (SEQ - 1); const float2 cs = rope[pos * 32 + i];
        const float o1 = a1[j] * cs.x - a2[j] * cs.y, o2 = a2[j] * cs.x + a1[j] * cs.y;
        *(unsigned*)(O + (size_t)r * 512 + head * 64 + 2 * i) = pk2(o1 * sc, o2 * sc); }
}
__global__ void __launch_bounds__(256) nv_inproj_rest(const bf16_t* XN, const float* W, bf16_t* V, bf16_t* U, bf16_t* GV, bf16_t* GA, bf16_t* GB) {
    const int r0 = blockIdx.x * 8, n = 1024 + blockIdx.y * 256 + threadIdx.x;
    float acc[8];
#pragma unroll
    for (int j = 0; j < 8; ++j) acc[j] = 0.f;
    for (int k = 0; k < 1024; ++k) { const float w = W[(size_t)k * IN_COLS + n];
#pragma unroll
        for (int j = 0; j < 8; ++j) acc[j] += bf2f(XN[(size_t)(r0 + j) * 1024 + k]) * w; }
#pragma unroll
    for (int j = 0; j < 8; ++j) { const size_t r = r0 + j; const float v = acc[j];
        if (n < 1536) V[r * 512 + (n - 1024)] = f2bf(v);
        else if (n < 2048) U[r * 512 + (n - 1536)] = f2bf(gelu_tanh(v));
        else if (n < 2560) GV[r * 512 + (n - 2048)] = f2bf(gelu_tanh(v));
        else if (n < 3584) GA[r * 1024 + (n - 2560)] = f2bf(sigmoidf(v));
        else GB[r * 1024 + (n - 3584)] = f2bf(sigmoidf(v)); }
}
__global__ void __launch_bounds__(512) nv_kmean(const bf16_t* K, float* KMP) {
    const int blk = blockIdx.x, c = threadIdx.x; float s = 0.f;
    for (int r = 0; r < 256; ++r) s += bf2f(K[(size_t)(blk * 256 + r) * 512 + c]);
    KMP[(size_t)blk * 1024 + c] = s; KMP[(size_t)blk * 1024 + 512 + c] = 0.f;
}
template <int MODE>
__global__ void __launch_bounds__(256) nv_gemm(const bf16_t* A, int lda, const float* W, int ldw, int K, const float* kscale, bf16_t* O, int ldo, const float* SS, float cscale, float* res) {
    const int r0 = blockIdx.x * 8, n = blockIdx.y * 256 + threadIdx.x;
    float acc[8];
#pragma unroll
    for (int j = 0; j < 8; ++j) acc[j] = 0.f;
    for (int k = 0; k < K; ++k) { const float w = W[(size_t)k * ldw + n] * (kscale ? kscale[k] : 1.f);
#pragma unroll
        for (int j = 0; j < 8; ++j) acc[j] += bf2f(A[(size_t)(r0 + j) * lda + k]) * w; }
#pragma unroll
    for (int j = 0; j < 8; ++j) { const size_t r = r0 + j; float v = acc[j];
        if (MODE == 0) { float rs = 1.f; if (SS) { float s = 0.f; for (int q = 0; q < 16; ++q) s += SS[r * 16 + q]; rs = rsqrtf(s * (1.f / DM) + EPS); } O[r * ldo + n] = f2bf(v * rs * cscale); }
        else { const float x = res[r * ldo + n] + v; res[r * ldo + n] = x; O[r * ldo + n] = f2bf(x); } }
}
__global__ void __launch_bounds__(256) nv_wout(const bf16_t* A, const float* W, const float* x, float* out, bf16_t* XB) {
    const int r0 = blockIdx.x * 8, n = blockIdx.y * 256 + threadIdx.x;
    float acc[8];
#pragma unroll
    for (int j = 0; j < 8; ++j) acc[j] = 0.f;
    for (int k = 0; k < 1024; ++k) { const float w = W[(size_t)k * 1024 + n];
#pragma unroll
        for (int j = 0; j < 8; ++j) acc[j] += bf2f(A[(size_t)(r0 + j) * 1024 + k]) * w; }
#pragma unroll
    for (int j = 0; j < 8; ++j) { const size_t r = r0 + j; const float v = x[r * 1024 + n] + acc[j]; out[r * 1024 + n] = v; XB[r * 1024 + n] = f2bf(v); }
}
__global__ void __launch_bounds__(256) nv_merged(const bf16_t* AG, const float* Wa, const float* Wb, const bf16_t* GA, const bf16_t* GB, bf16_t* MG) {
    const int r0 = blockIdx.x * 8, n = blockIdx.y * 256 + threadIdx.x;
    float ya[8], yb[8];
#pragma unroll
    for (int j = 0; j < 8; ++j) { ya[j] = 0.f; yb[j] = 0.f; }
    for (int k = 0; k < 512; ++k) { const float wa = Wa[(size_t)k * 1024 + n], wb = Wb[(size_t)k * 1024 + n];
#pragma unroll
        for (int j = 0; j < 8; ++j) { ya[j] += bf2f(AG[(size_t)(r0 + j) * 1024 + k]) * wa; yb[j] += bf2f(AG[(size_t)(r0 + j) * 1024 + 512 + k]) * wb; } }
#pragma unroll
    for (int j = 0; j < 8; ++j) { const size_t r = r0 + j; MG[r * 1024 + n] = f2bf(bf2f(GA[r * 1024 + n]) * ya[j] + bf2f(GB[r * 1024 + n]) * yb[j]); }
}
__global__ void __launch_bounds__(256) nv_rowss(const float* X, float* SS) {
    const int lane = threadIdx.x & 63, row = blockIdx.x * 4 + (threadIdx.x >> 6); float s = 0.f;
    for (int j = 0; j < 16; ++j) { const float v = X[(size_t)row * 1024 + j * 64 + lane]; s += v * v; }
    s = wave_sum(s);
    if (lane < 16) SS[(size_t)row * 16 + lane] = lane == 0 ? s : 0.f;
}
__global__ void __launch_bounds__(256) nv_sel(const bf16_t* Q, const float* KMP, signed char* SEL) {
    const int idx = blockIdx.x * 256 + threadIdx.x, t = idx >> 3, h = idx & 7, b = t / SEQ, qb = (t % SEQ) / 256;
    float bv[3] = {-3e38f, -3e38f, -3e38f}; int bi[3] = {-1, -1, -1};
    for (int n = 0; n < qb; ++n) { float g = 0.f; const float* km = KMP + (size_t)(b * 32 + n) * 1024 + h * 64;
        for (int j = 0; j < 64; ++j) g += bf2f(Q[(size_t)t * 512 + h * 64 + j]) * (km[j] + km[512 + j]);
        if (g > bv[0]) { bv[2] = bv[1]; bi[2] = bi[1]; bv[1] = bv[0]; bi[1] = bi[0]; bv[0] = g; bi[0] = n; }
        else if (g > bv[1]) { bv[2] = bv[1]; bi[2] = bi[1]; bv[1] = g; bi[1] = n; }
        else if (g > bv[2]) { bv[2] = g; bi[2] = n; } }
    char4 o; o.x = (signed char)bi[0]; o.y = (signed char)bi[1]; o.z = (signed char)bi[2]; o.w = -1;
    ((char4*)SEL)[(size_t)(b * 8 + h) * SEQ + (t % SEQ)] = o;
}
__global__ void __launch_bounds__(256) nv_moba(const bf16_t* Q, const bf16_t* K, const bf16_t* V, const signed char* SEL, bf16_t* ATTGM) {
    const int lane = threadIdx.x & 63, idx = blockIdx.x * 4 + (threadIdx.x >> 6), t = idx >> 3, h = idx & 7, b = t / SEQ, pos = t % SEQ, qb = pos / 256;
    const float q = bf2f(Q[(size_t)t * 512 + h * 64 + lane]);
    float m = -3e38f, l = 0.f, o = 0.f;
    for (int s = 0; s < 4; ++s) {
        int n, cnt;
        if (s < 3) { n = SEL[((size_t)(b * 8 + h) * SEQ + pos) * 4 + s]; if (n < 0) continue; cnt = 256; } else { n = qb; cnt = pos - qb * 256 + 1; }
        const size_t base = (size_t)b * SEQ + (size_t)n * 256;
        for (int j = 0; j < cnt; ++j) {
            const float sc = wave_sum(q * bf2f(K[(base + j) * 512 + h * 64 + lane]));
            const float mn = fmaxf(m, sc), al = exp2f(m - mn), p = exp2f(sc - mn);
            l = l * al + p; o = o * al + p * bf2f(V[(base + j) * 512 + h * 64 + lane]); m = mn; } }
    ATTGM[(size_t)t * 1024 + h * 64 + lane] = f2bf(o / l);
}
__global__ void __launch_bounds__(256) nv_gvstat(const bf16_t* GV, float* RS) {
    const int lane = threadIdx.x & 63, row = blockIdx.x * 4 + (threadIdx.x >> 6); float s = 0.f;
    for (int j = 0; j < 8; ++j) { const float v = bf2f(GV[(size_t)row * 512 + j * 64 + lane]); s += v * v; }
    s = wave_sum(s);
    if (lane == 0) RS[row] = rsqrtf(s * (1.f / 512.f) + EPS);
}
__global__ void __launch_bounds__(256) nv_gmlp(const bf16_t* U, const bf16_t* GV, const float* RS, const float* ng, const float* w_s, const float* b_s, bf16_t* ATTGM) {
    const size_t idx = (size_t)blockIdx.x * 256 + threadIdx.x; const int t = (int)(idx >> 9), c = (int)(idx & 511), g = c >> 6, tt = t & 127, t0 = t - tt;
    float z = 0.f;
    for (int s = 0; s <= tt; ++s) z += w_s[((size_t)g * 128 + tt) * 128 + s] * (bf2f(GV[(size_t)(t0 + s) * 512 + c]) * RS[t0 + s] * ng[c]);
    z += b_s[g * 128 + tt];
    ATTGM[(size_t)t * 1024 + 512 + c] = f2bf(bf2f(U[(size_t)t * 512 + c]) * z);
}
__global__ void __launch_bounds__(256) nv_xattn(const bf16_t* XQ, const bf16_t* XKV, bf16_t* XO) {
    const int lane = threadIdx.x & 63, idx = blockIdx.x * 4 + (threadIdx.x >> 6), t = idx >> 2, h = idx & 3, b = t / SEQ;
    const float q0 = bf2f(XQ[(size_t)t * 512 + h * 128 + lane]), q1 = bf2f(XQ[(size_t)t * 512 + h * 128 + 64 + lane]);
    float m = -3e38f, l = 0.f, o0 = 0.f, o1 = 0.f;
    for (int j = 0; j < NMEM; ++j) { const bf16_t* kr = XKV + (size_t)(b * NMEM + j) * 1024 + h * 128;
        const float sc = wave_sum(q0 * bf2f(kr[lane]) + q1 * bf2f(kr[64 + lane]));
        const float mn = fmaxf(m, sc), al = exp2f(m - mn), p = exp2f(sc - mn);
        l = l * al + p; o0 = o0 * al + p * bf2f(kr[512 + lane]); o1 = o1 * al + p * bf2f(kr[512 + 64 + lane]); m = mn; }
    XO[(size_t)t * 512 + h * 128 + lane] = f2bf(o0 / l); XO[(size_t)t * 512 + h * 128 + 64 + lane] = f2bf(o1 / l);
}
__device__ __forceinline__ void wave_argmax(float v, int i, float& bv, int& bi) {
#pragma unroll
    for (int o = 1; o < 64; o <<= 1) { const float ov = __shfl_xor(v, o); const int oi = __shfl_xor(i, o); if (ov > v || (ov == v && oi < i)) { v = ov; i = oi; } }
    bv = v; bi = i;
}
__global__ void __launch_bounds__(256) nv_peer_topk(const bf16_t* QP, const float* SK, int* PID, float* PW) {
    __shared__ float sv[4][2][16]; __shared__ int si[4][2][16];
    const int lane = threadIdx.x & 63, w = threadIdx.x >> 6, idx = blockIdx.x * 4 + w, t = idx >> 3, h = idx & 7;
    for (int p = 0; p < 2; ++p) {
        const bf16_t* q = QP + (size_t)t * 2048 + h * 256 + p * 128; const float* k0 = SK + ((size_t)(h * 2 + p) * 128 + lane) * 128; const float* k1 = k0 + 64 * 128;
        float s0 = 0.f, s1 = 0.f;
        for (int d = 0; d < 128; ++d) { const float qq = bf2f(q[d]); s0 += qq * k0[d]; s1 += qq * k1[d]; }
        for (int r = 0; r < 16; ++r) { float v; int i; if (s0 >= s1) { v = s0; i = lane; } else { v = s1; i = lane + 64; }
            float bv; int bi; wave_argmax(v, i, bv, bi);
            if (bi == lane) s0 = -3e38f; if (bi == lane + 64) s1 = -3e38f;
            if (lane == 0) { sv[w][p][r] = bv; si[w][p][r] = bi; } }
    }
    __syncthreads();
    float c[4]; int ci[4];
#pragma unroll
    for (int j = 0; j < 4; ++j) { const int pos = lane * 4 + j, i1 = pos >> 4, i2 = pos & 15; c[j] = sv[w][0][i1] + sv[w][1][i2]; ci[j] = pos; }
    float mykeep = 0.f; int myid = 0;
    float top0 = 0.f, denom = 0.f;
    for (int r = 0; r < 16; ++r) { float v = c[0]; int i = ci[0];
#pragma unroll
        for (int j = 1; j < 4; ++j) if (c[j] > v) { v = c[j]; i = ci[j]; }
        float bv; int bi; wave_argmax(v, i, bv, bi);
#pragma unroll
        for (int j = 0; j < 4; ++j) if (ci[j] == bi) c[j] = -3e38f;
        if (r == 0) top0 = bv;
        const float e = __expf(bv - top0); denom += e;
        if (lane == r) { mykeep = e; myid = si[w][0][bi >> 4] * 128 + si[w][1][bi & 15]; } }
    if (lane < 16) { PID[(size_t)idx * 16 + lane] = myid; PW[(size_t)idx * 16 + lane] = mykeep / denom; }
}
__global__ void __launch_bounds__(256) nv_peer_ffn(const bf16_t* XB, const float* SS, const float* gffn, const float* WDn, const float* WUp, const int* PID, const float* PW, const float* fg, float* out) {
    __shared__ float coef[128]; __shared__ int eid[128]; __shared__ float red[4];
    const int t = blockIdx.x, tid = threadIdx.x, lane = tid & 63, w = tid >> 6;
    float s = 0.f; for (int q = 0; q < 16; ++q) s += SS[(size_t)t * 16 + q]; const float rstd = rsqrtf(s * (1.f / DM) + EPS);
    float xh[16];
#pragma unroll
    for (int j = 0; j < 16; ++j) xh[j] = bf2f(XB[(size_t)t * 1024 + j * 64 + lane]) * gffn[j * 64 + lane];
    for (int jj = 0; jj < 32; ++jj) { const int j = w * 32 + jj; const int e = PID[(size_t)t * 128 + j]; const float* wd = WDn + (size_t)e * 1024; float d = 0.f;
#pragma unroll
        for (int q = 0; q < 16; ++q) d += xh[q] * wd[q * 64 + lane];
        d = wave_sum(d) * rstd;
        if (lane == 0) { coef[j] = PW[(size_t)t * 128 + j] * gelu_tanh(d); eid[j] = e; } }
    __syncthreads();
    float y[4] = {0.f, 0.f, 0.f, 0.f};
    for (int j = 0; j < 128; ++j) { const float cf = coef[j]; const float4 u = *(const float4*)(WUp + (size_t)eid[j] * 1024 + tid * 4); y[0] += cf * u.x; y[1] += cf * u.y; y[2] += cf * u.z; y[3] += cf * u.w; }
    const float4 x2 = *(const float4*)(out + (size_t)t * 1024 + tid * 4);
    y[0] += x2.x; y[1] += x2.y; y[2] += x2.z; y[3] += x2.w;
    float ss = wave_sum(y[0] * y[0] + y[1] * y[1] + y[2] * y[2] + y[3] * y[3]);
    if (lane == 0) red[w] = ss;
    __syncthreads();
    const float r2 = rsqrtf((red[0] + red[1] + red[2] + red[3]) * (1.f / DM) + EPS);
    const float4 g = *(const float4*)(fg + tid * 4);
    *(float4*)(out + (size_t)t * 1024 + tid * 4) = make_float4(y[0] * r2 * g.x, y[1] * r2 * g.y, y[2] * r2 * g.z, y[3] * r2 * g.w);
}

#ifndef OPT_MASK
#define OPT_MASK 0xFFFFu
#endif

static void launch_mega(const Args& a0, int lo, int hi, int grid, hipStream_t stream, int li = 0) {
    Args a = a0; a.ph_lo = lo; a.ph_hi = hi; a.li = li;
    void* args[] = {&a};
    hipError_t e = hipLaunchCooperativeKernel((void*)mega_fwd, dim3(grid), dim3(NTHREADS), args, LDS_BYTES, stream);
    if (e != hipSuccess) fprintf(stderr, "cooperative launch failed: %s (grid %d)\n", hipGetErrorString(e), grid);
}

extern "C" void kernel_launch(void* const* d_in, const int* in_sizes, int n_in, void* d_out, int out_size, void* d_ws, size_t ws_size, hipStream_t stream) {
    static int grid = 0;
    if (grid == 0) {
        int dev = 0, cus = 0, per_cu = 0;
        (void)hipGetDevice(&dev);
        (void)hipDeviceGetAttribute(&cus, hipDeviceAttributeMultiprocessorCount, dev);
        (void)hipFuncSetAttribute((const void*)mega_fwd, hipFuncAttributeMaxDynamicSharedMemorySize, LDS_BYTES);
        (void)hipOccupancyMaxActiveBlocksPerMultiprocessor(&per_cu, (const void*)mega_fwd, NTHREADS, LDS_BYTES);
        if (n_in != 21 || ws_size < WS_END || out_size != T_TOK * DM || per_cu < 1) { fprintf(stderr, "kernel_launch: bad config n_in %d ws %zu out %d per_cu %d\n", n_in, ws_size, out_size, per_cu); grid = -1; return; }
        grid = cus;
    }
    if (grid < 0) return;
    (void)hipMemsetAsync((char*)d_ws + WS_CTL, 0, CTL_BYTES, stream);
    Args a{};
    for (int i = 0; i < 21; ++i) a.in[i] = (const float*)d_in[i];
    a.out = (float*)d_out; a.ws = (unsigned char*)d_ws;
    unsigned char* ws = (unsigned char*)d_ws;
    const unsigned mask = OPT_MASK;
#ifndef PROBE_LO
#define PROBE_LO 0
#define PROBE_HI 0
#endif
    if (PROBE_HI >= PROBE_LO && PROBE_HI > 0) { launch_mega(a, 0, PROBE_HI, grid, stream, 0); launch_mega(a, PROBE_LO, NPHASE, grid, stream, 1); return; }
    if (mask == (1u << NPHASE) - 1u) { launch_mega(a, 0, NPHASE, grid, stream); return; }
#define BF(off) ((bf16_t*)(ws + (off)))
#define FP(off) ((float*)(ws + (off)))
    for (int ph = 0; ph < NPHASE; ++ph) {
        if (mask & (1u << ph)) { int hi = ph + 1; while (hi < NPHASE && (mask & (1u << hi))) ++hi; launch_mega(a, ph, hi, grid, stream); ph = hi - 1; continue; }
        switch (ph) {
        case 1:
            nv_inproj_rope<<<dim3(T_TOK / 8, 2), 256, 0, stream>>>(BF(WS_XN), a.in[3], (const float2*)(ws + WS_ROPE), BF(WS_Q), BF(WS_K));
            nv_inproj_rest<<<dim3(T_TOK / 8, 14), 256, 0, stream>>>(BF(WS_XN), a.in[3], BF(WS_V), BF(WS_U), BF(WS_GV), BF(WS_GA), BF(WS_GB));
            nv_kmean<<<256, 512, 0, stream>>>(BF(WS_K), FP(WS_KMP));
            nv_gemm<0><<<dim3(NB * NMEM / 8, 4), 256, 0, stream>>>(BF(WS_MN), 1024, a.in[13], 1024, 1024, nullptr, BF(WS_XKV), 1024, nullptr, 1.f, nullptr);
            break;
        case 2:
            nv_sel<<<T_TOK * 8 / 256, 256, 0, stream>>>(BF(WS_Q), FP(WS_KMP), (signed char*)(ws + WS_SEL));
            nv_gvstat<<<T_TOK / 4, 256, 0, stream>>>(BF(WS_GV), FP(WS_RS));
            nv_gmlp<<<T_TOK * 512 / 256, 256, 0, stream>>>(BF(WS_U), BF(WS_GV), FP(WS_RS), a.in[5], a.in[6], a.in[7], BF(WS_ATTGM));
            break;
        case 3:
            break;
        case 4:
            nv_moba<<<T_TOK * 8 / 4, 256, 0, stream>>>(BF(WS_Q), BF(WS_K), BF(WS_V), (const signed char*)(ws + WS_SEL), BF(WS_ATTGM));
            break;
        case 5:
            nv_merged<<<dim3(T_TOK / 8, 4), 256, 0, stream>>>(BF(WS_ATTGM), a.in[4], a.in[8], BF(WS_GA), BF(WS_GB), BF(WS_MERGED));
            break;
        case 6:
            nv_wout<<<dim3(T_TOK / 8, 4), 256, 0, stream>>>(BF(WS_MERGED), a.in[9], a.in[0], a.out, BF(WS_XB));
            nv_rowss<<<T_TOK / 4, 256, 0, stream>>>(a.out, FP(WS_SS1));
            break;
        case 7:
            nv_gemm<0><<<dim3(T_TOK / 8, 2), 256, 0, stream>>>(BF(WS_XB), 1024, a.in[12], 512, 1024, a.in[10], BF(WS_XQ), 512, FP(WS_SS1), C2X, nullptr);
            break;
        case 8:
            nv_xattn<<<T_TOK * 4 / 4, 256, 0, stream>>>(BF(WS_XQ), BF(WS_XKV), BF(WS_XO));
            break;
        case 9:
            nv_gemm<1><<<dim3(T_TOK / 8, 4), 256, 0, stream>>>(BF(WS_XO), 512, a.in[14], 1024, 512, nullptr, BF(WS_XB), 1024, nullptr, 1.f, a.out);
            nv_rowss<<<T_TOK / 4, 256, 0, stream>>>(a.out, FP(WS_SS2));
            break;
        case 10:
            nv_gemm<0><<<dim3(T_TOK / 8, 8), 256, 0, stream>>>(BF(WS_XB), 1024, a.in[16], 2048, 1024, a.in[15], BF(WS_QP), 2048, FP(WS_SS2), 1.f, nullptr);
            break;
        case 11:
            nv_peer_topk<<<T_TOK * 8 / 4, 256, 0, stream>>>(BF(WS_QP), a.in[17], (int*)(ws + WS_PID), FP(WS_PW));
            break;
        case 12:
            nv_peer_ffn<<<T_TOK, 256, 0, stream>>>(BF(WS_XB), FP(WS_SS2), a.in[15], a.in[18], a.in[19], (const int*)(ws + WS_PID), FP(WS_PW), a.in[20], a.out);
            break;
        default: break;
        }
    }
#undef BF
#undef FP
}
```

```cpp
#include <hip/hip_runtime.h>
#include <hip/hip_cooperative_groups.h>
#include <cstdio>
#include <cstdint>
namespace cg = cooperative_groups;

constexpr int T_TOK = 65536, DM = 1024, NB = 8, SEQ = 8192, NMEM = 256;
constexpr int IN_COLS = 4608;
constexpr float EPS = 1e-6f;
constexpr float LOG2E = 1.4426950408889634f;
constexpr float C2M = 0.125f * LOG2E;
constexpr float C2X = 0.08838834764831845f * LOG2E;

typedef unsigned short bf16_t;
#define LAS __attribute__((address_space(3)))

constexpr size_t MiB = 1u << 20;
constexpr size_t WS_CTL = 0, CTL_BYTES = 1 * MiB;
constexpr size_t WS_ROPE = 1 * MiB;
constexpr size_t WS_WIN_T = 3 * MiB;
constexpr int W8_BF16_ROWS = 1024;
constexpr size_t WS_WG8 = WS_WIN_T + (size_t)W8_BF16_ROWS * 2048;
constexpr size_t OUT_XN8 = 128 * MiB;
constexpr float WG8_SCALE = 64.f;
constexpr size_t WS_WAB_T = 12 * MiB;
constexpr size_t WS_WOUT_T = 14 * MiB;
constexpr size_t WS_XAQ_T = 16 * MiB;
constexpr size_t WS_XAKV_T = 17 * MiB;
constexpr size_t WS_XAO_T = 19 * MiB;
constexpr size_t WS_PQ_T = 20 * MiB;
constexpr size_t WS_SK = 24 * MiB;
constexpr size_t WS_WM = 24 * MiB + 512 * 1024;
constexpr size_t WS_MN = 25 * MiB;
constexpr size_t WS_XKV = 29 * MiB;
constexpr size_t WS_KMP = 33 * MiB;
constexpr size_t WS_SS1 = 34 * MiB;
constexpr size_t WS_SS2 = 38 * MiB;
constexpr size_t WS_SEL = 42 * MiB;
constexpr size_t WS_WD = 44 * MiB;
constexpr size_t WS_SD = 60 * MiB;
constexpr size_t WS_SU = 61 * MiB;
constexpr size_t WS_WU = 76 * MiB;
constexpr size_t WS_SS3 = 92 * MiB;
constexpr size_t WS_RS0 = 96 * MiB;
constexpr size_t WS_RA = 108 * MiB;
constexpr size_t WS_XN = WS_RA, WS_PART = WS_RA, WS_ML = WS_RA + 192 * MiB, WS_MERGED = WS_RA;
constexpr size_t WS_RB = 316 * MiB;
constexpr size_t WS_Q = WS_RB, WS_K = WS_RB + 64 * MiB, WS_V = WS_RB + 128 * MiB, WS_XB = WS_RB, WS_XQ = WS_V;
constexpr size_t WS_RC = 508 * MiB;
constexpr size_t WS_U = WS_RC, WS_GV = WS_RC + 64 * MiB, WS_XO = WS_U, WS_PID = WS_GV, WS_PW = WS_GV + 32 * MiB;
constexpr size_t WS_RD = 636 * MiB;
constexpr size_t WS_GA = WS_RD, WS_GB = WS_RD + 128 * MiB, WS_QP = WS_RD;
constexpr size_t WS_RE = 892 * MiB;
constexpr size_t WS_ATTGM = WS_RE, WS_COEF = WS_RE;
constexpr size_t WS_PARTD = WS_RD;
constexpr size_t WS_END = 1020 * MiB;
constexpr size_t WS_RS = WS_SS2;

__device__ __forceinline__ float bf2f(bf16_t v) { return __uint_as_float((unsigned)v << 16); }
typedef __bf16 hw_bf16x2 __attribute__((ext_vector_type(2)));
typedef float hw_f32x2 __attribute__((ext_vector_type(2)));
__device__ __forceinline__ unsigned pk2(float lo, float hi) { const hw_f32x2 v = {lo, hi}; return __builtin_bit_cast(unsigned, __builtin_convertvector(v, hw_bf16x2)); }
__device__ __forceinline__ bf16_t f2bf(float f) { return __builtin_bit_cast(bf16_t, (__bf16)f); }
__device__ __forceinline__ float gelu_tanh(float x) { const float t = x * (-2.3022082f + -0.10294325f * (x * x)); return x * __builtin_amdgcn_rcpf(1.f + __builtin_amdgcn_exp2f(t)); }
__device__ __forceinline__ float sigmoidf(float x) { return __builtin_amdgcn_rcpf(1.f + __builtin_amdgcn_exp2f(-1.4426950409f * x)); }
template <int CTRL> __device__ __forceinline__ float dppf_(float v) { return __builtin_bit_cast(float, __builtin_amdgcn_update_dpp(0, __builtin_bit_cast(int, v), CTRL, 0xf, 0xf, true)); }
__device__ __forceinline__ float wave_sum(float v) {
    v += dppf_<0xB1>(v); v += dppf_<0x4E>(v); v += dppf_<0x141>(v); v += dppf_<0x140>(v);
    { auto rr = __builtin_amdgcn_permlane16_swap(__float_as_uint(v), __float_as_uint(v), false, false); v = __uint_as_float(rr[0]) + __uint_as_float(rr[1]); }
    { auto rr = __builtin_amdgcn_permlane32_swap(__float_as_uint(v), __float_as_uint(v), false, false); v = __uint_as_float(rr[0]) + __uint_as_float(rr[1]); }
    return v;
}
__device__ __forceinline__ float wave_max(float v) {
#pragma unroll
    for (int o = 1; o < 64; o <<= 1) v = fmaxf(v, __shfl_xor(v, o));
    return v;
}
__device__ __forceinline__ int qk_store_col(int d) { return 2 * (d & 31) + (d >> 5); }

struct Args { const float* in[21]; float* out; unsigned char* ws; int ph_lo, ph_hi, li, pad; };

template <bool QKPERM>
__device__ __forceinline__ void p0_transpose_item(const float* W, int ldw, int K, int Ncols, bf16_t* WT, int ldt, int col_off, const float* kscale, LAS float* scr, int item, int lane) {
    const int nblk = Ncols / 32, kb = item / nblk, nb = item % nblk, k0 = 64 * kb, n0 = 32 * nb;
#pragma unroll 8
    for (int i = 0; i < 32; ++i) { const int kk = 2 * i + (lane >> 5); float v = W[(size_t)(k0 + kk) * ldw + n0 + (lane & 31)]; if (kscale) v *= kscale[k0 + kk]; scr[kk * 33 + (lane & 31)] = v; }
    asm volatile("s_waitcnt lgkmcnt(0)" ::: "memory");
    const int c = lane & 7;
#pragma unroll
    for (int j = 0; j < 4; ++j) { const int n = (lane >> 3) + 8 * j; const LAS float* s = scr + (8 * c) * 33 + n;
        uint4 o; o.x = pk2(s[0 * 33], s[1 * 33]); o.y = pk2(s[2 * 33], s[3 * 33]); o.z = pk2(s[4 * 33], s[5 * 33]); o.w = pk2(s[6 * 33], s[7 * 33]);
        int nn = n0 + n;
        if (QKPERM) { if (nn < 1024) nn = (nn & ~63) + qk_store_col(nn & 63); }
        int f8row = -1;
        if (QKPERM) { if (nn >= 2560) f8row = nn - 2560; else if (nn >= 2048) f8row = 2560 + (nn - 2048); else if (nn >= 1536) nn = 512 + (nn - 1536); else if (nn >= 1024) f8row = 2048 + (nn - 1024); else if (nn >= 512) f8row = 3072 + (nn - 512); }
        if (f8row >= 0) {
            int lo = __builtin_amdgcn_cvt_pk_fp8_f32(s[0 * 33] * WG8_SCALE, s[1 * 33] * WG8_SCALE, 0, false); lo = __builtin_amdgcn_cvt_pk_fp8_f32(s[2 * 33] * WG8_SCALE, s[3 * 33] * WG8_SCALE, lo, true);
            int hi = __builtin_amdgcn_cvt_pk_fp8_f32(s[4 * 33] * WG8_SCALE, s[5 * 33] * WG8_SCALE, 0, false); hi = __builtin_amdgcn_cvt_pk_fp8_f32(s[6 * 33] * WG8_SCALE, s[7 * 33] * WG8_SCALE, hi, true);
            *(uint2*)((unsigned char*)WT + (size_t)W8_BF16_ROWS * 2048 + (size_t)f8row * 1024 + k0 + 8 * c) = make_uint2((unsigned)lo, (unsigned)hi);
        } else *(uint4*)(WT + (size_t)nn * ldt + col_off + k0 + 8 * c) = o; }
    asm volatile("s_waitcnt lgkmcnt(0)" ::: "memory");
}
template <int B>
__device__ __forceinline__ void rms_rows_to_bf16(const float* __restrict__ X, const float* __restrict__ g, bf16_t* __restrict__ O, size_t m0, size_t mstride, int lane, float* __restrict__ RS = nullptr, unsigned char* __restrict__ O8 = nullptr) {
    float4 v[B][4];
#pragma unroll
    for (int u = 0; u < B; ++u) { const float4* xr = (const float4*)(X + (m0 + u * mstride) * DM) + lane;
#pragma unroll
        for (int j = 0; j < 4; ++j) v[u][j] = xr[64 * j]; }
    float4 gg[4];
#pragma unroll
    for (int j = 0; j < 4; ++j) gg[j] = RS ? make_float4(1.f, 1.f, 1.f, 1.f) : ((const float4*)g + lane)[64 * j];
#pragma unroll
    for (int u = 0; u < B; ++u) { float s = 0.f;
#pragma unroll
        for (int j = 0; j < 4; ++j) s += (v[u][j].x * v[u][j].x + v[u][j].y * v[u][j].y) + (v[u][j].z * v[u][j].z + v[u][j].w * v[u][j].w);
        const float ms = wave_sum(s) * (1.f / DM) + EPS; const float rstd = rsqrtf(ms);
        if (RS && lane == 0) RS[m0 + u * mstride] = sqrtf(ms);
        uint2* o8 = (uint2*)(O + (m0 + u * mstride) * DM) + lane;
#pragma unroll
        for (int j = 0; j < 4; ++j) { uint2 o; o.x = pk2(v[u][j].x * rstd * gg[j].x, v[u][j].y * rstd * gg[j].y); o.y = pk2(v[u][j].z * rstd * gg[j].z, v[u][j].w * rstd * gg[j].w); o8[64 * j] = o; }
        if (O8) {
#pragma unroll
            for (int j = 0; j < 4; ++j) { int w = __builtin_amdgcn_cvt_pk_fp8_f32(v[u][j].x * rstd, v[u][j].y * rstd, 0, false); w = __builtin_amdgcn_cvt_pk_fp8_f32(v[u][j].z * rstd, v[u][j].w * rstd, w, true);
                ((unsigned*)(O8 + (m0 + u * mstride) * DM))[64 * j + lane] = (unsigned)w; } } }
}
__device__ __forceinline__ void p0_prologue(const Args& a, LAS unsigned char* lds) {
    const int tid = threadIdx.x, lane = tid & 63, wave = tid >> 6;
    const int gw = blockIdx.x * 8 + wave, NGW = gridDim.x * 8;
    unsigned char* ws = a.ws;
    LAS float* scr = (LAS float*)(lds + wave * 16384);
    constexpr int I_IN = (1024 / 64) * (IN_COLS / 32), I_A = (512 / 64) * (1024 / 32), I_O = (1024 / 64) * (1024 / 32), I_XQ = (1024 / 64) * (512 / 32), I_KV = I_O, I_XO = (512 / 64) * (1024 / 32), I_PQ = (1024 / 64) * (2048 / 32);
    constexpr int NITEMS = I_IN + 2 * I_A + I_O + I_XQ + I_KV + I_XO + I_PQ;
    for (int it = gw; it < NITEMS; it += NGW) {
        int r = it;
        if (r < I_IN) { p0_transpose_item<true>(a.in[3], IN_COLS, 1024, IN_COLS, (bf16_t*)(ws + WS_WIN_T), 1024, 0, a.in[2], scr, r, lane); continue; } r -= I_IN;
        if (r < I_A) { p0_transpose_item<false>(a.in[4], 1024, 512, 1024, (bf16_t*)(ws + WS_WAB_T), 1024, 0, nullptr, scr, r, lane); continue; } r -= I_A;
        if (r < I_A) { p0_transpose_item<false>(a.in[8], 1024, 512, 1024, (bf16_t*)(ws + WS_WAB_T), 1024, 512, nullptr, scr, r, lane); continue; } r -= I_A;
        if (r < I_O) { p0_transpose_item<false>(a.in[9], 1024, 1024, 1024, (bf16_t*)(ws + WS_WOUT_T), 1024, 0, nullptr, scr, r, lane); continue; } r -= I_O;
        if (r < I_XQ) { p0_transpose_item<false>(a.in[12], 512, 1024, 512, (bf16_t*)(ws + WS_XAQ_T), 1024, 0, a.in[10], scr, r, lane); continue; } r -= I_XQ;
        if (r < I_KV) { p0_transpose_item<false>(a.in[13], 1024, 1024, 1024, (bf16_t*)(ws + WS_XAKV_T), 1024, 0, nullptr, scr, r, lane); continue; } r -= I_KV;
        if (r < I_XO) { p0_transpose_item<false>(a.in[14], 1024, 512, 1024, (bf16_t*)(ws + WS_XAO_T), 512, 0, nullptr, scr, r, lane); continue; } r -= I_XO;
        p0_transpose_item<false>(a.in[16], 2048, 1024, 2048, (bf16_t*)(ws + WS_PQ_T), 1024, 0, a.in[15], scr, r, lane);
    }
    const size_t gt = (size_t)blockIdx.x * blockDim.x + tid, GT = (size_t)gridDim.x * blockDim.x;
    {
        const float* s = a.in[17]; bf16_t* d = (bf16_t*)(ws + WS_SK);
        for (size_t i = gt; i < 8 * 2 * 128 * 128 / 4; i += GT) { const float4 v = ((const float4*)s)[i]; uint2 o; o.x = pk2(v.x, v.y); o.y = pk2(v.z, v.w); ((uint2*)d)[i] = o; }
    }
    {
        const float* s = a.in[6]; bf16_t* d = (bf16_t*)(ws + WS_WM);
        for (size_t i = gt; i < 8 * 128 * 128; i += GT) { const int ss = i & 127, tt = (i >> 7) & 127; d[i] = f2bf(ss <= tt ? s[i] : 0.f); }
    }
    {
        float2* d = (float2*)(ws + WS_ROPE);
        for (size_t i = gt; i < 8192 * 32; i += GT) { const int p = (int)(i >> 5), k = (int)(i & 31);
            const float freq = powf(10000.0f, -(float)k / 32.0f); const float ang = (float)p * freq; float sn, cs; sincosf(ang, &sn, &cs); d[i] = make_float2(cs, sn); }
    }
    for (int r0 = gw; r0 < 2 * 16384; r0 += 4 * NGW) {
        float v[4][16];
#pragma unroll
        for (int u = 0; u < 4; ++u) { const int r = r0 + u * NGW; if (r < 2 * 16384) { const int which = r >> 14, e = r & 16383; const float* src = (which ? a.in[19] : a.in[18]) + (size_t)e * 1024 + lane * 16;
#pragma unroll
            for (int q = 0; q < 4; ++q) { const float4 t4 = *(const float4*)(src + 4 * q); v[u][4 * q] = t4.x; v[u][4 * q + 1] = t4.y; v[u][4 * q + 2] = t4.z; v[u][4 * q + 3] = t4.w; } } }
#pragma unroll
        for (int u = 0; u < 4; ++u) { const int r = r0 + u * NGW; if (r < 2 * 16384) { const int which = r >> 14, e = r & 16383;
            if (!which) {
#pragma unroll
                for (int q = 0; q < 4; ++q) { const float4 g4 = *(const float4*)(a.in[15] + lane * 16 + 4 * q); v[u][4 * q] *= g4.x; v[u][4 * q + 1] *= g4.y; v[u][4 * q + 2] *= g4.z; v[u][4 * q + 3] *= g4.w; } }
            float am = 0.f;
#pragma unroll
            for (int q = 0; q < 16; ++q) am = fmaxf(am, fabsf(v[u][q]));
            am = wave_max(am);
            const float qmax = which ? 440.f : 127.f;
            const float inv = am > 0.f ? qmax / am : 0.f;
            if (lane == 0) ((float*)(ws + (which ? WS_SU : WS_SD)))[e] = am > 0.f ? am / qmax : 1.f;
            unsigned w[4];
            if (which) {
#pragma unroll
                for (int q = 0; q < 4; ++q) { int pk = __builtin_amdgcn_cvt_pk_fp8_f32(v[u][4 * q] * inv, v[u][4 * q + 1] * inv, 0, false); pk = __builtin_amdgcn_cvt_pk_fp8_f32(v[u][4 * q + 2] * inv, v[u][4 * q + 3] * inv, pk, true); w[q] = (unsigned)pk; }
            } else {
#pragma unroll
                for (int q = 0; q < 4; ++q) w[q] = ((unsigned)__float2int_rn(v[u][4 * q] * inv) & 0xffu) | (((unsigned)__float2int_rn(v[u][4 * q + 1] * inv) & 0xffu) << 8) | (((unsigned)__float2int_rn(v[u][4 * q + 2] * inv) & 0xffu) << 16) | ((unsigned)__float2int_rn(v[u][4 * q + 3] * inv) << 24);
            }
            *(uint4*)(ws + (which ? WS_WU : WS_WD) + (size_t)(lane >> 3) * (16384 * 128) + (size_t)e * 128 + (lane & 7) * 16) = make_uint4(w[0], w[1], w[2], w[3]); } }
    }
    { size_t m = gw;
      for (; m + 3 * (size_t)NGW < T_TOK; m += 4 * (size_t)NGW) rms_rows_to_bf16<4>(a.in[0], nullptr, (bf16_t*)a.out, m, NGW, lane, (float*)(ws + WS_RS0), (unsigned char*)a.out + OUT_XN8);
      for (; m < T_TOK; m += NGW) rms_rows_to_bf16<1>(a.in[0], nullptr, (bf16_t*)a.out, m, NGW, lane, (float*)(ws + WS_RS0), (unsigned char*)a.out + OUT_XN8); }
    for (size_t m = gw; m < NB * NMEM; m += NGW) rms_rows_to_bf16<1>(a.in[1], a.in[11], (bf16_t*)(ws + WS_MN), m, NGW, lane);
}


namespace pg8 {
typedef short bf16x8 __attribute__((ext_vector_type(8)));
typedef float f32x4 __attribute__((ext_vector_type(4)));
typedef unsigned u32x4 __attribute__((ext_vector_type(4)));
constexpr int BM = 256, BK = 64, HALF = 128, HTB = HALF * BK * 2, STAGE_BYTES = 8 * HTB, NXCD = 8, WGM = 8;
__host__ __device__ __forceinline__ int lds_byte(int r, int c) { const int st = (r >> 4) * 2 + (c >> 5), rr = r & 15, cc = c & 31, ob = rr * 64 + cc * 2; return st * 1024 + (ob ^ (((ob >> 9) & 1) << 5)); }
__host__ __device__ __forceinline__ void stage_rc(int b, int& R, int& C) { const int st = b / 1024, sb = b % 1024, swz = sb ^ (((sb >> 9) & 1) << 5); R = (st >> 1) * 16 + swz / 64; C = (st & 1) * 32 + (swz % 64) / 2; }
__host__ __device__ __forceinline__ int perm32(int rho) { const int n = rho >> 4, i = rho & 15; return 8 * (i >> 2) + 4 * n + (i & 3); }
struct Unit { int pm, pn, kofs, var; };
struct Gemm { const bf16_t* A; const bf16_t* Bt; int lda, ldb, K; };
typedef int i32x4_t __attribute__((ext_vector_type(4)));
typedef int i32x8_t __attribute__((ext_vector_type(8)));
template <bool F8> struct FragS;
template <> struct FragS<false> { bf16x8 k[2]; };
template <> struct FragS<true> { i32x8_t w; };
__device__ __forceinline__ i32x8_t cat8(const bf16x8 lo, const bf16x8 hi) { const i32x4_t a = __builtin_bit_cast(i32x4_t, lo), b = __builtin_bit_cast(i32x4_t, hi); return __builtin_shufflevector(a, b, 0, 1, 2, 3, 4, 5, 6, 7); }
struct StaticOrder {
    int nM, nN, nwg, G, c, NV, kvar;
    __device__ void init(int M, int N, int G_, int c_, int NV_ = 1, int kvar_ = 0) { nM = M / BM; nN = N / BM; nwg = nM * nN; G = G_; c = c_; NV = NV_; kvar = kvar_; }
    __device__ bool next(int i, Unit& u) const {
        const int it = i / NV, v = i - it * NV;
        const long L = (long)it * G + c; if (L >= nwg) return false;
        int wgid = (int)L; { const int q = nwg / NXCD, r = nwg % NXCD, xcd = wgid % NXCD, off = wgid / NXCD; wgid = (xcd < r ? xcd * (q + 1) : r * (q + 1) + (xcd - r) * q) + off; }
        const int nig = WGM * nN, gid = wgid / nig, fm = gid * WGM, gsz = (nM - fm) < WGM ? (nM - fm) : WGM;
        u.pm = fm + ((wgid % nig) % gsz); u.pn = (wgid % nig) / gsz; u.kofs = v * kvar; u.var = v; return true;
    }
};
typedef __bf16 cvt_bf16x2 __attribute__((ext_vector_type(2)));
typedef float cvt_f32x2 __attribute__((ext_vector_type(2)));
__device__ __forceinline__ unsigned cvt_pk_bf16(float lo, float hi) { const cvt_f32x2 v = {lo, hi}; return __builtin_bit_cast(unsigned, __builtin_convertvector(v, cvt_bf16x2)); }
__device__ __forceinline__ u32x4 pack8(const f32x4 a, const f32x4 b) { u32x4 w; w.x = cvt_pk_bf16(a[0], a[1]); w.y = cvt_pk_bf16(a[2], a[3]); w.z = cvt_pk_bf16(b[0], b[1]); w.w = cvt_pk_bf16(b[2], b[3]); return w; }
__device__ __forceinline__ uint2 pack8f8(const f32x4 a, const f32x4 b) {
    int lo = __builtin_amdgcn_cvt_pk_fp8_f32(a[0], a[1], 0, false); lo = __builtin_amdgcn_cvt_pk_fp8_f32(a[2], a[3], lo, true);
    int hi = __builtin_amdgcn_cvt_pk_fp8_f32(b[0], b[1], 0, false); hi = __builtin_amdgcn_cvt_pk_fp8_f32(b[2], b[3], hi, true);
    return make_uint2((unsigned)lo, (unsigned)hi); }
__device__ __forceinline__ void unpack8(const u32x4 w, f32x4& a, f32x4& b) {
    a[0] = __uint_as_float(w.x << 16); a[1] = __uint_as_float(w.x & 0xffff0000u); a[2] = __uint_as_float(w.y << 16); a[3] = __uint_as_float(w.y & 0xffff0000u);
    b[0] = __uint_as_float(w.z << 16); b[1] = __uint_as_float(w.z & 0xffff0000u); b[2] = __uint_as_float(w.w << 16); b[3] = __uint_as_float(w.w & 0xffff0000u); }

template <class Epi, class Sched, bool MIDHOOK = false, bool F8 = false>
__device__ __forceinline__ void gemm_phase(LAS unsigned char* lds, const Gemm g, const Sched& S, const Epi& E) {
    int tid = threadIdx.x; asm volatile("" : "+v"(tid));
    const int wid = __builtin_amdgcn_readfirstlane(tid >> 6), lane = tid & 63, wr = wid >> 2, wc = wid & 3, fr = lane & 15, fq = lane >> 4;
    const int nt = g.K / BK;
    unsigned voffA[2], voffB[2];
#pragma unroll
    for (int i = 0; i < 2; ++i) { int R, C; stage_rc(tid * 16 + i * 8192, R, C); const int Rb = (R & ~31) + perm32(R & 31);
        voffA[i] = (unsigned)(R * g.lda + C) * 2u; voffB[i] = (unsigned)(Rb * g.ldb + C) * 2u; }
    const size_t kstep = (size_t)(BK * 2);
    const size_t hstepA = (size_t)HALF * g.lda * 2, hstepB = (size_t)HALF * g.ldb * 2;
    const size_t tstepA = 2 * hstepA, tstepB = 2 * hstepB;
    const unsigned ldsw = (unsigned)wid * 1024u;
    const int aoff = lds_byte(wr * 64 + fr, fq * 8), boff = lds_byte(wc * 32 + fr, fq * 8);
#define PG8_SA(b, h) (((b) * 2 + (h)) * HTB)
#define PG8_SB(b, h) ((4 + (b) * 2 + (h)) * HTB)
#define PG8_STAGE(bufoff, gbase, voff) do { const char* gb_ = (const char*)(gbase); if constexpr (F8) asm volatile("" : "+s"(gb_));     \
        _Pragma("unroll") for (int _i = 0; _i < 2; ++_i) \
        __builtin_amdgcn_global_load_lds((const unsigned*)(gb_ + (voff)[_i]), (LAS unsigned*)(lds + (bufoff) + ldsw + _i * 8192), 16, 0, 0); } while (0)
#define PG8_LDF(f, p) do { if constexpr (F8) (f).w = cat8(*(const LAS bf16x8*)(p), *(const LAS bf16x8*)((p) + 1024)); else { (f).k[0] = *(const LAS bf16x8*)(p); (f).k[1] = *(const LAS bf16x8*)((p) + 1024); } } while (0)
#define PG8_LDA(dst, b, h) do { _Pragma("unroll") for (int m = 0; m < 4; ++m) PG8_LDF(dst[m], lds + PG8_SA(b, h) + aoff + m * 2048); } while (0)
#define PG8_LDB(dst, b, h) do { _Pragma("unroll") for (int n = 0; n < 2; ++n) PG8_LDF(dst[n], lds + PG8_SB(b, h) + boff + n * 2048); } while (0)
#define PG8_MMA(ai, bj, At, Bt) do { __builtin_amdgcn_s_setprio(1); _Pragma("unroll") for (int m = 0; m < 4; ++m) _Pragma("unroll") for (int n = 0; n < 2; ++n) { \
        if constexpr (F8) asm volatile("v_mfma_f32_16x16x128_f8f6f4 %0, %1, %2, %0" : "+v"(acc[ai][bj][m][n]) : "v"(Bt[n].w), "v"(At[m].w));     \
        else { _Pragma("unroll") for (int k = 0; k < 2; ++k) acc[ai][bj][m][n] = __builtin_amdgcn_mfma_f32_16x16x32_bf16(Bt[n].k[k], At[m].k[k], acc[ai][bj][m][n], 0, 0, 0); } } __builtin_amdgcn_s_setprio(0); } while (0)
#define PG8_WAIT_V(n) asm volatile("s_waitcnt vmcnt(" #n ")" ::: "memory")
#define PG8_WAIT_L(n) asm volatile("s_waitcnt lgkmcnt(" #n ")" ::: "memory")
#define PG8_BAR __builtin_amdgcn_s_barrier()
#define PG8_SCHED __builtin_amdgcn_sched_barrier(0)
    Unit cur, nxt; int ui = 0;
    if (!S.next(0, cur)) return;
    f32x4 acc[2][2][4][2];
#pragma unroll
    for (int a = 0; a < 2; ++a)
#pragma unroll
        for (int b = 0; b < 2; ++b)
#pragma unroll
            for (int m = 0; m < 4; ++m)
#pragma unroll
                for (int n = 0; n < 2; ++n) acc[a][b][m][n] = (f32x4){0.f, 0.f, 0.f, 0.f};
    FragS<F8> At[4], B0[2], B1[2];
    const char* cA = (const char*)g.A + (size_t)cur.pm * tstepA + (size_t)cur.kofs * 2; const char* cB = (const char*)g.Bt + (size_t)cur.pn * tstepB + (size_t)cur.kofs * 2;
    PG8_STAGE(PG8_SB(0, 0), cB, voffB); PG8_STAGE(PG8_SB(0, 1), cB + hstepB, voffB); PG8_STAGE(PG8_SA(0, 0), cA, voffA); PG8_STAGE(PG8_SA(0, 1), cA + hstepA, voffA);
    if (wr == 1) PG8_BAR;
    PG8_WAIT_V(2); PG8_BAR;
    PG8_STAGE(PG8_SB(1, 0), cB + kstep, voffB); PG8_STAGE(PG8_SA(1, 0), cA + kstep, voffA); PG8_STAGE(PG8_SB(1, 1), cB + hstepB + kstep, voffB);
    PG8_WAIT_V(6); PG8_BAR;
    for (;;) {
        const bool has_next = S.next(ui + 1, nxt);
        const char* nA = has_next ? (const char*)g.A + (size_t)nxt.pm * tstepA + (size_t)nxt.kofs * 2 : cA; const char* nB = has_next ? (const char*)g.Bt + (size_t)nxt.pn * tstepB + (size_t)nxt.kofs * 2 : cB;
#define PG8_KPAIR(t) do { \
            const bool last = (t == nt - 2); \
            const char* a1 = cA + (size_t)(t + 1) * kstep; \
            const char* a2 = last ? nA : cA + (size_t)(t + 2) * kstep; const char* b2 = last ? nB : cB + (size_t)(t + 2) * kstep; \
            const char* a3 = a2 + kstep; const char* b3 = b2 + kstep; \
            PG8_LDB(B0, 0, 0); PG8_LDB(B1, 0, 1); PG8_SCHED; PG8_LDA(At, 0, 0); PG8_STAGE(PG8_SA(1, 1), a1 + hstepA, voffA); \
            PG8_WAIT_V(8); PG8_WAIT_L(0); PG8_BAR; PG8_MMA(0, 0, At, B0); PG8_MMA(0, 1, At, B1); PG8_BAR; PG8_SCHED; \
            PG8_LDA(At, 0, 1); PG8_STAGE(PG8_SB(0, 0), b2, voffB); PG8_STAGE(PG8_SB(0, 1), b2 + hstepB, voffB); PG8_STAGE(PG8_SA(0, 0), a2, voffA); \
            PG8_WAIT_V(8); PG8_WAIT_L(0); PG8_BAR; PG8_MMA(1, 0, At, B0); PG8_MMA(1, 1, At, B1); PG8_BAR; PG8_SCHED; \
            PG8_LDB(B0, 1, 0); PG8_LDB(B1, 1, 1); PG8_SCHED; PG8_LDA(At, 1, 0); PG8_STAGE(PG8_SA(0, 1), a2 + hstepA, voffA); \
            PG8_WAIT_V(8); PG8_WAIT_L(0); PG8_BAR; PG8_MMA(0, 0, At, B0); PG8_MMA(0, 1, At, B1); PG8_BAR; PG8_SCHED; \
            PG8_LDA(At, 1, 1); PG8_STAGE(PG8_SB(1, 0), b3, voffB); PG8_STAGE(PG8_SB(1, 1), b3 + hstepB, voffB); PG8_STAGE(PG8_SA(1, 0), a3, voffA); \
            PG8_WAIT_V(8); PG8_WAIT_L(0); PG8_BAR; PG8_MMA(1, 0, At, B0); PG8_MMA(1, 1, At, B1); PG8_BAR; PG8_SCHED; \
        } while (0)
        if constexpr (MIDHOOK) {
            for (int t = 0; t < nt / 2; t += 2) PG8_KPAIR(t);
            E.mid(acc, cur, wr, wc, fr, fq);
            for (int t = nt / 2; t < nt; t += 2) PG8_KPAIR(t);
        } else {
            for (int t = 0; t < nt; t += 2) PG8_KPAIR(t);
        }
#undef PG8_KPAIR
        if (wr == 0) PG8_BAR;
        if constexpr (F8) asm volatile("s_nop 15\n s_nop 15" ::: "memory");
        E(acc, cur, wr, wc, fr, fq);
        if (!has_next) break;
#pragma unroll
        for (int a = 0; a < 2; ++a)
#pragma unroll
            for (int b = 0; b < 2; ++b)
#pragma unroll
                for (int m = 0; m < 4; ++m)
#pragma unroll
                    for (int n = 0; n < 2; ++n) acc[a][b][m][n] = (f32x4){0.f, 0.f, 0.f, 0.f};
        cur = nxt; cA = nA; cB = nB; ++ui;
        if (wr == 1) PG8_BAR;
    }
    PG8_WAIT_V(0);
    PG8_BAR;
#undef PG8_SA
#undef PG8_SB
#undef PG8_STAGE
#undef PG8_LDA
#undef PG8_LDB
#undef PG8_MMA
#undef PG8_WAIT_V
#undef PG8_WAIT_L
#undef PG8_BAR
#undef PG8_SCHED
}

#define EPI_ROWS() const int row0 = u.pm * BM + wr * 64 + fr; const int cw = wc * 32 + 8 * fq
template <int ACT>
__device__ __forceinline__ void store_act(const f32x4 (&acc)[2][2][4][2], bf16_t* O, int ldc, int colt, int row0, int cw, float sc = 1.f) {
#pragma unroll
    for (int ai = 0; ai < 2; ++ai)
#pragma unroll
        for (int m = 0; m < 4; ++m) { bf16_t* rowp = O + (unsigned)((row0 + ai * HALF + m * 16) * ldc + colt + cw);
#pragma unroll
            for (int bj = 0; bj < 2; ++bj) { f32x4 v0 = acc[ai][bj][m][0] * sc, v1 = acc[ai][bj][m][1] * sc;
                if (ACT != 0) asm volatile("" : "+v"(v0[0]), "+v"(v0[1]), "+v"(v0[2]), "+v"(v0[3]), "+v"(v1[0]), "+v"(v1[1]), "+v"(v1[2]), "+v"(v1[3]) :: "memory");
                if (ACT == 1) {
#pragma unroll
                    for (int e = 0; e < 4; ++e) { v0[e] = gelu_tanh(v0[e]); v1[e] = gelu_tanh(v1[e]); } }
                if (ACT == 2) {
#pragma unroll
                    for (int e = 0; e < 4; ++e) { v0[e] = sigmoidf(v0[e]); v1[e] = sigmoidf(v1[e]); } }
                *(u32x4*)(rowp + bj * HALF) = pack8(v0, v1);
 } }
}
struct EpiPlain { bf16_t* O; int ldc;
    __device__ __forceinline__ void operator()(const f32x4 (&acc)[2][2][4][2], const Unit& u, int wr, int wc, int fr, int fq) const { EPI_ROWS(); store_act<0>(acc, O, ldc, u.pn * BM, row0, cw); } };
struct EpiInProj { bf16_t *Q, *K, *V, *U, *GV, *GA, *GB; float* KMP; const float2* rope; int kmode; float ascale;
    __device__ __forceinline__ void operator()(const f32x4 (&acc)[2][2][4][2], const Unit& u, int wr, int wc, int fr, int fq) const {
        EPI_ROWS(); const int pn = u.pn;
        if (kmode || pn < 2) {
            const bool isk = kmode != 0; bf16_t* O = isk ? K : Q; const float sc = isk ? 1.f : C2M; const int ct = (pn & 1) * 256;
            const int i0 = ((wc & 1) * 32 + 8 * fq) >> 1;
            f32x4 ks[2][2];
#pragma unroll
            for (int bj = 0; bj < 2; ++bj) { ks[bj][0] = (f32x4){0.f, 0.f, 0.f, 0.f}; ks[bj][1] = (f32x4){0.f, 0.f, 0.f, 0.f}; }
            f32x4 tt[2][4][2];
#pragma unroll
            for (int ai = 0; ai < 2; ++ai)
#pragma unroll
                for (int m = 0; m < 4; ++m) { const int pos = (row0 + ai * HALF + m * 16) & (SEQ - 1); tt[ai][m][0] = *(const f32x4*)(rope + pos * 32 + i0); tt[ai][m][1] = *(const f32x4*)(rope + pos * 32 + i0 + 2); }
#pragma unroll
            for (int ai = 0; ai < 2; ++ai)
#pragma unroll
                for (int m = 0; m < 4; ++m) { const int r = row0 + ai * HALF + m * 16;
                    const f32x4 t0 = tt[ai][m][0], t1 = tt[ai][m][1];
#pragma unroll
                    for (int bj = 0; bj < 2; ++bj) { const f32x4 v0 = acc[ai][bj][m][0] * ascale, v1 = acc[ai][bj][m][1] * ascale; f32x4 o0, o1;
                        o0[0] = v0[0] * t0[0] - v0[1] * t0[1]; o0[1] = v0[1] * t0[0] + v0[0] * t0[1];
                        o0[2] = v0[2] * t0[2] - v0[3] * t0[3]; o0[3] = v0[3] * t0[2] + v0[2] * t0[3];
                        o1[0] = v1[0] * t1[0] - v1[1] * t1[1]; o1[1] = v1[1] * t1[0] + v1[0] * t1[1];
                        o1[2] = v1[2] * t1[2] - v1[3] * t1[3]; o1[3] = v1[3] * t1[2] + v1[2] * t1[3];
                        if (isk) { ks[bj][0] += o0; ks[bj][1] += o1; }
                        if (isk) *(uint2*)((unsigned char*)O + (unsigned)(r * 512 + ct + bj * HALF + cw)) = pack8f8(o0, o1);
                        else *(u32x4*)(O + (unsigned)(r * 512 + ct + bj * HALF + cw)) = pack8(o0 * sc, o1 * sc); } }
            if (isk) {
#pragma unroll
                for (int bj = 0; bj < 2; ++bj)
#pragma unroll
                    for (int n = 0; n < 2; ++n)
#pragma unroll
                        for (int e = 0; e < 4; ++e) { float v = ks[bj][n][e]; v += __shfl_xor(v, 1); v += __shfl_xor(v, 2); v += __shfl_xor(v, 4); v += __shfl_xor(v, 8); ks[bj][n][e] = v; }
                if (fr == 0) {
#pragma unroll
                    for (int bj = 0; bj < 2; ++bj)
#pragma unroll
                        for (int n = 0; n < 2; ++n) *(f32x4*)(KMP + ((size_t)u.pm * 2 + wr) * 512 + ct + bj * HALF + cw + 4 * n) = ks[bj][n]; }
            }
        } else store_act<1>(acc, U, 512, (pn - 2) * BM, row0, cw);
    } };
struct EpiGate8 { unsigned char *GA, *GB; bf16_t *V, *GV; EpiInProj KE;
    __device__ __forceinline__ void operator()(const f32x4 (&acc)[2][2][4][2], const Unit& u, int wr, int wc, int fr, int fq) const {
        if (u.pn >= 12) { Unit uk = u; uk.pn = u.pn - 12; KE(acc, uk, wr, wc, fr, fq); return; }
        EPI_ROWS();
        if (u.pn >= 10) { store_act<1>(acc, GV, 512, (u.pn - 10) * BM, row0, cw, 1.f / WG8_SCALE); return; }
        if (u.pn >= 8) {
#pragma unroll
            for (int ai = 0; ai < 2; ++ai)
#pragma unroll
                for (int m = 0; m < 4; ++m)
#pragma unroll
                    for (int bj = 0; bj < 2; ++bj)
                        *(uint2*)((unsigned char*)V + (unsigned)((row0 + ai * HALF + m * 16) * 512 + (u.pn - 8) * BM + cw + bj * HALF)) = pack8f8(acc[ai][bj][m][0] * (1.f / WG8_SCALE), acc[ai][bj][m][1] * (1.f / WG8_SCALE));
            return; }
        unsigned char* G8 = u.pn < 4 ? GA : GB; const int colt = (u.pn & 3) * BM;
#pragma unroll
        for (int ai = 0; ai < 2; ++ai)
#pragma unroll
            for (int m = 0; m < 4; ++m) { unsigned char* rowp = G8 + (unsigned)((row0 + ai * HALF + m * 16) * 1024 + colt + cw);
#pragma unroll
                for (int bj = 0; bj < 2; ++bj) { f32x4 v0 = acc[ai][bj][m][0], v1 = acc[ai][bj][m][1];
                    asm volatile("" : "+v"(v0[0]), "+v"(v0[1]), "+v"(v0[2]), "+v"(v0[3]), "+v"(v1[0]), "+v"(v1[1]), "+v"(v1[2]), "+v"(v1[3]) :: "memory");
                    unsigned w0 = 0u, w1 = 0u;
#pragma unroll
                    for (int e = 0; e < 4; ++e) {
                        constexpr float K1 = -1.4426950409f / WG8_SCALE, C255 = 1.f / 255.f;
                        const float q0 = __builtin_amdgcn_rcpf(__builtin_fmaf(__builtin_amdgcn_exp2f(v0[e] * K1), C255, C255)), q1 = __builtin_amdgcn_rcpf(__builtin_fmaf(__builtin_amdgcn_exp2f(v1[e] * K1), C255, C255));
                        w0 = __builtin_amdgcn_cvt_pk_u8_f32(fmaxf(q0, 1.f), e, w0); w1 = __builtin_amdgcn_cvt_pk_u8_f32(fmaxf(q1, 1.f), e, w1); }
                    *(uint2*)(rowp + bj * HALF) = make_uint2(w0, w1); } }
    } };
struct EpiMerged { const bf16_t *GA, *GB; bf16_t* MG;
    __device__ __forceinline__ void operator()(const f32x4 (&acc)[2][2][4][2], const Unit& u, int wr, int wc, int fr, int fq) const {
        EPI_ROWS(); const bf16_t* G = u.var ? GB : GA;
#pragma unroll
        for (int ai = 0; ai < 2; ++ai) {
            u32x4 gq[4][2], pq[4][2];
#pragma unroll
            for (int m = 0; m < 4; ++m)
#pragma unroll
                for (int bj = 0; bj < 2; ++bj) { const size_t off = (size_t)(row0 + ai * HALF + m * 16) * 1024 + u.pn * BM + cw + bj * HALF; gq[m][bj] = *(const u32x4*)(G + off); if (u.var) pq[m][bj] = *(const u32x4*)(MG + off); }
#pragma unroll
            for (int m = 0; m < 4; ++m)
#pragma unroll
                for (int bj = 0; bj < 2; ++bj) { const size_t off = (size_t)(row0 + ai * HALF + m * 16) * 1024 + u.pn * BM + cw + bj * HALF; f32x4 g0, g1; unpack8(gq[m][bj], g0, g1);
                    f32x4 v0 = acc[ai][bj][m][0] * g0, v1 = acc[ai][bj][m][1] * g1;
                    if (u.var) { f32x4 p0, p1; unpack8(pq[m][bj], p0, p1); v0 += p0; v1 += p1; }
                    *(u32x4*)(MG + off) = pack8(v0, v1); }
        }
    } };
struct EpiMergedFused { const unsigned char *GA, *GB; bf16_t* MG;
    static __device__ __forceinline__ void ub8(const uint2 w, f32x4& a, f32x4& b) {
        a[0] = (float)(w.x & 0xffu); a[1] = (float)((w.x >> 8) & 0xffu); a[2] = (float)((w.x >> 16) & 0xffu); a[3] = (float)(w.x >> 24);
        b[0] = (float)(w.y & 0xffu); b[1] = (float)((w.y >> 8) & 0xffu); b[2] = (float)((w.y >> 16) & 0xffu); b[3] = (float)(w.y >> 24); }
    __device__ __forceinline__ void mid(f32x4 (&acc)[2][2][4][2], const Unit& u, int wr, int wc, int fr, int fq) const {
        EPI_ROWS();
#pragma unroll
        for (int ai = 0; ai < 2; ++ai)
#pragma unroll
            for (int mh = 0; mh < 2; ++mh) {
                uint2 ga[2][2], gb[2][2];
#pragma unroll
                for (int mm = 0; mm < 2; ++mm)
#pragma unroll
                    for (int bj = 0; bj < 2; ++bj) { const unsigned off = (unsigned)((row0 + ai * HALF + (mh * 2 + mm) * 16) * 1024 + u.pn * BM + cw + bj * HALF); ga[mm][bj] = *(const uint2*)(GA + off); gb[mm][bj] = *(const uint2*)(GB + off); }
#pragma unroll
                for (int mm = 0; mm < 2; ++mm)
#pragma unroll
                    for (int bj = 0; bj < 2; ++bj) { const int m = mh * 2 + mm; f32x4 a0, a1, b0, b1; ub8(ga[mm][bj], a0, a1); ub8(gb[mm][bj], b0, b1);
#pragma unroll
                        for (int e = 0; e < 4; ++e) { acc[ai][bj][m][0][e] *= a0[e] * __builtin_amdgcn_rcpf(b0[e]); acc[ai][bj][m][1][e] *= a1[e] * __builtin_amdgcn_rcpf(b1[e]); } }
                asm volatile("" ::: "memory");
            }
    }
    __device__ __forceinline__ void operator()(const f32x4 (&acc)[2][2][4][2], const Unit& u, int wr, int wc, int fr, int fq) const {
        EPI_ROWS();
#pragma unroll
        for (int ai = 0; ai < 2; ++ai) {
            uint2 gb[4][2];
#pragma unroll
            for (int m = 0; m < 4; ++m)
#pragma unroll
                for (int bj = 0; bj < 2; ++bj) gb[m][bj] = *(const uint2*)(GB + (unsigned)((row0 + ai * HALF + m * 16) * 1024 + u.pn * BM + cw + bj * HALF));
#pragma unroll
            for (int m = 0; m < 4; ++m)
#pragma unroll
                for (int bj = 0; bj < 2; ++bj) { f32x4 b0, b1; ub8(gb[m][bj], b0, b1);
                    *(u32x4*)(MG + (size_t)(row0 + ai * HALF + m * 16) * 1024 + u.pn * BM + cw + bj * HALF) = pack8(acc[ai][bj][m][0] * (b0 * (1.f / 255.f)), acc[ai][bj][m][1] * (b1 * (1.f / 255.f))); }
        }
    } };
template <int RESBF> struct EpiResid { const float* res; const bf16_t* XNR; bf16_t* XB; float* SS;
    __device__ __forceinline__ void operator()(const f32x4 (&acc)[2][2][4][2], const Unit& u, int wr, int wc, int fr, int fq) const {
        EPI_ROWS();
#pragma unroll
        for (int ai = 0; ai < 2; ++ai) {
            f32x4 xr[4][2][2];
#pragma unroll
            for (int m = 0; m < 4; ++m)
#pragma unroll
                for (int bj = 0; bj < 2; ++bj) { const size_t off = (size_t)(row0 + ai * HALF + m * 16) * 1024 + u.pn * BM + cw + bj * HALF;
                    if (RESBF) { const u32x4 w = *(const u32x4*)((RESBF == 2 ? XNR : XB) + off); xr[m][bj][0] = __builtin_bit_cast(f32x4, w); }
                    else { xr[m][bj][0] = *(const f32x4*)(res + off); xr[m][bj][1] = *(const f32x4*)(res + off + 4); } }
#pragma unroll
            for (int m = 0; m < 4; ++m) { const int r = row0 + ai * HALF + m * 16; float ss = 0.f; const float rsc = RESBF == 2 ? res[r] : 1.f;
#pragma unroll
                for (int bj = 0; bj < 2; ++bj) { const size_t off = (size_t)r * 1024 + u.pn * BM + cw + bj * HALF; f32x4 x0, x1;
                    if (RESBF) { unpack8(__builtin_bit_cast(u32x4, xr[m][bj][0]), x0, x1); if (RESBF == 2) { x0 *= rsc; x1 *= rsc; } } else { x0 = xr[m][bj][0]; x1 = xr[m][bj][1]; }
                    const f32x4 v0 = acc[ai][bj][m][0] + x0, v1 = acc[ai][bj][m][1] + x1;
                    *(u32x4*)(XB + off) = pack8(v0, v1);
                    ss += (v0[0] * v0[0] + v0[1] * v0[1]) + (v0[2] * v0[2] + v0[3] * v0[3]) + (v1[0] * v1[0] + v1[1] * v1[1]) + (v1[2] * v1[2] + v1[3] * v1[3]); }
                ss += __shfl_xor(ss, 16); ss += __shfl_xor(ss, 32);
                if (fq == 0) SS[(size_t)r * 16 + u.pn * 4 + wc] = ss; }
        }
    } };
struct EpiRowScale { bf16_t* O; int ldc; const float* SS; float cscale;
    __device__ __forceinline__ void operator()(const f32x4 (&acc)[2][2][4][2], const Unit& u, int wr, int wc, int fr, int fq) const {
        EPI_ROWS();
        f32x4 sq[2][4];
#pragma unroll
        for (int ai = 0; ai < 2; ++ai)
#pragma unroll
            for (int m = 0; m < 4; ++m) sq[ai][m] = *(const f32x4*)(SS + (size_t)(row0 + ai * HALF + m * 16) * 16 + 4 * fq);
#pragma unroll
        for (int ai = 0; ai < 2; ++ai)
#pragma unroll
            for (int m = 0; m < 4; ++m) { const int r = row0 + ai * HALF + m * 16; const f32x4 s4 = sq[ai][m];
                float st = (s4[0] + s4[1]) + (s4[2] + s4[3]); st += __shfl_xor(st, 16); st += __shfl_xor(st, 32);
                const float rs = rsqrtf(st * (1.f / DM) + EPS) * cscale;
                bf16_t* rowp = O + (size_t)r * ldc + u.pn * BM + cw;
#pragma unroll
                for (int bj = 0; bj < 2; ++bj) *(u32x4*)(rowp + bj * HALF) = pack8(acc[ai][bj][m][0] * rs, acc[ai][bj][m][1] * rs); }
    } };
#undef EPI_ROWS
}


namespace att {
typedef unsigned u32x4 __attribute__((ext_vector_type(4)));
typedef float f32x4 __attribute__((ext_vector_type(4)));
typedef short bf16x8 __attribute__((ext_vector_type(8)));
typedef short s16x4 __attribute__((ext_vector_type(4)));
typedef float f32x16 __attribute__((ext_vector_type(16)));
typedef float f32x8 __attribute__((ext_vector_type(8)));
typedef float f32x2 __attribute__((ext_vector_type(2)));
#define KSWZ(row, colB) ((row) * 256 + ((colB) ^ (((row) & 7) << 4)))
#define SBAR() __builtin_amdgcn_sched_barrier(0)
constexpr float THR2 = 8.f;
__device__ __forceinline__ int crow(int r, int hi) { return (r & 3) + 8 * (r >> 2) + 4 * hi; }
__device__ __forceinline__ unsigned cvtpk(float lo, float hi) { return pg8::cvt_pk_bf16(lo, hi); }
template <bool SWAPK>
__device__ __forceinline__ void softmax_tile(f32x16& p0, f32x16& p1, float& m_reg, float& l_reg, float& alpha, f32x16& negm, bool first, bf16x8& pa0, bf16x8& pa1, bf16x8& pa2, bf16x8& pa3) {
    float pmax = p0[0];
#pragma unroll
    for (int r = 1; r < 16; ++r) pmax = fmaxf(pmax, p0[r]);
#pragma unroll
    for (int r = 0; r < 16; ++r) pmax = fmaxf(pmax, p1[r]);
    { auto rr = __builtin_amdgcn_permlane32_swap(__float_as_uint(pmax), __float_as_uint(pmax), false, false); pmax = fmaxf(__uint_as_float(rr[0]), __uint_as_float(rr[1])); }
    alpha = 1.f;
    if (first || !__all(pmax <= THR2)) {
        const float d = first ? pmax : fmaxf(pmax, 0.f);
        m_reg += d; alpha = first ? 1.f : __builtin_amdgcn_exp2f(-d);
#pragma unroll
        for (int r = 0; r < 16; ++r) { p0[r] -= d; p1[r] -= d; negm[r] = -m_reg; }
    }
#pragma unroll
    for (int r = 0; r < 16; ++r) { p0[r] = __builtin_amdgcn_exp2f(p0[r]); p1[r] = __builtin_amdgcn_exp2f(p1[r]); }
    float ps;
    { const f32x16 s16 = p0 + p1;
      const f32x8 s8 = s16.lo + s16.hi; const f32x4 s4 = s8.lo + s8.hi; const f32x2 s2 = s4.lo + s4.hi; ps = s2[0] + s2[1]; }
    { auto rr = __builtin_amdgcn_permlane32_swap(__float_as_uint(ps), __float_as_uint(ps), false, false); ps = __uint_as_float(rr[0]) + __uint_as_float(rr[1]); }
    l_reg = l_reg * alpha + ps;
#define PK4(P, BASE, OUT) do { unsigned a0 = cvtpk(P[BASE + 0], P[BASE + 1]), a1 = cvtpk(P[BASE + 2], P[BASE + 3]); \
    unsigned b0 = cvtpk(P[BASE + 4], P[BASE + 5]), b1 = cvtpk(P[BASE + 6], P[BASE + 7]); \
    auto r0 = __builtin_amdgcn_permlane32_swap(a0, b0, false, false); auto r1 = __builtin_amdgcn_permlane32_swap(a1, b1, false, false); \
    u32x4 w = {r0[0], r1[0], r0[1], r1[1]}; OUT = __builtin_bit_cast(bf16x8, w); } while (0)
#define PKD(P, BASE, OUT) do { u32x4 w = {cvtpk(P[BASE + 0], P[BASE + 1]), cvtpk(P[BASE + 2], P[BASE + 3]), cvtpk(P[BASE + 4], P[BASE + 5]), cvtpk(P[BASE + 6], P[BASE + 7])}; OUT = __builtin_bit_cast(bf16x8, w); } while (0)
    if (SWAPK) { PK4(p0, 0, pa0); PK4(p0, 8, pa1); PK4(p1, 0, pa2); PK4(p1, 8, pa3); }
    else { PKD(p0, 0, pa0); PKD(p0, 8, pa1); PKD(p1, 0, pa2); PKD(p1, 8, pa3); }
#undef PKD
#undef PK4
}
__device__ __forceinline__ void qkt128(f32x16& p0, f32x16& p1, const LAS unsigned char* Ks, const bf16x8* qr, const f32x16& negm, int r32, int hi) {
    p0 = negm; p1 = negm;
#pragma unroll
    for (int d0 = 0; d0 < 8; ++d0) { const int cb = (d0 * 16 + hi * 8) * 2;
        const bf16x8 b0 = *(const LAS bf16x8*)(Ks + KSWZ(r32, cb)); const bf16x8 b1 = *(const LAS bf16x8*)(Ks + KSWZ(32 + r32, cb));
        p0 = __builtin_amdgcn_mfma_f32_32x32x16_bf16(b0, qr[d0], p0, 0, 0, 0); p1 = __builtin_amdgcn_mfma_f32_32x32x16_bf16(b1, qr[d0], p1, 0, 0, 0); }
}
__device__ __forceinline__ int v_st(int k, int c) { const int kk = (k & ~0xC) | ((k & 4) << 1) | ((k & 8) >> 1); return ((kk >> 3) * 4 + (c >> 5)) * 512 + ((kk & 7) * 32 + (c & 31)) * 2; }
__device__ __forceinline__ int v_rd_base(int lane) { return ((lane & 3) << 3) | (((lane >> 2) & 3) << 6) | (((lane >> 4) & 1) << 5) | (((lane >> 5) & 1) << 8); }
constexpr int v_rd_off(int d0, int ks, int half) { return d0 * 512 + ks * 4096 + half * 2048; }
template <int OFF> __device__ __forceinline__ s16x4 tr_read(int vb) { s16x4 r; asm volatile("ds_read_b64_tr_b16 %0, %1 offset:%2" : "=&v"(r) : "v"(vb), "i"(OFF) : "memory"); return r; }
template <int D0> __device__ __forceinline__ void pv_one(f32x16& od, int vb, bf16x8 pa0, bf16x8 pa1, bf16x8 pa2, bf16x8 pa3) {
    const s16x4 l0 = tr_read<v_rd_off(D0, 0, 0)>(vb), h0 = tr_read<v_rd_off(D0, 0, 1)>(vb), l1 = tr_read<v_rd_off(D0, 1, 0)>(vb), h1 = tr_read<v_rd_off(D0, 1, 1)>(vb);
    const s16x4 l2 = tr_read<v_rd_off(D0, 2, 0)>(vb), h2 = tr_read<v_rd_off(D0, 2, 1)>(vb), l3 = tr_read<v_rd_off(D0, 3, 0)>(vb), h3 = tr_read<v_rd_off(D0, 3, 1)>(vb);
    asm volatile("s_waitcnt lgkmcnt(0)" ::: "memory"); SBAR();
#define PK(L, H) (bf16x8){L[0], L[1], L[2], L[3], H[0], H[1], H[2], H[3]}
    od = __builtin_amdgcn_mfma_f32_32x32x16_bf16(pa0, PK(l0, h0), od, 0, 0, 0);
    od = __builtin_amdgcn_mfma_f32_32x32x16_bf16(pa1, PK(l1, h1), od, 0, 0, 0);
    od = __builtin_amdgcn_mfma_f32_32x32x16_bf16(pa2, PK(l2, h2), od, 0, 0, 0);
    od = __builtin_amdgcn_mfma_f32_32x32x16_bf16(pa3, PK(l3, h3), od, 0, 0, 0);
#undef PK
}

__device__ __forceinline__ void qkt64(f32x16& p0, f32x16& p1, const LAS unsigned char* Kt, const bf16x8* qr, const f32x16& negm, int r32, int hi) {
    const LAS unsigned char* kb = Kt + hi * 1024 + r32 * 16;
    p0 = negm; p1 = negm;
#pragma unroll
    for (int d0 = 0; d0 < 4; ++d0) { const bf16x8 b0 = *(const LAS bf16x8*)(kb + d0 * 2048), b1 = *(const LAS bf16x8*)(kb + d0 * 2048 + 512);
        p0 = __builtin_amdgcn_mfma_f32_32x32x16_bf16(b0, qr[d0], p0, 0, 0, 0); p1 = __builtin_amdgcn_mfma_f32_32x32x16_bf16(b1, qr[d0], p1, 0, 0, 0); }
}
template <int D0> __device__ __forceinline__ void pv64_one(f32x16& od, int vb, bf16x8 pa0, bf16x8 pa1, bf16x8 pa2, bf16x8 pa3) {
    const s16x4 l0 = tr_read<D0 * 4096 + 0>(vb), h0 = tr_read<D0 * 4096 + 512>(vb), l1 = tr_read<D0 * 4096 + 1024>(vb), h1 = tr_read<D0 * 4096 + 1536>(vb);
    const s16x4 l2 = tr_read<D0 * 4096 + 2048>(vb), h2 = tr_read<D0 * 4096 + 2560>(vb), l3 = tr_read<D0 * 4096 + 3072>(vb), h3 = tr_read<D0 * 4096 + 3584>(vb);
    asm volatile("s_waitcnt lgkmcnt(0)" ::: "memory"); SBAR();
#define PK(L, H) (bf16x8){L[0], L[1], L[2], L[3], H[0], H[1], H[2], H[3]}
    od = __builtin_amdgcn_mfma_f32_32x32x16_bf16(pa0, PK(l0, h0), od, 0, 0, 0);
    od = __builtin_amdgcn_mfma_f32_32x32x16_bf16(pa1, PK(l1, h1), od, 0, 0, 0);
    od = __builtin_amdgcn_mfma_f32_32x32x16_bf16(pa2, PK(l2, h2), od, 0, 0, 0);
    od = __builtin_amdgcn_mfma_f32_32x32x16_bf16(pa3, PK(l3, h3), od, 0, 0, 0);
#undef PK
}
constexpr int MB_K = 0, MB_V = 32768, MB_LIST = 65536, MB_WS = 81920, MB_MISC = 90112, MB_STG = 91136;
struct KVRegs { uint2 k[4], v[4]; };
typedef float f32x2_kv __attribute__((ext_vector_type(2)));
__device__ __forceinline__ u32x4 f8x8_to_bf16x8(const uint2 w) {
    const f32x2_kv a = __builtin_amdgcn_cvt_pk_f32_fp8((int)w.x, false), b = __builtin_amdgcn_cvt_pk_f32_fp8((int)w.x, true), c = __builtin_amdgcn_cvt_pk_f32_fp8((int)w.y, false), d = __builtin_amdgcn_cvt_pk_f32_fp8((int)w.y, true);
    return (u32x4){pk2(a.x, a.y), pk2(b.x, b.y), pk2(c.x, c.y), pk2(d.x, d.y)}; }
__device__ __forceinline__ void moba_kv_load(KVRegs& R, const bf16_t* K, const bf16_t* V, size_t row0, int h, int tid) {
    const unsigned char* K8 = (const unsigned char*)K; const unsigned char* V8 = (const unsigned char*)V;
#pragma unroll
    for (int i = 0; i < 4; ++i) { const int key = tid & 255, ch = (tid >> 8) + 2 * i; R.k[i] = *(const uint2*)(K8 + (row0 + key) * 512 + h * 64 + ch * 8); }
#pragma unroll
    for (int i = 0; i < 4; ++i) { const int pc = tid + 512 * i, key = pc >> 3, c8 = pc & 7; R.v[i] = *(const uint2*)(V8 + (row0 + key) * 512 + h * 64 + c8 * 8); }
}
__device__ __forceinline__ void moba_kv_store(LAS unsigned char* lds, const KVRegs& R, int tid) {
#pragma unroll
    for (int i = 0; i < 4; ++i) { const int key = tid & 255, ch = (tid >> 8) + 2 * i;
        *(LAS u32x4*)(lds + MB_K + (key >> 6) * 8192 + ch * 1024 + (key & 63) * 16) = f8x8_to_bf16x8(R.k[i]); }
#pragma unroll
    for (int i = 0; i < 4; ++i) { const int pc = tid + 512 * i, key = pc >> 3, c8 = pc & 7;
        *(LAS u32x4*)(lds + MB_V + (key >> 6) * 8192 + (c8 >> 2) * 4096 + ((key >> 4) & 3) * 1024 + (key & 15) * 64 + (c8 & 3) * 16) = f8x8_to_bf16x8(R.v[i]); }
}
__device__ __forceinline__ void rescale_o2(f32x16 (&o)[2], float alpha, LAS float* wsf, int r32, int hi) {
    if (__any(alpha < 1.f)) { if (hi == 0) wsf[r32] = alpha; asm volatile("s_waitcnt lgkmcnt(0)" ::: "memory");
#pragma unroll
        for (int r = 0; r < 16; ++r) { const float al = wsf[crow(r, hi)]; o[0][r] *= al; o[1][r] *= al; }
        asm volatile("s_waitcnt lgkmcnt(0)" ::: "memory"); }
}
__device__ __forceinline__ void top3_insert(float v, int i, float& v0, int& i0, float& v1, int& i1, float& v2, int& i2) {
    const bool g0 = v > v0, g1 = v > v1, g2 = v > v2;
    v2 = g1 ? v1 : (g2 ? v : v2); i2 = g1 ? i1 : (g2 ? i : i2);
    v1 = g0 ? v0 : (g1 ? v : v1); i1 = g0 ? i0 : (g1 ? i : i1);
    v0 = g0 ? v : v0; i0 = g0 ? i : i0;
}
__device__ __forceinline__ void sel_phase(const bf16_t* __restrict__ Q, const float* __restrict__ KMP, signed char* __restrict__ SEL) {
    const int tid = threadIdx.x, lane = tid & 63, wid = tid >> 6, r32 = lane & 31, hi = lane >> 5;
    const int gw = blockIdx.x * 8 + wid, NGW = gridDim.x * 8;
    for (int wu = gw; wu < 64 * 32; wu += NGW) {
        const int bh = wu & 63, qb = wu >> 6, b = bh >> 3, h = bh & 7;
        if (qb == 0) {
#pragma unroll
            for (int g = 0; g < 4; ++g) ((unsigned*)SEL)[(size_t)(b * 8 + h) * SEQ + g * 64 + lane] = 0xffffffffu;
            continue;
        }
        bf16x8 ka[4];
        { const float* kp = KMP + (size_t)(b * 32 + r32) * 1024 + h * 64 + hi * 8;
#pragma unroll
          for (int ks = 0; ks < 4; ++ks) { const f32x4 a0 = *(const f32x4*)(kp + ks * 16), a1 = *(const f32x4*)(kp + ks * 16 + 4), c0 = *(const f32x4*)(kp + 512 + ks * 16), c1 = *(const f32x4*)(kp + 512 + ks * 16 + 4);
              const f32x4 s0 = (a0 + c0) * (1.f / 256.f), s1 = (a1 + c1) * (1.f / 256.f);
              const u32x4 w = {cvtpk(s0[0], s0[1]), cvtpk(s0[2], s0[3]), cvtpk(s1[0], s1[1]), cvtpk(s1[2], s1[3])}; ka[ks] = __builtin_bit_cast(bf16x8, w); } }
#pragma unroll 1
        for (int gp = 0; gp < 2; ++gp) {
            bf16x8 qf[4][4];
#pragma unroll
            for (int g = 0; g < 4; ++g)
#pragma unroll
                for (int ks = 0; ks < 4; ++ks) qf[g][ks] = *(const bf16x8*)(Q + ((size_t)b * SEQ + qb * 256 + (gp * 4 + g) * 32 + r32) * 512 + h * 64 + ks * 16 + hi * 8);
#pragma unroll
            for (int g = 0; g < 4; ++g) {
                f32x16 acc = {};
#pragma unroll
                for (int ks = 0; ks < 4; ++ks) acc = __builtin_amdgcn_mfma_f32_32x32x16_bf16(ka[ks], qf[g][ks], acc, 0, 0, 0);
                float v0 = -3e38f, v1 = -3e38f, v2 = -3e38f; int i0 = -1, i1 = -1, i2 = -1;
#pragma unroll
                for (int r = 0; r < 16; ++r) { const int n = crow(r, hi); if (n < qb) top3_insert(acc[r], n, v0, i0, v1, i1, v2, i2); }
                float pv[3] = {v0, v1, v2}; int pi[3] = {i0, i1, i2};
#pragma unroll
                for (int k = 0; k < 3; ++k) { auto rv = __builtin_amdgcn_permlane32_swap(__float_as_uint(pv[k]), __float_as_uint(pv[k]), false, false); auto ri = __builtin_amdgcn_permlane32_swap((unsigned)pi[k], (unsigned)pi[k], false, false);
                    const float ov = __uint_as_float(hi ? rv[0] : rv[1]); const int oi = (int)(hi ? ri[0] : ri[1]);
                    if (oi >= 0) top3_insert(ov, oi, v0, i0, v1, i1, v2, i2); }
                if (hi == 0) ((unsigned*)SEL)[(size_t)(b * 8 + h) * SEQ + qb * 256 + (gp * 4 + g) * 32 + r32] = (unsigned)(i0 & 0xff) | ((unsigned)(i1 & 0xff) << 8) | ((unsigned)(i2 & 0xff) << 16) | 0xff000000u;
            }
        }
    }
}
__device__ __forceinline__ void moba_sel_phase(LAS unsigned char* lds, const bf16_t* Q, const bf16_t* K, const bf16_t* V, const signed char* SEL, bf16_t* PART, float* ML, unsigned* qctr) {
    const int tid = threadIdx.x, wid = tid >> 6, lane = tid & 63, r32 = lane & 31, hi = lane >> 5;
    LAS float* wsf = (LAS float*)(lds + MB_WS + wid * 1024); LAS int* wsd = (LAS int*)(wsf + 64);
    LAS unsigned* misc = (LAS unsigned*)(lds + MB_MISC); LAS unsigned short* list = (LAS unsigned short*)(lds + MB_LIST);
    const int vb0 = (int)(uintptr_t)(lds + MB_V) + ((lane >> 4) & 1) * 32 + (lane & 3) * 8 + (4 * hi + ((lane & 15) >> 2)) * 64;
    constexpr int NU = 31 * 64;
    if (tid == 0) misc[2] = __hip_atomic_fetch_add(qctr, 1u, __ATOMIC_RELAXED, __HIP_MEMORY_SCOPE_AGENT);
    __syncthreads();
    int u = (int)misc[2];
    KVRegs R;
    if (u < NU) moba_kv_load(R, K, V, (size_t)((u & 63) >> 3) * SEQ + (size_t)(u >> 6) * 256, u & 7, tid);
    if (tid == 0) misc[4] = 0u;
    int par = 0;
    while (u < NU) {
        const int n = u >> 6, bh = u & 63, b = bh >> 3, h = bh & 7;
        __syncthreads();
        moba_kv_store(lds, R, tid);
        if (tid == 0) misc[2] = __hip_atomic_fetch_add(qctr, 1u, __ATOMIC_RELAXED, __HIP_MEMORY_SCOPE_AGENT);
        unsigned sv[16];
#pragma unroll
        for (int i = 0; i < 16; ++i) { const int pos = 256 * (n + 1) + i * 512 + tid; sv[i] = ((const unsigned*)SEL)[(size_t)(b * 8 + h) * SEQ + (pos < SEQ ? pos : SEQ - 1)]; }
        int wtot = 0;
#pragma unroll
        for (int i = 0; i < 16; ++i) { const int pos = 256 * (n + 1) + i * 512 + tid;
            const bool hit = pos < SEQ && ((sv[i] & 0xff) == (unsigned)n || ((sv[i] >> 8) & 0xff) == (unsigned)n || ((sv[i] >> 16) & 0xff) == (unsigned)n);
            wtot += __popcll(__ballot(hit)); }
        unsigned off = 0; if (lane == 0 && wtot) off = __hip_atomic_fetch_add(misc + 4 + par, (unsigned)wtot, __ATOMIC_RELAXED, __HIP_MEMORY_SCOPE_WORKGROUP);
        off = __builtin_amdgcn_readfirstlane(off);
#pragma unroll
        for (int i = 0; i < 16; ++i) { const int pos = 256 * (n + 1) + i * 512 + tid;
            const int slot = pos >= SEQ ? -1 : ((sv[i] & 0xff) == (unsigned)n) ? 0 : (((sv[i] >> 8) & 0xff) == (unsigned)n) ? 1 : (((sv[i] >> 16) & 0xff) == (unsigned)n) ? 2 : -1;
            const unsigned long long bal = __ballot(slot >= 0);
            if (slot >= 0) list[off + __popcll(bal & ((1ull << lane) - 1ull))] = (unsigned short)((pos << 2) | slot);
            off += (unsigned)__popcll(bal); }
        __syncthreads();
        if (tid == 0) misc[5 - par] = 0u;
        const int unext = (int)misc[2];
        if (unext < NU) moba_kv_load(R, K, V, (size_t)((unext & 63) >> 3) * SEQ + (size_t)(unext >> 6) * 256, unext & 7, tid);
        const int cnt = (int)misc[4 + par], nbatch = (cnt + 31) >> 5; par ^= 1;
        unsigned en = 0; bf16x8 qn[4];
        if (wid < nbatch) { const int li0 = wid * 32 + r32; en = list[li0 < cnt ? li0 : cnt - 1];
#pragma unroll
            for (int d0 = 0; d0 < 4; ++d0) qn[d0] = *(const bf16x8*)(Q + ((size_t)b * SEQ + (en >> 2)) * 512 + h * 64 + d0 * 16 + hi * 8); }
        for (int bt = wid; bt < nbatch; bt += 8) {
            const int li = bt * 32 + r32; const bool valid = li < cnt; const unsigned e = en;
            const int pos = e >> 2, slot = e & 3; const size_t t = (size_t)b * SEQ + pos;
            bf16x8 qr[4];
#pragma unroll
            for (int d0 = 0; d0 < 4; ++d0) qr[d0] = qn[d0];
            { const int btn = (bt + 8 < nbatch) ? bt + 8 : bt; const int lin = btn * 32 + r32; en = list[lin < cnt ? lin : cnt - 1];
#pragma unroll
              for (int d0 = 0; d0 < 4; ++d0) qn[d0] = *(const bf16x8*)(Q + ((size_t)b * SEQ + (en >> 2)) * 512 + h * 64 + d0 * 16 + hi * 8); }
            float m_reg = 0.f, l_reg = 0.f; f32x16 o[2] = {}; f32x16 negm = {};
#pragma unroll
            for (int kt = 0; kt < 4; ++kt) {
                f32x16 p0, p1; float alpha; bf16x8 pa0, pa1, pa2, pa3;
                qkt64(p0, p1, lds + MB_K + kt * 8192, qr, negm, r32, hi);
                softmax_tile<false>(p0, p1, m_reg, l_reg, alpha, negm, kt == 0, pa0, pa1, pa2, pa3);
                rescale_o2(o, alpha, wsf, r32, hi);
                pv64_one<0>(o[0], vb0 + kt * 8192, pa0, pa1, pa2, pa3); pv64_one<1>(o[1], vb0 + kt * 8192, pa0, pa1, pa2, pa3);
            }
            const int dst = valid ? (int)((t * 8 + h) * 3 + slot) : -1;
            if (hi == 0) { wsf[32 + r32] = l_reg; wsd[r32] = dst; if (valid) *(float2*)(ML + (size_t)dst * 2) = make_float2(m_reg, l_reg); }
            asm volatile("s_waitcnt lgkmcnt(0)" ::: "memory");
            LAS unsigned char* stg = lds + MB_STG + wid * 4096;
#pragma unroll
            for (int r = 0; r < 16; ++r) { const int orow = crow(r, hi); const float rl = __builtin_amdgcn_rcpf(wsf[32 + orow]);
                const unsigned w = (unsigned)__builtin_amdgcn_cvt_pk_fp8_f32(o[0][r] * rl, o[1][r] * rl, 0, false); stg[orow * 64 + r32] = (unsigned char)w; stg[orow * 64 + 32 + r32] = (unsigned char)(w >> 8); }
            asm volatile("s_waitcnt lgkmcnt(0)" ::: "memory");
#pragma unroll
            for (int i = 0; i < 2; ++i) { const int row = i * 16 + (lane >> 2), pcs = lane & 3; const u32x4 v = *(const LAS u32x4*)(stg + row * 64 + pcs * 16); const int dd = wsd[row];
                if (dd >= 0) *(u32x4*)((unsigned char*)PART + (unsigned)(dd * 64 + pcs * 16)) = v; }
            asm volatile("s_waitcnt lgkmcnt(0)" ::: "memory");
        }
        u = unext;
    }
}
__device__ __forceinline__ void moba_own_phase(LAS unsigned char* lds, const bf16_t* Q, const bf16_t* K, const bf16_t* V, const signed char* SEL, const bf16_t* PART, const float* ML, bf16_t* ATT) {
    const int tid = threadIdx.x, wid = tid >> 6, lane = tid & 63, r32 = lane & 31, hi = lane >> 5;
    LAS float* wsf = (LAS float*)(lds + MB_WS + wid * 1024);
    const int vb0 = (int)(uintptr_t)(lds + MB_V) + ((lane >> 4) & 1) * 32 + (lane & 3) * 8 + (4 * hi + ((lane & 15) >> 2)) * 64;
    KVRegs R;
    if ((int)blockIdx.x < 64 * 32) { const int u0 = blockIdx.x; moba_kv_load(R, K, V, (size_t)((u0 & 63) >> 3) * SEQ + (size_t)(u0 >> 6) * 256, u0 & 7, tid); }
    for (int u = blockIdx.x; u < 64 * 32; u += gridDim.x) {
        const int bh = u & 63, n = u >> 6, b = bh >> 3, h = bh & 7;
        __syncthreads();
        moba_kv_store(lds, R, tid);
        __syncthreads();
        const size_t t0 = (size_t)b * SEQ + (size_t)n * 256 + wid * 32, t = t0 + r32;
        bf16x8 qr[4];
#pragma unroll
        for (int d0 = 0; d0 < 4; ++d0) qr[d0] = *(const bf16x8*)(Q + t * 512 + h * 64 + d0 * 16 + hi * 8);
        uint2 pr[4][3];
#pragma unroll
        for (int i = 0; i < 2; ++i) { const int row = i * 8 + (lane >> 3), pcs = lane & 7;
#pragma unroll
            for (int q = 0; q < 3; ++q) pr[i][q] = *(const uint2*)((const unsigned char*)PART + (unsigned)(((((unsigned)t0 + row) * 8 + h) * 3 + q) * 64 + pcs * 8)); }
        const unsigned sv = ((const unsigned*)SEL)[(size_t)(b * 8 + h) * SEQ + n * 256 + wid * 32 + r32];
        float2 mlv[3];
#pragma unroll
        for (int i = 0; i < 3; ++i) mlv[i] = *(const float2*)(ML + ((t * 8 + h) * 3 + i) * 2);
        { const int un = u + gridDim.x; if (un < 64 * 32) moba_kv_load(R, K, V, (size_t)((un & 63) >> 3) * SEQ + (size_t)(un >> 6) * 256, un & 7, tid); }
        float m_reg = 0.f, l_reg = 0.f; f32x16 o[2] = {}; f32x16 negm = {};
        const int ntile = (wid >> 1) + 1, rowa = wid * 32 + r32;
#pragma unroll
        for (int kt = 0; kt < 4; ++kt) { if (kt >= ntile) break;
            f32x16 p0, p1; float alpha; bf16x8 pa0, pa1, pa2, pa3;
            qkt64(p0, p1, lds + MB_K + kt * 8192, qr, negm, r32, hi);
            if (kt == ntile - 1) {
#pragma unroll
                for (int r = 0; r < 16; ++r) { const int ka = 64 * kt + crow(r, hi); if (ka > rowa) p0[r] = -1e30f; if (ka + 32 > rowa) p1[r] = -1e30f; } }
            softmax_tile<false>(p0, p1, m_reg, l_reg, alpha, negm, kt == 0, pa0, pa1, pa2, pa3);
            rescale_o2(o, alpha, wsf, r32, hi);
            pv64_one<0>(o[0], vb0 + kt * 8192, pa0, pa1, pa2, pa3); pv64_one<1>(o[1], vb0 + kt * 8192, pa0, pa1, pa2, pa3);
        }
#pragma unroll
        for (int i = 2; i < 4; ++i) { const int row = i * 8 + (lane >> 3), pcs = lane & 7;
#pragma unroll
            for (int q = 0; q < 3; ++q) pr[i][q] = *(const uint2*)((const unsigned char*)PART + (unsigned)(((((unsigned)t0 + row) * 8 + h) * 3 + q) * 64 + pcs * 8)); }
        float mi[3], li[3]; float M = m_reg;
#pragma unroll
        for (int i = 0; i < 3; ++i) { const bool v = ((sv >> (8 * i)) & 0x80u) == 0u; mi[i] = v ? mlv[i].x : -1e30f; li[i] = v ? mlv[i].y : 0.f; M = fmaxf(M, mi[i]); }
        const float wo = __builtin_amdgcn_exp2f(m_reg - M); float L = l_reg * wo; float wi[3];
#pragma unroll
        for (int i = 0; i < 3; ++i) { wi[i] = li[i] * __builtin_amdgcn_exp2f(mi[i] - M); L += wi[i]; }
        const float rL = 1.f / L;
        if (hi == 0) { wsf[32 + r32] = wo * rL; wsf[64 + r32] = wi[0] * rL; wsf[96 + r32] = wi[1] * rL; wsf[128 + r32] = wi[2] * rL; }
        asm volatile("s_waitcnt lgkmcnt(0)" ::: "memory");
        LAS bf16_t* stg = (LAS bf16_t*)(lds + MB_STG + wid * 4096);
#pragma unroll
        for (int r = 0; r < 16; ++r) { const int orow = crow(r, hi); const float a0 = wsf[32 + orow];
            const unsigned w = pk2(o[0][r] * a0, o[1][r] * a0); stg[orow * 64 + r32] = (bf16_t)w; stg[orow * 64 + 32 + r32] = (bf16_t)(w >> 16); }
        asm volatile("s_waitcnt lgkmcnt(0)" ::: "memory");
#pragma unroll
        for (int i = 0; i < 4; ++i) { const int row = i * 8 + (lane >> 3), pcs = lane & 7;
            const u32x4 own = *(const LAS u32x4*)(stg + row * 64 + pcs * 8); const float a1 = wsf[64 + row], a2 = wsf[96 + row], a3 = wsf[128 + row];
            float v[8];
#pragma unroll
            for (int q = 0; q < 4; ++q) { v[2 * q] = __uint_as_float(own[q] << 16); v[2 * q + 1] = __uint_as_float(own[q] & 0xffff0000u); }
            float pf[3][8];
#pragma unroll
            for (int s3 = 0; s3 < 3; ++s3) { const f32x2_kv c0 = __builtin_amdgcn_cvt_pk_f32_fp8((int)pr[i][s3].x, false), c1 = __builtin_amdgcn_cvt_pk_f32_fp8((int)pr[i][s3].x, true), c2 = __builtin_amdgcn_cvt_pk_f32_fp8((int)pr[i][s3].y, false), c3 = __builtin_amdgcn_cvt_pk_f32_fp8((int)pr[i][s3].y, true);
                pf[s3][0] = c0.x; pf[s3][1] = c0.y; pf[s3][2] = c1.x; pf[s3][3] = c1.y; pf[s3][4] = c2.x; pf[s3][5] = c2.y; pf[s3][6] = c3.x; pf[s3][7] = c3.y; }
#pragma unroll
            for (int j = 0; j < 8; ++j) v[j] += (a1 != 0.f ? a1 * pf[0][j] : 0.f) + (a2 != 0.f ? a2 * pf[1][j] : 0.f) + (a3 != 0.f ? a3 * pf[2][j] : 0.f);
            *(u32x4*)(ATT + (t0 + row) * 1024 + h * 64 + pcs * 8) = (u32x4){pk2(v[0], v[1]), pk2(v[2], v[3]), pk2(v[4], v[5]), pk2(v[6], v[7])}; }
        asm volatile("s_waitcnt lgkmcnt(0)" ::: "memory");
    }
    __syncthreads();
}
__device__ __forceinline__ void gmlp_phase(LAS unsigned char* lds, const bf16_t* U, const bf16_t* GV, const bf16_t* WM, const float* ng, const float* bs, bf16_t* ATTGM) {
    const int tid = threadIdx.x, wid = tid >> 6, lane = tid & 63, r32 = lane & 31, hi = lane >> 5;
    const int tb = wid & 3, hf = wid >> 2;
    for (int c = blockIdx.x; c < T_TOK / 128; c += gridDim.x) {
        const size_t t0 = (size_t)c * 128;
        __syncthreads();
        {
            uint4 v[16];
#pragma unroll
            for (int i = 0; i < 16; ++i) v[i] = *(const uint4*)(GV + (t0 + wid * 16 + i) * 512 + lane * 8);
#pragma unroll
            for (int i = 0; i < 16; ++i) { const int sidx = wid * 16 + i;
                float f[8]; f[0] = __uint_as_float(v[i].x << 16); f[1] = __uint_as_float(v[i].x & 0xffff0000u); f[2] = __uint_as_float(v[i].y << 16); f[3] = __uint_as_float(v[i].y & 0xffff0000u);
                f[4] = __uint_as_float(v[i].z << 16); f[5] = __uint_as_float(v[i].z & 0xffff0000u); f[6] = __uint_as_float(v[i].w << 16); f[7] = __uint_as_float(v[i].w & 0xffff0000u);
                float ss = 0.f;
#pragma unroll
                for (int e = 0; e < 8; ++e) ss += f[e] * f[e];
                const float rs = rsqrtf(wave_sum(ss) * (1.f / 512.f) + EPS);
                const u32x4 w = {cvtpk(f[0] * rs, f[1] * rs), cvtpk(f[2] * rs, f[3] * rs), cvtpk(f[4] * rs, f[5] * rs), cvtpk(f[6] * rs, f[7] * rs)};
                *(LAS u32x4*)(lds + (lane >> 4) * 32768 + (sidx >> 6) * 16384 + v_st(sidx & 63, (lane & 15) * 8)) = w; }
        }
        __syncthreads();
#pragma unroll 1
        for (int slab = 0; slab < 4; ++slab) {
            const int g = slab * 2 + hf;
            bf16x8 pa[8];
#pragma unroll
            for (int ks = 0; ks < 8; ++ks) pa[ks] = *(const bf16x8*)(WM + ((size_t)(g * 128 + tb * 32 + r32)) * 128 + ks * 16 + hi * 8);
            f32x16 o[2] = {};
            const int vb = (int)(uintptr_t)lds + slab * 32768 + hf * 1024 + v_rd_base(lane);
            const int c0 = slab * 128 + hf * 64 + r32;
            const float ng0 = ng[c0], ng1 = ng[c0 + 32];
            float bbv[16]; bf16_t u0[16], u1[16];
#pragma unroll
            for (int r = 0; r < 16; ++r) { const int tt = tb * 32 + crow(r, hi); bbv[r] = bs[g * 128 + tt]; const bf16_t* up = U + (t0 + tt) * 512 + c0; u0[r] = up[0]; u1[r] = up[32]; }
#define GSTEP(KS) if ((KS) <= 2 * tb + 1) { \
                const s16x4 l0 = tr_read<((KS) >> 2) * 16384 + v_rd_off(0, (KS) & 3, 0)>(vb), h0 = tr_read<((KS) >> 2) * 16384 + v_rd_off(0, (KS) & 3, 1)>(vb); \
                const s16x4 l1 = tr_read<((KS) >> 2) * 16384 + v_rd_off(1, (KS) & 3, 0)>(vb), h1 = tr_read<((KS) >> 2) * 16384 + v_rd_off(1, (KS) & 3, 1)>(vb); \
                asm volatile("s_waitcnt lgkmcnt(0)" ::: "memory"); SBAR(); \
                o[0] = __builtin_amdgcn_mfma_f32_32x32x16_bf16(pa[KS], ((bf16x8){l0[0], l0[1], l0[2], l0[3], h0[0], h0[1], h0[2], h0[3]}), o[0], 0, 0, 0); \
                o[1] = __builtin_amdgcn_mfma_f32_32x32x16_bf16(pa[KS], ((bf16x8){l1[0], l1[1], l1[2], l1[3], h1[0], h1[1], h1[2], h1[3]}), o[1], 0, 0, 0); }
            GSTEP(0) GSTEP(1) GSTEP(2) GSTEP(3) GSTEP(4) GSTEP(5) GSTEP(6) GSTEP(7)
#undef GSTEP
#pragma unroll
            for (int r = 0; r < 16; ++r) { const int tt = tb * 32 + crow(r, hi); const float bb = bbv[r];
                bf16_t* op = ATTGM + (t0 + tt) * 1024 + 512 + c0;
                op[0] = f2bf(bf2f(u0[r]) * (o[0][r] * ng0 + bb)); op[32] = f2bf(bf2f(u1[r]) * (o[1][r] * ng1 + bb)); }
        }
    }
    __syncthreads();
}
constexpr int XA_K = 0, XA_V = 65536, XA_WS = 131072;
__device__ __forceinline__ void xattn_phase(LAS unsigned char* lds, const bf16_t* XQ, const bf16_t* XKV, bf16_t* XO) {
    const int tid = threadIdx.x, wid = tid >> 6, lane = tid & 63, r32 = lane & 31, hi = lane >> 5;
    LAS float* wsf = (LAS float*)(lds + XA_WS) + wid * 64;
    const int vb0 = (int)(uintptr_t)(lds + XA_V) + v_rd_base(lane);
    int staged = -1;
    for (int u = blockIdx.x; u < 32 * 32; u += gridDim.x) {
        const int bh = u & 31, tile = u >> 5, b = bh >> 2, h = bh & 3;
        if (bh != staged) {
            __syncthreads();
            const int sr = tid >> 4, sc = (tid & 15) * 8;
#pragma unroll
            for (int i = 0; i < 8; ++i) { const int key = i * 32 + sr; const bf16_t* src = XKV + (size_t)(b * NMEM + key) * 1024 + h * 128 + sc;
                const uint4 kv = *(const uint4*)src, vv = *(const uint4*)(src + 512);
                *(LAS u32x4*)(lds + XA_K + (key >> 6) * 16384 + KSWZ(key & 63, sc * 2)) = (u32x4){kv.x, kv.y, kv.z, kv.w};
                *(LAS u32x4*)(lds + XA_V + (key >> 6) * 16384 + v_st(key & 63, sc)) = (u32x4){vv.x, vv.y, vv.z, vv.w}; }
            __syncthreads(); staged = bh;
        }
        const size_t t0 = (size_t)b * SEQ + tile * 256 + wid * 32;
        bf16x8 qr[8];
#pragma unroll
        for (int d0 = 0; d0 < 8; ++d0) qr[d0] = *(const bf16x8*)(XQ + (t0 + r32) * 512 + h * 128 + d0 * 16 + hi * 8);
        float m_reg = 0.f, l_reg = 0.f; f32x16 o[4] = {}; f32x16 negm = {};
#pragma unroll
        for (int kt = 0; kt < 4; ++kt) {
            f32x16 p0, p1; float alpha; bf16x8 pa0, pa1, pa2, pa3;
            qkt128(p0, p1, lds + XA_K + kt * 16384, qr, negm, r32, hi);
            softmax_tile<true>(p0, p1, m_reg, l_reg, alpha, negm, kt == 0, pa0, pa1, pa2, pa3);
            if (__any(alpha < 1.f)) { if (hi == 0) wsf[r32] = alpha; asm volatile("s_waitcnt lgkmcnt(0)" ::: "memory");
#pragma unroll
                for (int r = 0; r < 16; ++r) { const float al = wsf[crow(r, hi)];
#pragma unroll
                    for (int d = 0; d < 4; ++d) o[d][r] *= al; }
                asm volatile("s_waitcnt lgkmcnt(0)" ::: "memory"); }
            const int vb = vb0 + kt * 16384;
            pv_one<0>(o[0], vb, pa0, pa1, pa2, pa3); pv_one<1>(o[1], vb, pa0, pa1, pa2, pa3); pv_one<2>(o[2], vb, pa0, pa1, pa2, pa3); pv_one<3>(o[3], vb, pa0, pa1, pa2, pa3);
        }
        if (hi == 0) wsf[32 + r32] = l_reg; asm volatile("s_waitcnt lgkmcnt(0)" ::: "memory");
#pragma unroll
        for (int r = 0; r < 16; ++r) { const int orow = crow(r, hi); const float rl = __builtin_amdgcn_rcpf(wsf[32 + orow]);
            bf16_t* op = XO + (t0 + orow) * 512 + h * 128 + r32;
#pragma unroll
            for (int d0 = 0; d0 < 4; ++d0) op[d0 * 32] = f2bf(o[d0][r] * rl); }
        asm volatile("s_waitcnt lgkmcnt(0)" ::: "memory");
    }
    __syncthreads();
}
}

namespace peer {
typedef unsigned u32x4 __attribute__((ext_vector_type(4)));
typedef short bf16x8 __attribute__((ext_vector_type(8)));
typedef float f32x16 __attribute__((ext_vector_type(16)));
typedef float f32x4 __attribute__((ext_vector_type(4)));
typedef __bf16 bf16x2 __attribute__((ext_vector_type(2)));
#define KSWZ(row, colB) ((row) * 256 + ((colB) ^ (((row) & 7) << 4)))
__device__ __forceinline__ int crow(int r, int hi) { return (r & 3) + 8 * (r >> 2) + 4 * hi; }
__device__ __forceinline__ unsigned ord_key(float f) { const unsigned b = __float_as_uint(f); return b ^ ((unsigned)((int)b >> 31) | 0x80000000u); }
__device__ __forceinline__ float ord_inv(unsigned o) { return __uint_as_float(o ^ ((unsigned)((int)(~o) >> 31) | 0x80000000u)); }
__device__ __forceinline__ unsigned selu(unsigned m, unsigned a, unsigned b) { return (a & m) | (b & ~m); }
__device__ __forceinline__ unsigned umax_(unsigned a, unsigned b) { return (int)a > (int)b ? a : b; }
__device__ __forceinline__ unsigned umin_(unsigned a, unsigned b) { return (int)a < (int)b ? a : b; }
template <int OFF, int A, int B> __device__ __forceinline__ void ce_desc(unsigned (&k)[64]) { const unsigned a = k[OFF + A], b = k[OFF + B]; k[OFF + A] = umax_(a, b); k[OFF + B] = umin_(a, b); }
template <int OFF> __device__ __forceinline__ void sort16_desc(unsigned (&k)[64]) {
#define CE(a, b) ce_desc<OFF, a, b>(k);
    CE(0,13) CE(1,12) CE(2,15) CE(3,14) CE(4,8) CE(5,6) CE(7,11) CE(9,10)
    CE(0,5) CE(1,7) CE(2,9) CE(3,4) CE(6,13) CE(8,14) CE(10,15) CE(11,12)
    CE(0,1) CE(2,3) CE(4,5) CE(6,8) CE(7,9) CE(10,11) CE(12,13) CE(14,15)
    CE(0,2) CE(1,3) CE(4,10) CE(5,11) CE(6,7) CE(8,9) CE(12,14) CE(13,15)
    CE(1,2) CE(3,12) CE(4,6) CE(5,7) CE(8,10) CE(9,11) CE(13,14)
    CE(1,4) CE(2,6) CE(5,8) CE(7,10) CE(9,13) CE(11,14)
    CE(2,4) CE(3,6) CE(9,12) CE(11,13)
    CE(3,5) CE(6,8) CE(7,9) CE(10,12)
    CE(3,4) CE(5,6) CE(7,8) CE(9,10) CE(11,12)
    CE(6,7) CE(8,9)
#undef CE
}
template <int OFF> __device__ __forceinline__ void merge16_desc(unsigned (&k)[64]) {
#pragma unroll
    for (int stride = 8; stride > 0; stride >>= 1)
#pragma unroll
        for (int i = 0; i < 16; ++i) { const int j = i ^ stride; if (j > i) { const unsigned a = k[OFF + i], b = k[OFF + j]; k[OFF + i] = umax_(a, b); k[OFF + j] = umin_(a, b); } }
}
template <int A, int B> __device__ __forceinline__ void top16_merge(unsigned (&k)[64]) {
#pragma unroll
    for (int i = 0; i < 16; ++i) k[A + i] = umax_(k[A + i], k[B + 15 - i]);
    merge16_desc<A>(k);
}
__device__ __forceinline__ void top16_of_64(unsigned (&k)[64]) {
    sort16_desc<0>(k); sort16_desc<16>(k); sort16_desc<32>(k); sort16_desc<48>(k);
    top16_merge<0, 16>(k); top16_merge<32, 48>(k); top16_merge<0, 32>(k);
}
__device__ __forceinline__ void top16_of_cand(unsigned (&k)[64]) {
    sort16_desc<0>(k); sort16_desc<16>(k); sort16_desc<32>(k); ce_desc<48, 0, 1>(k);
    top16_merge<0, 16>(k);
    k[46] = umax_(k[46], k[49]); k[47] = umax_(k[47], k[48]); merge16_desc<32>(k);
#pragma unroll
    for (int i = 0; i < 16; ++i) k[i] = umax_(k[i], k[32 + 15 - i]);
}
__device__ __forceinline__ void partner_merge(unsigned (&k)[64], int hi) {
    unsigned pr[16];
#pragma unroll
    for (int i = 0; i < 16; ++i) { const unsigned t = k[15 - i]; auto rr = __builtin_amdgcn_permlane32_swap(t, t, false, false); pr[i] = selu(0u - (unsigned)hi, rr[0], rr[1]); }
#pragma unroll
    for (int i = 0; i < 16; ++i) k[i] = umax_(k[i], pr[i]);
    merge16_desc<0>(k);
}
constexpr int cand_slot(int i, int j) { int n = 0; for (int a = 0; a < 16; ++a) for (int b = 0; b < 16; ++b) { if (a == i && b == j) return n; if ((a + 1) * (b + 1) <= 16) ++n; } return n; }
static_assert(cand_slot(15, 0) == 49, "50 candidates");
constexpr float TK_BIAS = 48.f;
__device__ __forceinline__ unsigned pos_key(float biased) { return __float_as_uint(biased); }
constexpr int TK_LDS_SK = 0, TK_LDS_IDX = 65536, TK_LDS_BYTES = 65536 + 8 * 32 * 32;
__device__ __forceinline__ void sk_tile(f32x16& p0, f32x16& p1, const LAS unsigned char* Ks, const bf16x8* qr, int r32, int hi) {
    p0 = f32x16{}; p1 = f32x16{};
#pragma unroll
    for (int d0 = 0; d0 < 8; ++d0) { const int cb = (d0 * 16 + hi * 8) * 2;
        const bf16x8 b0 = *(const LAS bf16x8*)(Ks + KSWZ(r32, cb)); const bf16x8 b1 = *(const LAS bf16x8*)(Ks + KSWZ(32 + r32, cb));
        p0 = __builtin_amdgcn_mfma_f32_32x32x16_bf16(b0, qr[d0], p0, 0, 0, 0); p1 = __builtin_amdgcn_mfma_f32_32x32x16_bf16(b1, qr[d0], p1, 0, 0, 0); }
}
__device__ __forceinline__ void topk_loadq(bf16x8 (&qa)[8], bf16x8 (&qb)[8], const bf16_t* QP, int t, int h, int hi) {
#pragma unroll
    for (int d0 = 0; d0 < 8; ++d0) { qa[d0] = *(const bf16x8*)(QP + (size_t)t * 2048 + h * 256 + d0 * 16 + hi * 8); qb[d0] = *(const bf16x8*)(QP + (size_t)t * 2048 + h * 256 + 128 + d0 * 16 + hi * 8); }
}
__device__ __forceinline__ void topk_half(unsigned (&top)[16], const LAS unsigned char* lds, const bf16x8 (&qr)[8], int p, int r32, int hi) {
    unsigned k[64];
#pragma unroll
    for (int tl = 0; tl < 2; ++tl) { f32x16 p0, p1; sk_tile(p0, p1, lds + TK_LDS_SK + (p * 2 + tl) * 16384, qr, r32, hi); p0 = p0 + TK_BIAS; p1 = p1 + TK_BIAS;
#pragma unroll
        for (int r = 0; r < 16; ++r) { k[tl * 32 + r] = (pos_key(p0[r]) & ~0x7Fu) | (unsigned)(tl * 64 + crow(r, hi)); k[tl * 32 + 16 + r] = (pos_key(p1[r]) & ~0x7Fu) | (unsigned)(tl * 64 + 32 + crow(r, hi)); } }
    top16_of_64(k); partner_merge(k, hi);
#pragma unroll
    for (int i = 0; i < 16; ++i) top[i] = k[i];
}
__device__ __forceinline__ void topk_phase(LAS unsigned char* lds, const bf16_t* QP, const bf16_t* SK, unsigned short* PID, float* PW) {
    const int tid = threadIdx.x, lane = tid & 63, wid = tid >> 6, r32 = lane & 31, hi = lane >> 5;
    LAS unsigned char* idxl = lds + TK_LDS_IDX + wid * 1024 + r32 * 32;
    int staged_h = -1;
    bf16x8 qa[8], qb[8];
    if ((int)blockIdx.x < 8 * 256) topk_loadq(qa, qb, QP, (int)(blockIdx.x >> 3) * 256 + wid * 32 + r32, blockIdx.x & 7, hi);
    for (int u = blockIdx.x; u < 8 * 256; u += gridDim.x) {
        const int h = u & 7, tile = u >> 3;
        if (h != staged_h) {
            __syncthreads();
            for (int pc = tid; pc < 4096; pc += 512) { const int row = pc >> 4, ch = pc & 15;
                const uint4 v = *(const uint4*)(SK + ((size_t)h * 256 + row) * 128 + ch * 8);
                *(LAS u32x4*)(lds + TK_LDS_SK + (row >> 6) * 16384 + KSWZ(row & 63, ch * 16)) = (u32x4){v.x, v.y, v.z, v.w}; }
            __syncthreads(); staged_h = h;
        }
        const int t = tile * 256 + wid * 32 + r32;
        const unsigned hm = 0u - (unsigned)hi;
        unsigned top0[16], top1[16];
        topk_half(top0, lds, qa, 0, r32, hi);
        topk_half(top1, lds, qb, 1, r32, hi);
        { const int un = (u + (int)gridDim.x < 8 * 256) ? u + (int)gridDim.x : u; topk_loadq(qa, qb, QP, (un >> 3) * 256 + wid * 32 + r32, un & 7, hi); }
        { unsigned w[4];
#pragma unroll
          for (int q = 0; q < 4; ++q) { const unsigned a0 = selu(hm, top1[4 * q], top0[4 * q]), a1 = selu(hm, top1[4 * q + 1], top0[4 * q + 1]), a2 = selu(hm, top1[4 * q + 2], top0[4 * q + 2]), a3 = selu(hm, top1[4 * q + 3], top0[4 * q + 3]);
              w[q] = (a0 & 0x7Fu) | ((a1 & 0x7Fu) << 8) | ((a2 & 0x7Fu) << 16) | ((a3 & 0x7Fu) << 24); }
          *(LAS u32x4*)(idxl + hi * 16) = (u32x4){w[0], w[1], w[2], w[3]}; }
        float f1[16], f2[16];
#pragma unroll
        for (int i = 0; i < 16; ++i) { f1[i] = __uint_as_float(top0[i] & ~0x7Fu); f2[i] = __uint_as_float(top1[i] & ~0x7Fu) - TK_BIAS; }
        unsigned k[64];
#pragma unroll
        for (int i = 0; i < 16; ++i)
#pragma unroll
            for (int j = 0; j < 16; ++j) if ((i + 1) * (j + 1) <= 16) k[cand_slot(i, j)] = (pos_key(f1[i] + f2[j]) & ~0xFFu) | (unsigned)(i * 16 + j);
        top16_of_cand(k);
        float sv[16], den = 0.f; const float s0 = __uint_as_float(k[0] & ~0xFFu);
#pragma unroll
        for (int i = 0; i < 16; ++i) { sv[i] = __expf(__uint_as_float(k[i] & ~0xFFu) - s0); den += sv[i]; }
        const float rden = 1.f / den;
        asm volatile("s_waitcnt lgkmcnt(0)" ::: "memory");
        int ids[8]; float ws_[8];
#pragma unroll
        for (int i = 0; i < 8; ++i) { const unsigned kk = selu(hm, k[8 + i], k[i]); const int ci = (kk >> 4) & 15, cj = kk & 15;
            const int i1 = *(const LAS unsigned char*)(idxl + ci), i2 = *(const LAS unsigned char*)(idxl + 16 + cj);
            ids[i] = i1 * 128 + i2; ws_[i] = __uint_as_float(selu(hm, __float_as_uint(sv[8 + i]), __float_as_uint(sv[i]))) * rden; }
        unsigned short* po = PID + ((size_t)t * 8 + h) * 16 + hi * 8; float* pw = PW + ((size_t)t * 8 + h) * 16 + hi * 8;
        *(uint4*)po = make_uint4((unsigned)ids[0] | ((unsigned)ids[1] << 16), (unsigned)ids[2] | ((unsigned)ids[3] << 16), (unsigned)ids[4] | ((unsigned)ids[5] << 16), (unsigned)ids[6] | ((unsigned)ids[7] << 16));
        *(float4*)pw = make_float4(ws_[0], ws_[1], ws_[2], ws_[3]); *(float4*)(pw + 4) = make_float4(ws_[4], ws_[5], ws_[6], ws_[7]);
        asm volatile("s_waitcnt lgkmcnt(0)" ::: "memory");
    }
    __syncthreads();
}

typedef float f32x2 __attribute__((ext_vector_type(2)));
template <int CTRL> __device__ __forceinline__ float dpp_f(float v) { return __builtin_bit_cast(float, __builtin_amdgcn_update_dpp(0, __builtin_bit_cast(int, v), CTRL, 0xf, 0xf, true)); }
__device__ __forceinline__ unsigned xcc_id() { return (unsigned)__builtin_amdgcn_s_getreg((3 << 11) | 20) & 7u; }
__device__ __forceinline__ float swapadd32(float a, float b) { auto rr = __builtin_amdgcn_permlane32_swap(__float_as_uint(a), __float_as_uint(b), false, false); return __uint_as_float(rr[0]) + __uint_as_float(rr[1]); }
__device__ __forceinline__ float swapadd16(float a, float b) { auto rr = __builtin_amdgcn_permlane16_swap(__float_as_uint(a), __float_as_uint(b), false, false); return __uint_as_float(rr[0]) + __uint_as_float(rr[1]); }
__device__ __forceinline__ void fp8x16_to_f32(const uint4 r, float (&f)[16]) {
    const unsigned w[4] = {r.x, r.y, r.z, r.w};
#pragma unroll
    for (int q = 0; q < 4; ++q) { const f32x2 lo = __builtin_amdgcn_cvt_pk_f32_fp8((int)w[q], false), hi = __builtin_amdgcn_cvt_pk_f32_fp8((int)w[q], true); f[4 * q] = lo.x; f[4 * q + 1] = lo.y; f[4 * q + 2] = hi.x; f[4 * q + 3] = hi.y; }
}
constexpr int PEER_ITEM_TOK = 64, PEER_N64 = 704, PEER_N32 = 320, PEER_N16 = 640, PEER_NITEM = PEER_N64 + PEER_N32 + PEER_N16;
static_assert(PEER_N64 * 64 + PEER_N32 * 32 + PEER_N16 * 16 == T_TOK, "guided item schedule must cover every token");
struct DnIn { unsigned idp; uint4 xa, xb; };
__device__ __forceinline__ void dn_s1(DnIn& I, const unsigned short* PID, const bf16_t* XB, size_t t, int slice, int lane, int l8) {
    I.idp = ((const unsigned*)PID)[t * 64 + lane];
    I.xa = *(const uint4*)(XB + t * 1024 + slice * 128 + l8 * 16); I.xb = *(const uint4*)(XB + t * 1024 + slice * 128 + l8 * 16 + 8);
}
template <int CTRL> __device__ __forceinline__ int dpp_i(int v) { return __builtin_amdgcn_update_dpp(0, v, CTRL, 0xf, 0xf, true); }
__device__ __forceinline__ void dn_quantx(unsigned (&xq)[4], float& sx, const DnIn& I) {
    const unsigned xw[8] = {I.xa.x, I.xa.y, I.xa.z, I.xa.w, I.xb.x, I.xb.y, I.xb.z, I.xb.w};
    float xf[16]; float am = 0.f;
#pragma unroll
    for (int q = 0; q < 8; ++q) { xf[2 * q] = __uint_as_float(xw[q] << 16); xf[2 * q + 1] = __uint_as_float(xw[q] & 0xffff0000u); am = fmaxf(am, fmaxf(fabsf(xf[2 * q]), fabsf(xf[2 * q + 1]))); }
    am = fmaxf(am, dpp_f<0xB1>(am)); am = fmaxf(am, dpp_f<0x4E>(am)); am = fmaxf(am, dpp_f<0x141>(am));
    const float inv = am > 0.f ? 127.f / am : 0.f; sx = am * (1.f / 127.f);
#pragma unroll
    for (int q = 0; q < 4; ++q) xq[q] = ((unsigned)__float2int_rn(xf[4 * q] * inv) & 0xffu) | (((unsigned)__float2int_rn(xf[4 * q + 1] * inv) & 0xffu) << 8) | (((unsigned)__float2int_rn(xf[4 * q + 2] * inv) & 0xffu) << 16) | ((unsigned)__float2int_rn(xf[4 * q + 3] * inv) << 24);
}
__device__ __forceinline__ void pe_s2(uint4 (&W)[16], unsigned idp, const unsigned char* wslice, unsigned loff, int g8) {
#pragma unroll
    for (int i = 0; i < 8; ++i) { const unsigned p0 = (unsigned)__shfl((int)idp, 4 * g8 + (i >> 1)), p1 = (unsigned)__shfl((int)idp, 32 + 4 * g8 + (i >> 1));
        const unsigned e0 = (i & 1) ? (p0 >> 16) : (p0 & 0xffffu), e1 = (i & 1) ? (p1 >> 16) : (p1 & 0xffffu);
        W[i] = *(const uint4*)(wslice + ((e0 << 7) + loff)); W[8 + i] = *(const uint4*)(wslice + ((e1 << 7) + loff)); }
}
__device__ __forceinline__ int reduce8x8(const int (&v)[8], bool b2, bool b1, bool b0) {
    int n[4], m[2];
#pragma unroll
    for (int j = 0; j < 4; ++j) n[j] = (b2 ? v[4 + j] : v[j]) + dpp_i<0x141>(b2 ? v[j] : v[4 + j]);
#pragma unroll
    for (int j = 0; j < 2; ++j) m[j] = (b1 ? n[2 + j] : n[j]) + dpp_i<0x4E>(b1 ? n[j] : n[2 + j]);
    return (b0 ? m[1] : m[0]) + dpp_i<0xB1>(b0 ? m[0] : m[1]);
}
__device__ __forceinline__ void dn_s3(const uint4 (&W)[16], const unsigned (&xq)[4], float sx, bf16_t* po, int lane, int l8) {
    const bool b2 = (l8 >> 2) & 1, b1 = (l8 >> 1) & 1, b0 = l8 & 1;
    int d[16];
#pragma unroll
    for (int i = 0; i < 16; ++i) { int a = __builtin_amdgcn_sdot4((int)W[i].x, (int)xq[0], 0, false); a = __builtin_amdgcn_sdot4((int)W[i].y, (int)xq[1], a, false);
        a = __builtin_amdgcn_sdot4((int)W[i].z, (int)xq[2], a, false); d[i] = __builtin_amdgcn_sdot4((int)W[i].w, (int)xq[3], a, false); }
    const int lo[8] = {d[0], d[1], d[2], d[3], d[4], d[5], d[6], d[7]}, hi[8] = {d[8], d[9], d[10], d[11], d[12], d[13], d[14], d[15]};
    const float r0 = (float)reduce8x8(lo, b2, b1, b0) * sx, r1 = (float)reduce8x8(hi, b2, b1, b0) * sx;
    const float n0 = dpp_f<0xB1>(r0), n1 = dpp_f<0xB1>(r1);
    if (!(lane & 1)) { ((unsigned*)po)[lane >> 1] = pk2(r0, n0); ((unsigned*)po)[32 + (lane >> 1)] = pk2(r1, n1); }
}
__device__ __forceinline__ void down_phase(const bf16_t* XB, const unsigned char* WDq, const unsigned short* PID, bf16_t* PARTD, unsigned* qctr) {
    const int lane = threadIdx.x & 63, g8 = lane >> 3, l8 = lane & 7;
    const unsigned xcc = xcc_id();
    for (int st = 0; st < 8; ++st) { const int slice = (int)((xcc + st) & 7u);
        const unsigned char* wslice = WDq + (size_t)slice * (16384 * 128); const unsigned loff = (unsigned)l8 * 16u;
        for (;;) { unsigned it_ = 0; if (lane == 0) it_ = __hip_atomic_fetch_add(qctr + slice * 64, 1u, __ATOMIC_RELAXED, __HIP_MEMORY_SCOPE_AGENT);
            const int item = (int)__builtin_amdgcn_readfirstlane(it_); if (item >= PEER_NITEM) break;
            const int ntok = item < PEER_N64 ? 64 : (item < PEER_N64 + PEER_N32 ? 32 : 16);
            const size_t t0 = item < PEER_N64 ? (size_t)item * 64 : (item < PEER_N64 + PEER_N32 ? (size_t)PEER_N64 * 64 + (size_t)(item - PEER_N64) * 32 : (size_t)PEER_N64 * 64 + (size_t)PEER_N32 * 32 + (size_t)(item - PEER_N64 - PEER_N32) * 16); bf16_t* pbase = PARTD + ((size_t)slice * T_TOK + t0) * 128;
            DnIn IA, IB; uint4 WA[16], WB[16]; unsigned xq[4]; float sx;
            dn_s1(IA, PID, XB, t0, slice, lane, l8); dn_s1(IB, PID, XB, t0 + 1, slice, lane, l8);
            pe_s2(WA, IA.idp, wslice, loff, g8);
#pragma unroll 1
            for (int k = 0; k < ntok; k += 2) {
                const int k2 = (k + 2 < ntok) ? k + 2 : ntok - 1, k3 = (k + 3 < ntok) ? k + 3 : ntok - 1;
                dn_quantx(xq, sx, IA); dn_s1(IA, PID, XB, t0 + k2, slice, lane, l8); pe_s2(WB, IB.idp, wslice, loff, g8);
                dn_s3(WA, xq, sx, pbase + (size_t)k * 128, lane, l8);
                dn_quantx(xq, sx, IB); dn_s1(IB, PID, XB, t0 + k3, slice, lane, l8); pe_s2(WA, IA.idp, wslice, loff, g8);
                dn_s3(WB, xq, sx, pbase + (size_t)(k + 1) * 128, lane, l8);
            }
        }
    }
}
template <int B>
__device__ __forceinline__ void coef_batch(const bf16_t* __restrict__ PARTD, const float* __restrict__ SS, const LAS float* SD, const LAS float* SU, const unsigned short* __restrict__ PID, const float* __restrict__ PW, bf16_t* __restrict__ COEF,
                                           size_t tq0, size_t tstride, int sub, int j8) {
    u32x4 pv[B][8], e[B]; f32x4 sq[B], pw[B][2];
#pragma unroll
    for (int u = 0; u < B; ++u) { const size_t t = (tq0 + u * tstride) * 4 + sub;
        e[u] = *(const u32x4*)(PID + t * 128 + j8); pw[u][0] = *(const f32x4*)(PW + t * 128 + j8); pw[u][1] = *(const f32x4*)(PW + t * 128 + j8 + 4);
        sq[u] = *(const f32x4*)(SS + t * 16 + (j8 & 24) / 2);
#pragma unroll
        for (int x = 0; x < 8; ++x) pv[u][x] = *(const u32x4*)(PARTD + ((size_t)x * T_TOK + t) * 128 + j8); }
    float sd[B][8], su[B][8];
#pragma unroll
    for (int u = 0; u < B; ++u)
#pragma unroll
        for (int q = 0; q < 4; ++q) { const unsigned ea = e[u][q] & 0xffffu, eb = e[u][q] >> 16; sd[u][2 * q] = SD[ea]; sd[u][2 * q + 1] = SD[eb]; su[u][2 * q] = SU[ea]; su[u][2 * q + 1] = SU[eb]; }
#pragma unroll
    for (int u = 0; u < B; ++u) { const size_t t = (tq0 + u * tstride) * 4 + sub;
        float d[8];
#pragma unroll
        for (int q = 0; q < 8; ++q) d[q] = 0.f;
#pragma unroll
        for (int x = 0; x < 8; ++x)
#pragma unroll
            for (int q = 0; q < 4; ++q) { d[2 * q] += __uint_as_float(pv[u][x][q] << 16); d[2 * q + 1] += __uint_as_float(pv[u][x][q] & 0xffff0000u); }
        float ssum = (sq[u][0] + sq[u][1]) + (sq[u][2] + sq[u][3]); ssum += dpp_f<0xB1>(ssum); ssum += dpp_f<0x4E>(ssum);
        const float rstd = rsqrtf(ssum * (1.f / DM) + EPS);
        float o[8];
#pragma unroll
        for (int q = 0; q < 8; ++q) o[q] = pw[u][q >> 2][q & 3] * su[u][q] * gelu_tanh(d[q] * rstd * sd[u][q]);
        *(u32x4*)(COEF + t * 128 + j8) = (u32x4){pk2(o[0], o[1]), pk2(o[2], o[3]), pk2(o[4], o[5]), pk2(o[6], o[7])}; }
}
__device__ __forceinline__ void coef_phase(LAS unsigned char* lds, const bf16_t* __restrict__ PARTD, const float* __restrict__ SS, const float* __restrict__ SDg, const float* __restrict__ SUg, const unsigned short* __restrict__ PID, const float* __restrict__ PW, bf16_t* __restrict__ COEF) {
    const int lane = threadIdx.x & 63, wid = threadIdx.x >> 6, sub = lane >> 4, j8 = (lane & 15) * 8;
    LAS float* SD = (LAS float*)lds; LAS float* SU = SD + 16384;
    __syncthreads();
    for (int i = threadIdx.x; i < 16384 / 4; i += 512) { ((LAS f32x4*)SD)[i] = ((const f32x4*)SDg)[i]; ((LAS f32x4*)SU)[i] = ((const f32x4*)SUg)[i]; }
    __syncthreads();
    const size_t gw = blockIdx.x * 8 + wid, NGW = gridDim.x * 8;
    size_t tq = gw;
    for (; tq + 1 * NGW < T_TOK / 4; tq += 2 * NGW) coef_batch<2>(PARTD, SS, SD, SU, PID, PW, COEF, tq, NGW, sub, j8);
    for (; tq < T_TOK / 4; tq += NGW) coef_batch<1>(PARTD, SS, SD, SU, PID, PW, COEF, tq, NGW, sub, j8);
}
struct UpIn { unsigned idp, cfp, x2; };
__device__ __forceinline__ void up_s1(UpIn& I, const unsigned short* PID, const bf16_t* COEF, const bf16_t* xin, size_t t, int slice, int lane, int c0) {
    I.idp = ((const unsigned*)PID)[t * 64 + lane]; I.cfp = ((const unsigned*)COEF)[t * 64 + lane];
    I.x2 = *(const unsigned*)(xin + t * 1024 + slice * 128 + c0);
}
__device__ __forceinline__ void up_s3(const uint4 (&W)[16], unsigned cfp, unsigned x2, bf16_t* orow, float* ss3, int lane, int g8) {
    f32x2 ac2[8];
#pragma unroll
    for (int q = 0; q < 8; ++q) ac2[q] = (f32x2){0.f, 0.f};
#pragma unroll
    for (int i = 0; i < 16; ++i) { const unsigned cp = (unsigned)__shfl((int)cfp, (i < 8 ? 0 : 32) + 4 * g8 + ((i & 7) >> 1)); const float c = (i & 1) ? __uint_as_float(cp & 0xffff0000u) : __uint_as_float(cp << 16); const f32x2 c2 = {c, c}; const unsigned w[4] = {W[i].x, W[i].y, W[i].z, W[i].w};
#pragma unroll
        for (int q = 0; q < 4; ++q) { ac2[2 * q] = __builtin_elementwise_fma(__builtin_amdgcn_cvt_pk_f32_fp8((int)w[q], false), c2, ac2[2 * q]); ac2[2 * q + 1] = __builtin_elementwise_fma(__builtin_amdgcn_cvt_pk_f32_fp8((int)w[q], true), c2, ac2[2 * q + 1]); } }
    float acc[16];
#pragma unroll
    for (int q = 0; q < 8; ++q) { acc[2 * q] = ac2[q].x; acc[2 * q + 1] = ac2[q].y; }
    float a8[8], a4[4];
#pragma unroll
    for (int q = 0; q < 8; ++q) a8[q] = swapadd32(acc[q], acc[q + 8]);
#pragma unroll
    for (int q = 0; q < 4; ++q) a4[q] = swapadd16(a8[q], a8[q + 4]);
    const bool b3 = (lane >> 3) & 1;
    const float y0 = (b3 ? a4[2] : a4[0]) + dpp_f<0x128>(b3 ? a4[0] : a4[2]);
    const float y1 = (b3 ? a4[3] : a4[1]) + dpp_f<0x128>(b3 ? a4[1] : a4[3]);
    const float o0 = __uint_as_float(x2 << 16) + y0, o1 = __uint_as_float(x2 & 0xffff0000u) + y1;
    *(unsigned*)orow = pk2(o0, o1);
    const float ss = wave_sum(o0 * o0 + o1 * o1);
    if (lane == 0) *ss3 = ss;
}
__device__ __forceinline__ void up_phase(const unsigned char* WUq, const unsigned short* PID, const bf16_t* COEF, const bf16_t* xin, bf16_t* xout, float* SS3, unsigned* qctr) {
    const int lane = threadIdx.x & 63, g8 = lane >> 3, l8 = lane & 7;
    const int c0 = 16 * l8 + 8 * ((lane >> 5) & 1) + 4 * ((lane >> 4) & 1) + 2 * ((lane >> 3) & 1);
    const unsigned xcc = xcc_id();
    for (int st = 0; st < 8; ++st) { const int slice = (int)((xcc + st) & 7u);
        const unsigned char* wslice = WUq + (size_t)slice * (16384 * 128); const unsigned loff = (unsigned)l8 * 16u;
        for (;;) { unsigned it_ = 0; if (lane == 0) it_ = __hip_atomic_fetch_add(qctr + slice * 64, 1u, __ATOMIC_RELAXED, __HIP_MEMORY_SCOPE_AGENT);
            const int item = (int)__builtin_amdgcn_readfirstlane(it_); if (item >= PEER_NITEM) break;
            const int ntok = item < PEER_N64 ? 64 : (item < PEER_N64 + PEER_N32 ? 32 : 16);
            const size_t t0 = item < PEER_N64 ? (size_t)item * 64 : (item < PEER_N64 + PEER_N32 ? (size_t)PEER_N64 * 64 + (size_t)(item - PEER_N64) * 32 : (size_t)PEER_N64 * 64 + (size_t)PEER_N32 * 32 + (size_t)(item - PEER_N64 - PEER_N32) * 16);
            UpIn IA, IB; uint4 WA[16], WB[16];
            up_s1(IA, PID, COEF, xin, t0, slice, lane, c0); up_s1(IB, PID, COEF, xin, t0 + 1, slice, lane, c0);
            pe_s2(WA, IA.idp, wslice, loff, g8);
#pragma unroll 1
            for (int k = 0; k < ntok; k += 2) {
                const int k2 = (k + 2 < ntok) ? k + 2 : ntok - 1, k3 = (k + 3 < ntok) ? k + 3 : ntok - 1;
                { const unsigned cp_ = IA.cfp; const unsigned xx = IA.x2;
                  up_s1(IA, PID, COEF, xin, t0 + k2, slice, lane, c0); pe_s2(WB, IB.idp, wslice, loff, g8);
                  up_s3(WA, cp_, xx, xout + (t0 + k) * 1024 + slice * 128 + c0, SS3 + (t0 + k) * 8 + slice, lane, g8); }
                { const unsigned cp_ = IB.cfp; const unsigned xx = IB.x2;
                  up_s1(IB, PID, COEF, xin, t0 + k3, slice, lane, c0); pe_s2(WA, IA.idp, wslice, loff, g8);
                  up_s3(WB, cp_, xx, xout + (t0 + k + 1) * 1024 + slice * 128 + c0, SS3 + (t0 + k + 1) * 8 + slice, lane, g8); }
            }
        }
    }
}
template <int B>
__device__ __forceinline__ void final_batch(const bf16_t* __restrict__ xin, const float* __restrict__ SS3, const float* __restrict__ fg, float* __restrict__ out, size_t t0, size_t tstride, int lane) {
    u32x4 v[B][2]; f32x4 sq[B][2];
#pragma unroll
    for (int u = 0; u < B; ++u) { const size_t t = t0 + u * tstride; sq[u][0] = *(const f32x4*)(SS3 + t * 8); sq[u][1] = *(const f32x4*)(SS3 + t * 8 + 4);
        v[u][0] = *(const u32x4*)(xin + t * 1024 + lane * 8); v[u][1] = *(const u32x4*)(xin + t * 1024 + 512 + lane * 8); }
    const f32x4 g00 = *(const f32x4*)(fg + lane * 8), g01 = *(const f32x4*)(fg + lane * 8 + 4), g10 = *(const f32x4*)(fg + 512 + lane * 8), g11 = *(const f32x4*)(fg + 516 + lane * 8);
#pragma unroll
    for (int u = 0; u < B; ++u) { const size_t t = t0 + u * tstride; const f32x4 s4 = sq[u][0] + sq[u][1];
        const float r2 = rsqrtf(((s4[0] + s4[1]) + (s4[2] + s4[3])) * (1.f / DM) + EPS);
#pragma unroll
        for (int q = 0; q < 2; ++q) { const u32x4 w = v[u][q]; const f32x4 ga = q ? g10 : g00, gb = q ? g11 : g01; float* op = out + t * 1024 + q * 512 + lane * 8;
            const f32x4 o0 = {__uint_as_float(w.x << 16) * r2 * ga[0], __uint_as_float(w.x & 0xffff0000u) * r2 * ga[1], __uint_as_float(w.y << 16) * r2 * ga[2], __uint_as_float(w.y & 0xffff0000u) * r2 * ga[3]};
            const f32x4 o1 = {__uint_as_float(w.z << 16) * r2 * gb[0], __uint_as_float(w.z & 0xffff0000u) * r2 * gb[1], __uint_as_float(w.w << 16) * r2 * gb[2], __uint_as_float(w.w & 0xffff0000u) * r2 * gb[3]};
            *(f32x4*)op = o0; *(f32x4*)(op + 4) = o1; } }
}
__device__ __forceinline__ void final_phase(const bf16_t* __restrict__ xin, const float* __restrict__ SS3, const float* __restrict__ fg, float* __restrict__ out) {
    const int lane = threadIdx.x & 63, wid = threadIdx.x >> 6;
    const size_t gw = blockIdx.x * 8 + wid, NGW = gridDim.x * 8;
    size_t t = gw;
    for (; t + 7 * NGW < T_TOK; t += 8 * NGW) final_batch<8>(xin, SS3, fg, out, t, NGW, lane);
    for (; t < T_TOK; t += NGW) final_batch<1>(xin, SS3, fg, out, t, NGW, lane);
}
#undef KSWZ
}


#define XB_TMO      128
#define XB_XCNT(j)  (256  + 64 * (j))
#define XB_XSUB(j)  (1280 + 64 * (j))
#define XB_XGEN(j)  (2304 + 64 * (j))
#define XB_TOP      3328
#define XB_TOPGEN   3392
#define XCD_BAR_WORDS 3456
#define XB_SPIN_CAP (1u << 22)
__device__ __forceinline__ unsigned xb_ld(unsigned* p)              { return __hip_atomic_load(p, __ATOMIC_RELAXED, __HIP_MEMORY_SCOPE_AGENT); }
__device__ __forceinline__ unsigned xb_add(unsigned* p, unsigned v) { return __hip_atomic_fetch_add(p, v, __ATOMIC_RELAXED, __HIP_MEMORY_SCOPE_AGENT); }
__device__ __forceinline__ unsigned xb_xcc_id() { return (unsigned)__builtin_amdgcn_s_getreg((3 << 11) | 20) & 0xFu; }
#define XB_SPIN(cond, bar) do { unsigned _sp = 0; while (cond) { __builtin_amdgcn_s_sleep(1); \
    if ((++_sp & 255u) == 0u) { if (xb_ld(&(bar)[XB_TMO])) break; if (_sp > XB_SPIN_CAP) { atomicAdd(&(bar)[XB_TMO], 1u); break; } } } } while (0)
struct XcdBarrier { unsigned* bar; unsigned x; volatile LAS unsigned* st; };
__device__ __forceinline__ XcdBarrier xcd_barrier_post(unsigned* bar, volatile LAS unsigned* st) {
    XcdBarrier b; b.bar = bar; b.x = xb_xcc_id(); b.st = st;
    if (threadIdx.x == 0) (void)xb_add(&bar[XB_XCNT(b.x)], 1u);
    return b;
}
__device__ __forceinline__ void xcd_barrier_complete(unsigned* bar, unsigned x, unsigned& nloc, unsigned& nx) {
    const unsigned G = gridDim.x * gridDim.y * gridDim.z;
    unsigned sum, cnt, mine, sp = 0u;
    for (;;) {
        sum = 0u; cnt = 0u; mine = 0u;
#pragma unroll
        for (unsigned j = 0; j < 16; ++j) { const unsigned c = xb_ld(&bar[XB_XCNT(j)]); sum += c; cnt += (c > 0u) ? 1u : 0u; mine = (j == x) ? c : mine; }
        if (sum == G) break;
        __builtin_amdgcn_s_sleep(1);
        if ((++sp & 255u) == 0u) { if (xb_ld(&bar[XB_TMO])) break; if (sp > XB_SPIN_CAP) { atomicAdd(&bar[XB_TMO], 1u); break; } }
    }
    nloc = mine > 0u ? mine : 1u; nx = cnt > 0u ? cnt : 1u;
}
__device__ __forceinline__ void xcd_barrier(const XcdBarrier& b) {
    asm volatile("s_waitcnt vmcnt(0)" ::: "memory");
    __syncthreads();
    if (threadIdx.x == 0) {
        unsigned* bar = b.bar;
        __builtin_amdgcn_s_waitcnt(0);
        unsigned nloc = b.st[0], nx = b.st[1];
        if (nloc == 0u) { xcd_barrier_complete(bar, b.x, nloc, nx); b.st[0] = nloc; b.st[1] = nx; }
        const unsigned old = xb_add(&bar[XB_XSUB(b.x)], 1u);
        const unsigned gen = old / nloc;
        if (old + 1u == (gen + 1u) * nloc) {
            __builtin_amdgcn_fence(__ATOMIC_RELEASE, "agent");
            asm volatile("s_waitcnt vmcnt(0)" ::: "memory");
            const unsigned og = xb_add(&bar[XB_TOP], 1u);
            const unsigned tg = og / nx;
            if (og + 1u == (tg + 1u) * nx) xb_add(&bar[XB_TOPGEN], 1u);
            else XB_SPIN(xb_ld(&bar[XB_TOPGEN]) == tg, bar);
            __builtin_amdgcn_fence(__ATOMIC_ACQUIRE, "agent");
            xb_add(&bar[XB_XGEN(b.x)], 1u);
            asm volatile("s_waitcnt vmcnt(0)" ::: "memory");
        } else {
            XB_SPIN(xb_ld(&bar[XB_XGEN(b.x)]) == gen, bar);
            __builtin_amdgcn_fence(__ATOMIC_ACQUIRE, "agent");
            asm volatile("s_waitcnt vmcnt(0)" ::: "memory");
        }
    }
    __syncthreads();
}

constexpr int NTHREADS = 512;
constexpr int LDS_BYTES = 147456;
constexpr int NPHASE = 16;

__global__ void __launch_bounds__(NTHREADS, 2) mega_fwd(Args a) {
    extern __shared__ __attribute__((aligned(16))) unsigned char lds_raw[];
    LAS unsigned char* lds = (LAS unsigned char*)lds_raw;
    cg::grid_group grid = cg::this_grid();
    const int lo = a.ph_lo, hi = a.ph_hi;
    volatile LAS unsigned* bst = (volatile LAS unsigned*)(lds + LDS_BYTES - 64);
    if (threadIdx.x < 2) bst[threadIdx.x] = 0u;
    __syncthreads();
    const XcdBarrier xbar = xcd_barrier_post((unsigned*)(a.ws + WS_CTL) + 16384 + a.li * 4096, bst);
#define IN(k) (lo <= (k) && (k) < hi)
#define SEAM(k) do { if (IN(k) && IN((k) + 1)) { if ((k) == 0) grid.sync(); else xcd_barrier(xbar); } } while (0)
#ifndef DUP_MASK
#define DUP_MASK 0u
#endif
#define REPS(k) for (int rep = 0, nrep = ((DUP_MASK >> (k)) & 1u) ? 2 : 1; rep < nrep; ++rep, (rep < nrep ? grid.sync() : (void)0))
    unsigned char* ws = a.ws;
#define BFP(off) ((bf16_t*)(ws + (off)))
#define FPP(off) ((float*)(ws + (off)))
    const int G = gridDim.x, cu = blockIdx.x;
    if (IN(0)) REPS(0) { p0_prologue(a, lds); }
    SEAM(0);
    if (IN(1)) REPS(1) {
        { pg8::Gemm g{(const bf16_t*)a.out, BFP(WS_WIN_T), 1024, 1024, 1024};
          pg8::StaticOrder S; S.init(T_TOK, W8_BF16_ROWS, G, cu);
          pg8::EpiInProj E{BFP(WS_Q), BFP(WS_K), BFP(WS_V), BFP(WS_U), BFP(WS_GV), BFP(WS_GA), BFP(WS_GB), FPP(WS_KMP), (const float2*)(ws + WS_ROPE), 0, 1.f};
          pg8::gemm_phase(lds, g, S, E); }
        { pg8::Gemm g{(const bf16_t*)((const unsigned char*)a.out + OUT_XN8), (const bf16_t*)(ws + WS_WG8), 512, 512, 512};
          pg8::StaticOrder S; S.init(T_TOK, 3584, G, cu);
          pg8::EpiGate8 E{ws + WS_GA, ws + WS_GB, BFP(WS_V), BFP(WS_GV), pg8::EpiInProj{BFP(WS_Q), BFP(WS_K), BFP(WS_V), BFP(WS_U), BFP(WS_GV), BFP(WS_GA), BFP(WS_GB), FPP(WS_KMP), (const float2*)(ws + WS_ROPE), 1, 1.f / WG8_SCALE}};
          pg8::gemm_phase<pg8::EpiGate8, pg8::StaticOrder, false, true>(lds, g, S, E); }
    }
    SEAM(1);
    if (IN(2)) REPS(2) { att::sel_phase(BFP(WS_Q), FPP(WS_KMP), (signed char*)(ws + WS_SEL));
                 att::gmlp_phase(lds, BFP(WS_U), BFP(WS_GV), BFP(WS_WM), a.in[5], a.in[7], BFP(WS_ATTGM)); }
    SEAM(2);
    if (IN(3)) REPS(3) {
        { pg8::Gemm g{BFP(WS_MN), BFP(WS_XAKV_T), 1024, 1024, 1024}; pg8::StaticOrder S; S.init(NB * NMEM, 1024, G, cu);
          pg8::EpiPlain E{BFP(WS_XKV), 1024};
          pg8::gemm_phase(lds, g, S, E); }
      att::moba_sel_phase(lds, BFP(WS_Q), BFP(WS_K), BFP(WS_V), (const signed char*)(ws + WS_SEL), BFP(WS_PART), FPP(WS_ML), (unsigned*)(ws + WS_CTL) + a.li * 8192 + 64 + rep); }
    SEAM(3);
    if (IN(4)) REPS(4) att::moba_own_phase(lds, BFP(WS_Q), BFP(WS_K), BFP(WS_V), (const signed char*)(ws + WS_SEL), BFP(WS_PART), FPP(WS_ML), BFP(WS_ATTGM));
    SEAM(4);
    if (IN(5)) REPS(5) {
        pg8::Gemm g{BFP(WS_ATTGM), BFP(WS_WAB_T), 1024, 1024, 1024}; pg8::StaticOrder S; S.init(T_TOK, 1024, G, cu);
        pg8::EpiMergedFused E{ws + WS_GA, ws + WS_GB, BFP(WS_MERGED)};
        pg8::gemm_phase<pg8::EpiMergedFused, pg8::StaticOrder, true>(lds, g, S, E);
    }
    SEAM(5);
    if (IN(6)) REPS(6) {
        pg8::Gemm g{BFP(WS_MERGED), BFP(WS_WOUT_T), 1024, 1024, 1024}; pg8::StaticOrder S; S.init(T_TOK, 1024, G, cu);
        pg8::EpiResid<2> E{FPP(WS_RS0), (const bf16_t*)a.out, BFP(WS_XB), FPP(WS_SS1)};
        pg8::gemm_phase(lds, g, S, E);
    }
    SEAM(6);
    if (IN(7)) REPS(7) {
        pg8::Gemm g{BFP(WS_XB), BFP(WS_XAQ_T), 1024, 1024, 1024}; pg8::StaticOrder S; S.init(T_TOK, 512, G, cu);
        pg8::EpiRowScale E{BFP(WS_XQ), 512, FPP(WS_SS1), C2X};
        pg8::gemm_phase(lds, g, S, E);
    }
    SEAM(7);
    if (IN(8)) REPS(8) att::xattn_phase(lds, BFP(WS_XQ), BFP(WS_XKV), BFP(WS_XO));
    SEAM(8);
    if (IN(9)) REPS(9) {
        pg8::Gemm g{BFP(WS_XO), BFP(WS_XAO_T), 512, 512, 512}; pg8::StaticOrder S; S.init(T_TOK, 1024, G, cu);
        pg8::EpiResid<1> E{nullptr, nullptr, BFP(WS_XB), FPP(WS_SS2)};
        pg8::gemm_phase(lds, g, S, E);
    }
    SEAM(9);
    if (IN(10)) REPS(10) {
        pg8::Gemm g{BFP(WS_XB), BFP(WS_PQ_T), 1024, 1024, 1024}; pg8::StaticOrder S; S.init(T_TOK, 2048, G, cu);
        pg8::EpiRowScale E{BFP(WS_QP), 2048, FPP(WS_SS2), 1.f};
        pg8::gemm_phase(lds, g, S, E);
    }
    SEAM(10);
    if (IN(11)) REPS(11) peer::topk_phase(lds, BFP(WS_QP), BFP(WS_SK), (unsigned short*)(ws + WS_PID), FPP(WS_PW));
    SEAM(11);
    if (IN(12)) REPS(12) peer::down_phase(BFP(WS_XB), ws + WS_WD, (const unsigned short*)(ws + WS_PID), BFP(WS_PARTD), (unsigned*)(ws + WS_CTL) + a.li * 8192 + 1024 + rep * 512);
    SEAM(12);
    if (IN(13)) REPS(13) peer::coef_phase(lds, BFP(WS_PARTD), FPP(WS_SS2), FPP(WS_SD), FPP(WS_SU), (const unsigned short*)(ws + WS_PID), FPP(WS_PW), BFP(WS_COEF));
    SEAM(13);
    if (IN(14)) REPS(14) peer::up_phase(ws + WS_WU, (const unsigned short*)(ws + WS_PID), BFP(WS_COEF), BFP(WS_XB), (rep + 1 < nrep) ? BFP(WS_RD) : BFP(WS_XB), FPP(WS_SS3), (unsigned*)(ws + WS_CTL) + a.li * 8192 + 2048 + rep * 512);
    SEAM(14);
    if (IN(15)) REPS(15) peer::final_phase(BFP(WS_XB), FPP(WS_SS3), a.in[20], a.out);
#undef BFP
#undef FPP
#undef IN
#undef SEAM
}

__global__ void __launch_bounds__(256) nv_inproj_rope(const bf16_t* XN, const float* W, const float2* rope, bf16_t* Q, bf16_t* K) {
    const int r0 = blockIdx.x * 8, which = blockIdx.y, p = threadIdx.x, head = p >> 5, i = p & 31;
    const int c1 = which * 512 + head * 64 + i, c2 = c1 + 32;
    float a1[8], a2[8];
#pragma unroll
    for (int j = 0; j < 8; ++j) { a1[j] = 0.f; a2[j] = 0.f; }
    for (int k = 0; k < 1024; ++k) { const float w1 = W[(size_t)k * IN_COLS + c1], w2 = W[(size_t)k * IN_COLS + c2];
#pragma unroll
        for (int j = 0; j < 8; ++j) { const float x = bf2f(XN[(size_t)(r0 + j) * 1024 + k]); a1[j] += x * w1; a2[j] += x * w2; } }
    bf16_t* O = which ? K : Q; const float sc = which ? 1.f : C2M;
#pragma unroll
    for (int j = 0; j < 8; ++j) { const int r = r0 + j, pos = r & (SEQ - 1); const float2 cs = rope[pos * 32 + i];
        const float o1 = a1[j] * cs.x - a2[j] * cs.y, o2 = a2[j] * cs.x + a1[j] * cs.y;
        *(unsigned*)(O + (size_t)r * 512 + head * 64 + 2 * i) = pk2(o1 * sc, o2 * sc); }
}
__global__ void __launch_bounds__(256) nv_inproj_rest(const bf16_t* XN, const float* W, bf16_t* V, bf16_t* U, bf16_t* GV, bf16_t* GA, bf16_t* GB) {
    const int r0 = blockIdx.x * 8, n = 1024 + blockIdx.y * 256 + threadIdx.x;
    float acc[8];
#pragma unroll
    for (int j = 0; j < 8; ++j) acc[j] = 0.f;
    for (int k = 0; k < 1024; ++k) { const float w = W[(size_t)k * IN_COLS + n];
#pragma unroll
        for (int j = 0; j < 8; ++j) acc[j] += bf2f(XN[(size_t)(r0 + j) * 1024 + k]) * w; }
#pragma unroll
    for (int j = 0; j < 8; ++j) { const size_t r = r0 + j; const float v = acc[j];
        if (n < 1536) V[r * 512 + (n - 1024)] = f2bf(v);
        else if (n < 2048) U[r * 512 + (n - 1536)] = f2bf(gelu_tanh(v));
        else if (n < 2560) GV[r * 512 + (n - 2048)] = f2bf(gelu_tanh(v));
        else if (n < 3584) GA[r * 1024 + (n - 2560)] = f2bf(sigmoidf(v));
        else GB[r * 1024 + (n - 3584)] = f2bf(sigmoidf(v)); }
}
__global__ void __launch_bounds__(512) nv_kmean(const bf16_t* K, float* KMP) {
    const int blk = blockIdx.x, c = threadIdx.x; float s = 0.f;
    for (int r = 0; r < 256; ++r) s += bf2f(K[(size_t)(blk * 256 + r) * 512 + c]);
    KMP[(size_t)blk * 1024 + c] = s; KMP[(size_t)blk * 1024 + 512 + c] = 0.f;
}
template <int MODE>
__global__ void __launch_bounds__(256) nv_gemm(const bf16_t* A, int lda, const float* W, int ldw, int K, const float* kscale, bf16_t* O, int ldo, const float* SS, float cscale, float* res) {
    const int r0 = blockIdx.x * 8, n = blockIdx.y * 256 + threadIdx.x;
    float acc[8];
#pragma unroll
    for (int j = 0; j < 8; ++j) acc[j] = 0.f;
    for (int k = 0; k < K; ++k) { const float w = W[(size_t)k * ldw + n] * (kscale ? kscale[k] : 1.f);
#pragma unroll
        for (int j = 0; j < 8; ++j) acc[j] += bf2f(A[(size_t)(r0 + j) * lda + k]) * w; }
#pragma unroll
    for (int j = 0; j < 8; ++j) { const size_t r = r0 + j; float v = acc[j];
        if (MODE == 0) { float rs = 1.f; if (SS) { float s = 0.f; for (int q = 0; q < 16; ++q) s += SS[r * 16 + q]; rs = rsqrtf(s * (1.f / DM) + EPS); } O[r * ldo + n] = f2bf(v * rs * cscale); }
        else { const float x = res[r * ldo + n] + v; res[r * ldo + n] = x; O[r * ldo + n] = f2bf(x); } }
}
__global__ void __launch_bounds__(256) nv_wout(const bf16_t* A, const float* W, const float* x, float* out, bf16_t* XB) {
    const int r0 = blockIdx.x * 8, n = blockIdx.y * 256 + threadIdx.x;
    float acc[8];
#pragma unroll
    for (int j = 0; j < 8; ++j) acc[j] = 0.f;
    for (int k = 0; k < 1024; ++k) { const float w = W[(size_t)k * 1024 + n];
#pragma unroll
        for (int j = 0; j < 8; ++j) acc[j] += bf2f(A[(size_t)(r0 + j) * 1024 + k]) * w; }
#pragma unroll
    for (int j = 0; j < 8; ++j) { const size_t r = r0 + j; const float v = x[r * 1024 + n] + acc[j]; out[r * 1024 + n] = v; XB[r * 1024 + n] = f2bf(v); }
}
__global__ void __launch_bounds__(256) nv_merged(const bf16_t* AG, const float* Wa, const float* Wb, const bf16_t* GA, const bf16_t* GB, bf16_t* MG) {
    const int r0 = blockIdx.x * 8, n = blockIdx.y * 256 + threadIdx.x;
    float ya[8], yb[8];
#pragma unroll
    for (int j = 0; j < 8; ++j) { ya[j] = 0.f; yb[j] = 0.f; }
    for (int k = 0; k < 512; ++k) { const float wa = Wa[(size_t)k * 1024 + n], wb = Wb[(size_t)k * 1024 + n];
#pragma unroll
        for (int j = 0; j < 8; ++j) { ya[j] += bf2f(AG[(size_t)(r0 + j) * 1024 + k]) * wa; yb[j] += bf2f(AG[(size_t)(r0 + j) * 1024 + 512 + k]) * wb; } }
#pragma unroll
    for (int j = 0; j < 8; ++j) { const size_t r = r0 + j; MG[r * 1024 + n] = f2bf(bf2f(GA[r * 1024 + n]) * ya[j] + bf2f(GB[r * 1024 + n]) * yb[j]); }
}
__global__ void __launch_bounds__(256) nv_rowss(const float* X, float* SS) {
    const int lane = threadIdx.x & 63, row = blockIdx.x * 4 + (threadIdx.x >> 6); float s = 0.f;
    for (int j = 0; j < 16; ++j) { const float v = X[(size_t)row * 1024 + j * 64 + lane]; s += v * v; }
    s = wave_sum(s);
    if (lane < 16) SS[(size_t)row * 16 + lane] = lane == 0 ? s : 0.f;
}
__global__ void __launch_bounds__(256) nv_sel(const bf16_t* Q, const float* KMP, signed char* SEL) {
    const int idx = blockIdx.x * 256 + threadIdx.x, t = idx >> 3, h = idx & 7, b = t / SEQ, qb = (t % SEQ) / 256;
    float bv[3] = {-3e38f, -3e38f, -3e38f}; int bi[3] = {-1, -1, -1};
    for (int n = 0; n < qb; ++n) { float g = 0.f; const float* km = KMP + (size_t)(b * 32 + n) * 1024 + h * 64;
        for (int j = 0; j < 64; ++j) g += bf2f(Q[(size_t)t * 512 + h * 64 + j]) * (km[j] + km[512 + j]);
        if (g > bv[0]) { bv[2] = bv[1]; bi[2] = bi[1]; bv[1] = bv[0]; bi[1] = bi[0]; bv[0] = g; bi[0] = n; }
        else if (g > bv[1]) { bv[2] = bv[1]; bi[2] = bi[1]; bv[1] = g; bi[1] = n; }
        else if (g > bv[2]) { bv[2] = g; bi[2] = n; } }
    char4 o; o.x = (signed char)bi[0]; o.y = (signed char)bi[1]; o.z = (signed char)bi[2]; o.w = -1;
    ((char4*)SEL)[(size_t)(b * 8 + h) * SEQ + (t % SEQ)] = o;
}
__global__ void __launch_bounds__(256) nv_moba(const bf16_t* Q, const bf16_t* K, const bf16_t* V, const signed char* SEL, bf16_t* ATTGM) {
    const int lane = threadIdx.x & 63, idx = blockIdx.x * 4 + (threadIdx.x >> 6), t = idx >> 3, h = idx & 7, b = t / SEQ, pos = t % SEQ, qb = pos / 256;
    const float q = bf2f(Q[(size_t)t * 512 + h * 64 + lane]);
    float m = -3e38f, l = 0.f, o = 0.f;
    for (int s = 0; s < 4; ++s) {
        int n, cnt;
        if (s < 3) { n = SEL[((size_t)(b * 8 + h) * SEQ + pos) * 4 + s]; if (n < 0) continue; cnt = 256; } else { n = qb; cnt = pos - qb * 256 + 1; }
        const size_t base = (size_t)b * SEQ + (size_t)n * 256;
        for (int j = 0; j < cnt; ++j) {
            const float sc = wave_sum(q * bf2f(K[(base + j) * 512 + h * 64 + lane]));
            const float mn = fmaxf(m, sc), al = exp2f(m - mn), p = exp2f(sc - mn);
            l = l * al + p; o = o * al + p * bf2f(V[(base + j) * 512 + h * 64 + lane]); m = mn; } }
    ATTGM[(size_t)t * 1024 + h * 64 + lane] = f2bf(o / l);
}
__global__ void __launch_bounds__(256) nv_gvstat(const bf16_t* GV, float* RS) {
    const int lane = threadIdx.x & 63, row = blockIdx.x * 4 + (threadIdx.x >> 6); float s = 0.f;
    for (int j = 0; j < 8; ++j) { const float v = bf2f(GV[(size_t)row * 512 + j * 64 + lane]); s += v * v; }
    s = wave_sum(s);
    if (lane == 0) RS[row] = rsqrtf(s * (1.f / 512.f) + EPS);
}
__global__ void __launch_bounds__(256) nv_gmlp(const bf16_t* U, const bf16_t* GV, const float* RS, const float* ng, const float* w_s, const float* b_s, bf16_t* ATTGM) {
    const size_t idx = (size_t)blockIdx.x * 256 + threadIdx.x; const int t = (int)(idx >> 9), c = (int)(idx & 511), g = c >> 6, tt = t & 127, t0 = t - tt;
    float z = 0.f;
    for (int s = 0; s <= tt; ++s) z += w_s[((size_t)g * 128 + tt) * 128 + s] * (bf2f(GV[(size_t)(t0 + s) * 512 + c]) * RS[t0 + s] * ng[c]);
    z += b_s[g * 128 + tt];
    ATTGM[(size_t)t * 1024 + 512 + c] = f2bf(bf2f(U[(size_t)t * 512 + c]) * z);
}
__global__ void __launch_bounds__(256) nv_xattn(const bf16_t* XQ, const bf16_t* XKV, bf16_t* XO) {
    const int lane = threadIdx.x & 63, idx = blockIdx.x * 4 + (threadIdx.x >> 6), t = idx >> 2, h = idx & 3, b = t / SEQ;
    const float q0 = bf2f(XQ[(size_t)t * 512 + h * 128 + lane]), q1 = bf2f(XQ[(size_t)t * 512 + h * 128 + 64 + lane]);
    float m = -3e38f, l = 0.f, o0 = 0.f, o1 = 0.f;
    for (int j = 0; j < NMEM; ++j) { const bf16_t* kr = XKV + (size_t)(b * NMEM + j) * 1024 + h * 128;
        const float sc = wave_sum(q0 * bf2f(kr[lane]) + q1 * bf2f(kr[64 + lane]));
        const float mn = fmaxf(m, sc), al = exp2f(m - mn), p = exp2f(sc - mn);
        l = l * al + p; o0 = o0 * al + p * bf2f(kr[512 + lane]); o1 = o1 * al + p * bf2f(kr[512 + 64 + lane]); m = mn; }
    XO[(size_t)t * 512 + h * 128 + lane] = f2bf(o0 / l); XO[(size_t)t * 512 + h * 128 + 64 + lane] = f2bf(o1 / l);
}
__device__ __forceinline__ void wave_argmax(float v, int i, float& bv, int& bi) {
#pragma unroll
    for (int o = 1; o < 64; o <<= 1) { const float ov = __shfl_xor(v, o); const int oi = __shfl_xor(i, o); if (ov > v || (ov == v && oi < i)) { v = ov; i = oi; } }
    bv = v; bi = i;
}
__global__ void __launch_bounds__(256) nv_peer_topk(const bf16_t* QP, const float* SK, int* PID, float* PW) {
    __shared__ float sv[4][2][16]; __shared__ int si[4][2][16];
    const int lane = threadIdx.x & 63, w = threadIdx.x >> 6, idx = blockIdx.x * 4 + w, t = idx >> 3, h = idx & 7;
    for (int p = 0; p < 2; ++p) {
        const bf16_t* q = QP + (size_t)t * 2048 + h * 256 + p * 128; const float* k0 = SK + ((size_t)(h * 2 + p) * 128 + lane) * 128; const float* k1 = k0 + 64 * 128;
        float s0 = 0.f, s1 = 0.f;
        for (int d = 0; d < 128; ++d) { const float qq = bf2f(q[d]); s0 += qq * k0[d]; s1 += qq * k1[d]; }
        for (int r = 0; r < 16; ++r) { float v; int i; if (s0 >= s1) { v = s0; i = lane; } else { v = s1; i = lane + 64; }
            float bv; int bi; wave_argmax(v, i, bv, bi);
            if (bi == lane) s0 = -3e38f; if (bi == lane + 64) s1 = -3e38f;
            if (lane == 0) { sv[w][p][r] = bv; si[w][p][r] = bi; } }
    }
    __syncthreads();
    float c[4]; int ci[4];
#pragma unroll
    for (int j = 0; j < 4; ++j) { const int pos = lane * 4 + j, i1 = pos >> 4, i2 = pos & 15; c[j] = sv[w][0][i1] + sv[w][1][i2]; ci[j] = pos; }
    float mykeep = 0.f; int myid = 0;
    float top0 = 0.f, denom = 0.f;
    for (int r = 0; r < 16; ++r) { float v = c[0]; int i = ci[0];
#pragma unroll
        for (int j = 1; j < 4; ++j) if (c[j] > v) { v = c[j]; i = ci[j]; }
        float bv; int bi; wave_argmax(v, i, bv, bi);
#pragma unroll
        for (int j = 0; j < 4; ++j) if (ci[j] == bi) c[j] = -3e38f;
        if (r == 0) top0 = bv;
        const float e = __expf(bv - top0); denom += e;
        if (lane == r) { mykeep = e; myid = si[w][0][bi >> 4] * 128 + si[w][1][bi & 15]; } }
    if (lane < 16) { PID[(size_t)idx * 16 + lane] = myid; PW[(size_t)idx * 16 + lane] = mykeep / denom; }
}
__global__ void __launch_bounds__(256) nv_peer_ffn(const bf16_t* XB, const float* SS, const float* gffn, const float* WDn, const float* WUp, const int* PID, const float* PW, const float* fg, float* out) {
    __shared__ float coef[128]; __shared__ int eid[128]; __shared__ float red[4];
    const int t = blockIdx.x, tid = threadIdx.x, lane = tid & 63, w = tid >> 6;
    float s = 0.f; for (int q = 0; q < 16; ++q) s += SS[(size_t)t * 16 + q]; const float rstd = rsqrtf(s * (1.f / DM) + EPS);
    float xh[16];
#pragma unroll
    for (int j = 0; j < 16; ++j) xh[j] = bf2f(XB[(size_t)t * 1024 + j * 64 + lane]) * gffn[j * 64 + lane];
    for (int jj = 0; jj < 32; ++jj) { const int j = w * 32 + jj; const int e = PID[(size_t)t * 128 + j]; const float* wd = WDn + (size_t)e * 1024; float d = 0.f;
#pragma unroll
        for (int q = 0; q < 16; ++q) d += xh[q] * wd[q * 64 + lane];
        d = wave_sum(d) * rstd;
        if (lane == 0) { coef[j] = PW[(size_t)t * 128 + j] * gelu_tanh(d); eid[j] = e; } }
    __syncthreads();
    float y[4] = {0.f, 0.f, 0.f, 0.f};
    for (int j = 0; j < 128; ++j) { const float cf = coef[j]; const float4 u = *(const float4*)(WUp + (size_t)eid[j] * 1024 + tid * 4); y[0] += cf * u.x; y[1] += cf * u.y; y[2] += cf * u.z; y[3] += cf * u.w; }
    const float4 x2 = *(const float4*)(out + (size_t)t * 1024 + tid * 4);
    y[0] += x2.x; y[1] += x2.y; y[2] += x2.z; y[3] += x2.w;
    float ss = wave_sum(y[0] * y[0] + y[1] * y[1] + y[2] * y[2] + y[3] * y[3]);
    if (lane == 0) red[w] = ss;
    __syncthreads();
    const float r2 = rsqrtf((red[0] + red[1] + red[2] + red[3]) * (1.f / DM) + EPS);
    const float4 g = *(const float4*)(fg + tid * 4);
    *(float4*)(out + (size_t)t * 1024 + tid * 4) = make_float4(y[0] * r2 * g.x, y[1] * r2 * g.y, y[2] * r2 * g.z, y[3] * r2 * g.w);
}

#ifndef OPT_MASK
#define OPT_MASK 0xFFFFu
#endif

static void launch_mega(const Args& a0, int lo, int hi, int grid, hipStream_t stream, int li = 0) {
    Args a = a0; a.ph_lo = lo; a.ph_hi = hi; a.li = li;
    void* args[] = {&a};
    hipError_t e = hipLaunchCooperativeKernel((void*)mega_fwd, dim3(grid), dim3(NTHREADS), args, LDS_BYTES, stream);
    if (e != hipSuccess) fprintf(stderr, "cooperative launch failed: %s (grid %d)\n", hipGetErrorString(e), grid);
}

extern "C" void kernel_launch(void* const* d_in, const int* in_sizes, int n_in, void* d_out, int out_size, void* d_ws, size_t ws_size, hipStream_t stream) {
    static int grid = 0;
    if (grid == 0) {
        int dev = 0, cus = 0, per_cu = 0;
        (void)hipGetDevice(&dev);
        (void)hipDeviceGetAttribute(&cus, hipDeviceAttributeMultiprocessorCount, dev);
        (void)hipFuncSetAttribute((const void*)mega_fwd, hipFuncAttributeMaxDynamicSharedMemorySize, LDS_BYTES);
        (void)hipOccupancyMaxActiveBlocksPerMultiprocessor(&per_cu, (const void*)mega_fwd, NTHREADS, LDS_BYTES);
        if (n_in != 21 || ws_size < WS_END || out_size != T_TOK * DM || per_cu < 1) { fprintf(stderr, "kernel_launch: bad config n_in %d ws %zu out %d per_cu %d\n", n_in, ws_size, out_size, per_cu); grid = -1; return; }
        grid = cus;
    }
    if (grid < 0) return;
    (void)hipMemsetAsync((char*)d_ws + WS_CTL, 0, CTL_BYTES, stream);
    Args a{};
    for (int i = 0; i < 21; ++i) a.in[i] = (const float*)d_in[i];
    a.out = (float*)d_out; a.ws = (unsigned char*)d_ws;
    unsigned char* ws = (unsigned char*)d_ws;
    const unsigned mask = OPT_MASK;
#ifndef PROBE_LO
#define PROBE_LO 0
#define PROBE_HI 0
#endif
    if (PROBE_HI >= PROBE_LO && PROBE_HI > 0) { launch_mega(a, 0, PROBE_HI, grid, stream, 0); launch_mega(a, PROBE_LO, NPHASE, grid, stream, 1); return; }
    if (mask == (1u << NPHASE) - 1u) { launch_mega(a, 0, NPHASE, grid, stream); return; }
#define BF(off) ((bf16_t*)(ws + (off)))
#define FP(off) ((float*)(ws + (off)))
    for (int ph = 0; ph < NPHASE; ++ph) {
        if (mask & (1u << ph)) { int hi = ph + 1; while (hi < NPHASE && (mask & (1u << hi))) ++hi; launch_mega(a, ph, hi, grid, stream); ph = hi - 1; continue; }
        switch (ph) {
        case 1:
            nv_inproj_rope<<<dim3(T_TOK / 8, 2), 256, 0, stream>>>(BF(WS_XN), a.in[3], (const float2*)(ws + WS_ROPE), BF(WS_Q), BF(WS_K));
            nv_inproj_rest<<<dim3(T_TOK / 8, 14), 256, 0, stream>>>(BF(WS_XN), a.in[3], BF(WS_V), BF(WS_U), BF(WS_GV), BF(WS_GA), BF(WS_GB));
            nv_kmean<<<256, 512, 0, stream>>>(BF(WS_K), FP(WS_KMP));
            nv_gemm<0><<<dim3(NB * NMEM / 8, 4), 256, 0, stream>>>(BF(WS_MN), 1024, a.in[13], 1024, 1024, nullptr, BF(WS_XKV), 1024, nullptr, 1.f, nullptr);
            break;
        case 2:
            nv_sel<<<T_TOK * 8 / 256, 256, 0, stream>>>(BF(WS_Q), FP(WS_KMP), (signed char*)(ws + WS_SEL));
            nv_gvstat<<<T_TOK / 4, 256, 0, stream>>>(BF(WS_GV), FP(WS_RS));
            nv_gmlp<<<T_TOK * 512 / 256, 256, 0, stream>>>(BF(WS_U), BF(WS_GV), FP(WS_RS), a.in[5], a.in[6], a.in[7], BF(WS_ATTGM));
            break;
        case 3:
            break;
        case 4:
            nv_moba<<<T_TOK * 8 / 4, 256, 0, stream>>>(BF(WS_Q), BF(WS_K), BF(WS_V), (const signed char*)(ws + WS_SEL), BF(WS_ATTGM));
            break;
        case 5:
            nv_merged<<<dim3(T_TOK / 8, 4), 256, 0, stream>>>(BF(WS_ATTGM), a.in[4], a.in[8], BF(WS_GA), BF(WS_GB), BF(WS_MERGED));
            break;
        case 6:
            nv_wout<<<dim3(T_TOK / 8, 4), 256, 0, stream>>>(BF(WS_MERGED), a.in[9], a.in[0], a.out, BF(WS_XB));
            nv_rowss<<<T_TOK / 4, 256, 0, stream>>>(a.out, FP(WS_SS1));
            break;
        case 7:
            nv_gemm<0><<<dim3(T_TOK / 8, 2), 256, 0, stream>>>(BF(WS_XB), 1024, a.in[12], 512, 1024, a.in[10], BF(WS_XQ), 512, FP(WS_SS1), C2X, nullptr);
            break;
        case 8:
            nv_xattn<<<T_TOK * 4 / 4, 256, 0, stream>>>(BF(WS_XQ), BF(WS_XKV), BF(WS_XO));
            break;
        case 9:
            nv_gemm<1><<<dim3(T_TOK / 8, 4), 256, 0, stream>>>(BF(WS_XO), 512, a.in[14], 1024, 512, nullptr, BF(WS_XB), 1024, nullptr, 1.f, a.out);
            nv_rowss<<<T_TOK / 4, 256, 0, stream>>>(a.out, FP(WS_SS2));
            break;
        case 10:
            nv_gemm<0><<<dim3(T_TOK / 8, 8), 256, 0, stream>>>(BF(WS_XB), 1024, a.in[16], 2048, 1024, a.in[15], BF(WS_QP), 2048, FP(WS_SS2), 1.f, nullptr);
            break;
        case 11:
            nv_peer_topk<<<T_TOK * 8 / 4, 256, 0, stream>>>(BF(WS_QP), a.in[17], (int*)(ws + WS_PID), FP(WS_PW));
            break;
        case 12:
            nv_peer_ffn<<<T_TOK, 256, 0, stream>>>(BF(WS_XB), FP(WS_SS2), a.in[15], a.in[18], a.in[19], (const int*)(ws + WS_PID), FP(WS_PW), a.in[20], a.out);
            break;
        default: break;
        }
    }
#undef BF
#undef FP
}
```
